# Optimizing an MI355X kernel written in HIP

```python
import math
import jax, jax.numpy as jnp
from jax import lax
import numpy as np

D_MODEL = 1024
BATCH = 4
SEQ = 4096
DEPTH = 2

HEAD_DIM = 64
N_Q_HEADS = D_MODEL // HEAD_DIM
GQA_GROUP = 4
N_KV_HEADS = N_Q_HEADS // GQA_GROUP
WINDOW = 128
BLOCK = 128
NUM_BUCKETS = 32
MAX_DISTANCE = 128
ATTN_IN = (N_Q_HEADS + 2 * N_KV_HEADS) * HEAD_DIM
MLSTM_HEADS = 8
MLSTM_DV = D_MODEL // MLSTM_HEADS
MLSTM_DQK = MLSTM_DV // 2
MLSTM_CHUNK = 64
MLSTM_IN = 2 * MLSTM_HEADS * MLSTM_DQK + 2 * MLSTM_HEADS * MLSTM_DV + 4 * MLSTM_HEADS
N_EXPERTS = 16
CAPACITY_FACTOR = 2
D_EXPERT = 2 * D_MODEL
N_MIXERS = 2
N_ATTN_LAYERS = (DEPTH + 1) // 2
N_MLSTM_LAYERS = DEPTH // 2
RMS_EPS = 1e-6

kernel_name = "hybrid_swa_mlstm_ecmoe_encoder"


def rms_norm(x, g):
    xf = x.astype(jnp.float32)
    y = xf * lax.rsqrt(jnp.mean(xf * xf, axis=-1, keepdims=True) + RMS_EPS)
    return (y * g.astype(jnp.float32)).astype(x.dtype)


def t5_bucket(rel):
    nb = NUM_BUCKETS // 2
    ret = (rel > 0).astype(jnp.int32) * nb
    n = jnp.abs(rel)
    max_exact = nb // 2
    nf = jnp.maximum(n, 1).astype(jnp.float32)
    large = max_exact + (jnp.log(nf / max_exact) / math.log(MAX_DISTANCE / max_exact)
                         * (nb - max_exact)).astype(jnp.int32)
    large = jnp.minimum(large, nb - 1)
    return ret + jnp.where(n < max_exact, n, large)


def windowed_gqa(h, w_in, q_g, k_g, sink, w_out, rel_bias):
    B, S, _ = h.shape
    nb = S // BLOCK
    proj = h @ w_in
    q = proj[..., :N_Q_HEADS * HEAD_DIM].reshape(B, S, N_KV_HEADS, GQA_GROUP, HEAD_DIM)
    k = proj[..., N_Q_HEADS * HEAD_DIM:(N_Q_HEADS + N_KV_HEADS) * HEAD_DIM].reshape(B, S, N_KV_HEADS, HEAD_DIM)
    v = proj[..., (N_Q_HEADS + N_KV_HEADS) * HEAD_DIM:].reshape(B, S, N_KV_HEADS, HEAD_DIM)
    q = rms_norm(q, q_g) * (HEAD_DIM ** -0.5)
    k = rms_norm(k, k_g)
    qb = q.reshape(B, nb, BLOCK, N_KV_HEADS, GQA_GROUP, HEAD_DIM)

    def band(t):
        tp = jnp.pad(t, ((0, 0), (BLOCK, BLOCK), (0, 0), (0, 0))).reshape(B, nb + 2, BLOCK, N_KV_HEADS, HEAD_DIM)
        return jnp.concatenate([tp[:, :-2], tp[:, 1:-1], tp[:, 2:]], axis=2)

    kw, vw = band(k), band(v)
    qq = jnp.arange(BLOCK)[:, None]
    kk = jnp.arange(3 * BLOCK)[None, :]
    rel = kk - BLOCK - qq
    bias = rel_bias.astype(jnp.float32)[t5_bucket(rel)]
    bias = bias.transpose(2, 0, 1).reshape(N_KV_HEADS, GQA_GROUP, BLOCK, 3 * BLOCK)
    kpos = jnp.arange(nb)[:, None] * BLOCK + jnp.arange(3 * BLOCK)[None, :] - BLOCK
    mask = (jnp.abs(rel) <= WINDOW)[None] & ((kpos >= 0) & (kpos < S))[:, None, :]

    s = jnp.einsum('bnqhgd,bnkhd->bnhgqk', qb, kw).astype(jnp.float32) + bias
    s = jnp.where(mask[None, :, None, None], s, -jnp.inf)
    sk = sink.astype(jnp.float32).reshape(1, 1, N_KV_HEADS, GQA_GROUP, 1)
    m = jnp.maximum(jnp.max(s, axis=-1), sk)
    p = jnp.exp(s - m[..., None])
    den = jnp.sum(p, axis=-1) + jnp.exp(sk - m)
    p = p / den[..., None]
    o = jnp.einsum('bnhgqk,bnkhd->bnqhgd', p, vw.astype(jnp.float32))
    o = o.reshape(B, S, N_Q_HEADS * HEAD_DIM).astype(h.dtype)
    return o @ w_out


def mlstm_chunk_scan(q, k, v, ig, lf):
    B, H, S, dqk = q.shape
    dv = v.shape[-1]
    nc = S // MLSTM_CHUNK
    L = MLSTM_CHUNK

    def chunks(t):
        t = t.reshape((B, H, nc, L) + t.shape[3:])
        return jnp.moveaxis(t, 2, 0)

    tril = jnp.tril(jnp.ones((L, L), dtype=bool))

    def step(carry, inp):
        C, n, m = carry
        qc, kc, vc, ic, fc = inp
        b = jnp.cumsum(fc, axis=-1)
        Dm = jnp.where(tril, b[..., :, None] - b[..., None, :] + ic[..., None, :], -jnp.inf)
        a = b + m[..., None]
        mt = jnp.maximum(a, jnp.max(Dm, axis=-1))
        W = jnp.exp(Dm - mt[..., None])
        ea = jnp.exp(a - mt)
        Sw = W * jnp.einsum('bhld,bhsd->bhls', qc, kc)
        num = ea[..., None] * jnp.einsum('bhld,bhde->bhle', qc, C) + jnp.einsum('bhls,bhse->bhle', Sw, vc)
        den = ea * jnp.einsum('bhld,bhd->bhl', qc, n) + jnp.sum(Sw, axis=-1)
        hc = num / jnp.maximum(jnp.abs(den), jnp.exp(-mt))[..., None]
        bL = b[..., -1]
        g = bL[..., None] - b + ic
        m_new = jnp.maximum(bL + m, jnp.max(g, axis=-1))
        wC = jnp.exp(g - m_new[..., None])
        decay = jnp.exp(bL + m - m_new)
        C_new = decay[..., None, None] * C + jnp.einsum('bhs,bhsd,bhse->bhde', wC, kc, vc)
        n_new = decay[..., None] * n + jnp.einsum('bhs,bhsd->bhd', wC, kc)
        return (C_new, n_new, m_new), hc

    init = (jnp.zeros((B, H, dqk, dv), jnp.float32), jnp.zeros((B, H, dqk), jnp.float32),
            jnp.zeros((B, H), jnp.float32))
    _, hs = lax.scan(step, init, (chunks(q), chunks(k), chunks(v), chunks(ig), chunks(lf)))
    return jnp.moveaxis(hs, 0, 2).reshape(B, H, S, dv)


def bidir_mlstm(h, w_in, b_i, b_f, out_g, w_out):
    B, S, _ = h.shape
    proj = (h @ w_in).astype(jnp.float32)
    o1 = MLSTM_HEADS * MLSTM_DQK
    o2 = 2 * o1
    o3 = o2 + MLSTM_HEADS * MLSTM_DV
    o4 = o3 + MLSTM_HEADS * MLSTM_DV
    heads = lambda t, d: t.reshape(B, S, MLSTM_HEADS, d).transpose(0, 2, 1, 3)
    q = heads(proj[..., :o1], MLSTM_DQK)
    k = heads(proj[..., o1:o2], MLSTM_DQK) * (MLSTM_DQK ** -0.5)
    v = heads(proj[..., o2:o3], MLSTM_DV)
    og = proj[..., o3:o4]
    gates = proj[..., o4:].reshape(B, S, 4, MLSTM_HEADS).transpose(2, 0, 3, 1)
    bi = b_i.astype(jnp.float32)[:, None, :, None]
    bf = b_f.astype(jnp.float32)[:, None, :, None]
    ig_f, ig_b = gates[0] + bi[0], gates[2] + bi[1]
    lf_f, lf_b = jax.nn.log_sigmoid(gates[1] + bf[0]), jax.nn.log_sigmoid(gates[3] + bf[1])
    h_f = mlstm_chunk_scan(q, k, v, ig_f, lf_f)
    fl = lambda t: jnp.flip(t, axis=2)
    h_b = fl(mlstm_chunk_scan(fl(q), fl(k), fl(v), fl(ig_b), fl(lf_b)))
    hs = (h_f + h_b).transpose(0, 2, 1, 3)
    hs = rms_norm(hs, out_g.reshape(MLSTM_HEADS, MLSTM_DV)).reshape(B, S, MLSTM_HEADS * MLSTM_DV)
    y = (hs * jax.nn.sigmoid(og)).astype(h.dtype)
    return y @ w_out


def expert_choice_moe(h, w_r, w1, w3, w2):
    B, T, D = h.shape
    cap = CAPACITY_FACTOR * T // N_EXPERTS
    aff = jax.nn.softmax(jnp.einsum('btd,de->bte', h, w_r).astype(jnp.float32), axis=-1)
    g, idx = lax.top_k(jnp.swapaxes(aff, 1, 2), cap)
    xs = jax.vmap(lambda hb, ib: hb[ib])(h, idx)
    a = jnp.einsum('becd,edf->becf', xs, w1)
    u = jnp.einsum('becd,edf->becf', xs, w3)
    y = jnp.einsum('becf,efd->becd', jax.nn.silu(a) * u, w2)
    y = y * g[..., None].astype(y.dtype)
    return jax.vmap(lambda ib, yb: jnp.zeros((T, D), yb.dtype).at[ib.reshape(-1)].add(yb.reshape(-1, D)))(idx, y)


def setup_inputs(seed: int = 0) -> dict:
    key = jax.random.key(seed)
    ks = jax.random.split(key, 20)
    nrm = lambda k, shape, scale: jax.random.normal(k, shape, jnp.float32) * scale
    NA, NM, D = N_ATTN_LAYERS, N_MLSTM_LAYERS, D_MODEL
    return {
        "x": nrm(ks[0], (BATCH, SEQ, D), 1.0),
        "rel_bias": nrm(ks[1], (NUM_BUCKETS, N_Q_HEADS), 0.5),
        "attn_norm_g": 1.0 + nrm(ks[2], (NA, D), 0.02),
        "attn_w_in": nrm(ks[3], (NA, D, ATTN_IN), D ** -0.5),
        "attn_q_norm_g": 1.0 + nrm(ks[4], (NA, HEAD_DIM), 0.02),
        "attn_k_norm_g": 1.0 + nrm(ks[5], (NA, HEAD_DIM), 0.02),
        "attn_sink": nrm(ks[6], (NA, N_Q_HEADS), 0.5),
        "attn_w_out": nrm(ks[7], (NA, N_Q_HEADS * HEAD_DIM, D), (N_Q_HEADS * HEAD_DIM) ** -0.5),
        "mlstm_norm_g": 1.0 + nrm(ks[8], (NM, D), 0.02),
        "mlstm_w_in": nrm(ks[9], (NM, D, MLSTM_IN), D ** -0.5),
        "mlstm_b_i": nrm(ks[10], (NM, 2, MLSTM_HEADS), 0.1),
        "mlstm_b_f": jnp.linspace(3.0, 6.0, MLSTM_HEADS, dtype=jnp.float32)[None, None]
                      + nrm(ks[11], (NM, 2, MLSTM_HEADS), 0.1),
        "mlstm_out_norm_g": 1.0 + nrm(ks[12], (NM, MLSTM_HEADS * MLSTM_DV), 0.02),
        "mlstm_w_out": nrm(ks[13], (NM, MLSTM_HEADS * MLSTM_DV, D), (MLSTM_HEADS * MLSTM_DV) ** -0.5),
        "ffn_norm_g": 1.0 + nrm(ks[14], (DEPTH, D), 0.02),
        "router_w": nrm(ks[15], (DEPTH, D, N_EXPERTS), D ** -0.5),
        "expert_w1": nrm(ks[16], (DEPTH, N_EXPERTS, D, D_EXPERT), D ** -0.5),
        "expert_w3": nrm(ks[17], (DEPTH, N_EXPERTS, D, D_EXPERT), D ** -0.5),
        "expert_w2": nrm(ks[18], (DEPTH, N_EXPERTS, D_EXPERT, D), D_EXPERT ** -0.5),
    }


def reference(x, rel_bias, attn_norm_g, attn_w_in, attn_q_norm_g, attn_k_norm_g, attn_sink, attn_w_out,
              mlstm_norm_g, mlstm_w_in, mlstm_b_i, mlstm_b_f, mlstm_out_norm_g, mlstm_w_out,
              ffn_norm_g, router_w, expert_w1, expert_w3, expert_w2):
    for i in range(DEPTH):
        j = i // N_MIXERS
        if i % N_MIXERS == 0:
            x = x + windowed_gqa(rms_norm(x, attn_norm_g[j]), attn_w_in[j], attn_q_norm_g[j],
                                 attn_k_norm_g[j], attn_sink[j], attn_w_out[j], rel_bias)
        else:
            x = x + bidir_mlstm(rms_norm(x, mlstm_norm_g[j]), mlstm_w_in[j], mlstm_b_i[j], mlstm_b_f[j],
                                mlstm_out_norm_g[j], mlstm_w_out[j])
        x = x + expert_choice_moe(rms_norm(x, ffn_norm_g[i]), router_w[i], expert_w1[i], expert_w3[i],
                                  expert_w2[i])
    return x
```

```cpp
#include <hip/hip_runtime.h>
#include <cstdio>
#include <cstdint>

#define GAS __attribute__((address_space(1)))
#define LAS __attribute__((address_space(3)))
typedef unsigned short bf16_t;
typedef short bf16x8 __attribute__((ext_vector_type(8)));
typedef short s16x4 __attribute__((ext_vector_type(4)));
typedef float f32x4 __attribute__((ext_vector_type(4)));
typedef float f32x2 __attribute__((ext_vector_type(2)));
typedef float f32x16 __attribute__((ext_vector_type(16)));
typedef unsigned u32x4 __attribute__((ext_vector_type(4)));
typedef unsigned u32x2 __attribute__((ext_vector_type(2)));
typedef int i32x4 __attribute__((ext_vector_type(4)));
typedef int i32x8 __attribute__((ext_vector_type(8)));
#define LDS_WAIT() asm volatile("s_waitcnt lgkmcnt(0)" ::: "memory")
#define VM_WAIT() asm volatile("s_waitcnt vmcnt(0)" ::: "memory")
#define DI __device__ __forceinline__

constexpr int NB = 4, SEQ = 4096, D = 1024, M = NB * SEQ;
constexpr int NQKV = 1536;
constexpr int MIN_N = 3072, MIN_LD = 3104;
constexpr int NE = 16, CAP = 512, DE = 2048, MROWS = NB * NE * CAP;
constexpr float RMS_EPS = 1e-6f, LOG2E = 1.4426950408889634f;
constexpr int NWAVES = 8, NTHR = 512;

constexpr size_t MiB = 1u << 20;
constexpr size_t WS_CTL = 0, CTL_ZERO_BYTES = 1 * MiB;
constexpr size_t WS_WQKV = 2 * MiB, WS_WAO = 6 * MiB, WS_WMIN = 8 * MiB, WS_WMO = 14 * MiB;
constexpr size_t WS_W13 = 16 * MiB, W13_LAYER = 64 * MiB;
constexpr size_t WS_W2 = 272 * MiB, W2_LAYER = 32 * MiB;
constexpr size_t WS_XN = 400 * MiB, WS_X1 = 432 * MiB, WS_X2 = 496 * MiB, WS_X3 = 464 * MiB;
constexpr size_t WS_XN8 = 904 * MiB;
constexpr size_t WS_AFF = 560 * MiB, WS_IDX = 561 * MiB, WS_GATE = 562 * MiB, WS_SLOT = 563 * MiB, WS_MG = 564 * MiB;
constexpr size_t WS_ACT = 568 * MiB;
constexpr size_t WS_Q = WS_ACT, WS_K = WS_ACT + 32 * MiB, WS_V = WS_ACT + 40 * MiB, WS_O = WS_ACT + 48 * MiB;
constexpr size_t WS_H = WS_ACT, WS_Y = WS_ACT + 128 * MiB;
constexpr size_t WS_PROJ = WS_ACT, WS_CLOC = WS_ACT + 96 * MiB, WS_STATE = WS_ACT + 232 * MiB, WS_Y2 = WS_ACT + 300 * MiB;
constexpr size_t WS_NLOC = WS_ACT + 332 * MiB, WS_MLB = WS_ACT + 333 * MiB, WS_NST = WS_ACT + 334 * MiB, WS_MST = WS_ACT + 335 * MiB;
constexpr size_t WS_PART = 920 * MiB;
constexpr size_t WS_RSC = WS_AFF;
constexpr size_t WS_END = 928 * MiB;
constexpr int CW_BAR = 4096;

constexpr int RING_BYTES = 131072;
constexpr int AUX_OFF = RING_BYTES, AUX_BYTES = 24576;
constexpr int MISC_OFF = AUX_OFF + AUX_BYTES;
constexpr int LDS_BYTES = MISC_OFF + 256;

DI unsigned f2bf(float f) { unsigned u = __builtin_bit_cast(unsigned, f); return (u + 0x7fffu + ((u >> 16) & 1u)) >> 16; }
DI unsigned pk2(float lo, float hi) { return f2bf(lo) | (f2bf(hi) << 16); }
DI unsigned cvt_pk_bf16(float lo, float hi) { unsigned r; asm volatile("v_cvt_pk_bf16_f32 %0, %1, %2" : "=v"(r) : "v"(lo), "v"(hi)); return r; }
DI unsigned pk4_fp8(float a, float b, float c, float d) { unsigned w = 0u; w = __builtin_amdgcn_cvt_pk_fp8_f32(a, b, w, false); w = __builtin_amdgcn_cvt_pk_fp8_f32(c, d, w, true); return w; }
DI float bf2f(unsigned short b) { return __builtin_bit_cast(float, ((unsigned)b) << 16); }
DI float wave_sum(float v) {
#pragma unroll
    for (int o = 1; o < 64; o <<= 1) v += __shfl_xor(v, o);
    return v;
}

#define XB_TMO      128
#define XB_XCNT(j)  (256  + 64 * (j))
#define XB_XSUB(j)  (1280 + 64 * (j))
#define XB_XGEN(j)  (2304 + 64 * (j))
#define XB_TOP      3328
#define XB_TOPGEN   3392
#define XCD_BAR_WORDS 3456
#define XB_SPIN_CAP (1u << 18)
DI unsigned xb_ld(unsigned* p)              { return __hip_atomic_load(p, __ATOMIC_RELAXED, __HIP_MEMORY_SCOPE_AGENT); }
DI unsigned xb_add(unsigned* p, unsigned v) { return __hip_atomic_fetch_add(p, v, __ATOMIC_RELAXED, __HIP_MEMORY_SCOPE_AGENT); }
DI unsigned xb_xcc_id() { return (unsigned)__builtin_amdgcn_s_getreg((3 << 11) | 20) & 0xFu; }
#define XB_SPIN(cond, bar) do { unsigned _sp = 0; while (cond) { __builtin_amdgcn_s_sleep(1); \
    if ((++_sp & 255u) == 0u) { if (xb_ld(&(bar)[XB_TMO])) break; if (_sp > XB_SPIN_CAP) { atomicAdd(&(bar)[XB_TMO], 1u); break; } } } } while (0)
struct XcdBarrier { unsigned* bar; unsigned x; volatile LAS unsigned* st; };
DI XcdBarrier xcd_barrier_post(unsigned* bar, volatile LAS unsigned* st) {
    XcdBarrier b; b.bar = bar; b.x = xb_xcc_id(); b.st = st;
    if (threadIdx.x == 0) (void)xb_add(&bar[XB_XCNT(b.x)], 1u);
    return b;
}
DI void xcd_barrier_complete(unsigned* bar, unsigned x, unsigned& nloc, unsigned& nx) {
    const unsigned G = gridDim.x * gridDim.y * gridDim.z;
    unsigned sum, cnt, mine, sp = 0u;
    for (;;) {
        sum = 0u; cnt = 0u; mine = 0u;
#pragma unroll
        for (unsigned j = 0; j < 16; ++j) { const unsigned c = xb_ld(&bar[XB_XCNT(j)]); sum += c; cnt += (c > 0u) ? 1u : 0u; mine = (j == x) ? c : mine; }
        if (sum == G) break;
        __builtin_amdgcn_s_sleep(1);
        if ((++sp & 255u) == 0u) { if (xb_ld(&bar[XB_TMO])) break; if (sp > XB_SPIN_CAP) { atomicAdd(&bar[XB_TMO], 1u); break; } }
    }
    nloc = mine > 0u ? mine : 1u; nx = cnt > 0u ? cnt : 1u;
}
DI void xcd_barrier(const XcdBarrier& b) {
    asm volatile("s_waitcnt vmcnt(0)" ::: "memory");
    __syncthreads();
    if (threadIdx.x == 0) {
        unsigned* bar = b.bar;
        __builtin_amdgcn_s_waitcnt(0);
        unsigned nloc = b.st[0], nx = b.st[1];
        if (nloc == 0u) { xcd_barrier_complete(bar, b.x, nloc, nx); b.st[0] = nloc; b.st[1] = nx; }
        const unsigned old = xb_add(&bar[XB_XSUB(b.x)], 1u);
        const unsigned gen = old / nloc;
        if (old + 1u == (gen + 1u) * nloc) {
            __builtin_amdgcn_fence(__ATOMIC_RELEASE, "agent");
            asm volatile("s_waitcnt vmcnt(0)" ::: "memory");
            const unsigned og = xb_add(&bar[XB_TOP], 1u);
            const unsigned tg = og / nx;
            if (og + 1u == (tg + 1u) * nx) xb_add(&bar[XB_TOPGEN], 1u);
            else XB_SPIN(xb_ld(&bar[XB_TOPGEN]) == tg, bar);
            __builtin_amdgcn_fence(__ATOMIC_ACQUIRE, "agent");
            xb_add(&bar[XB_XGEN(b.x)], 1u);
            asm volatile("s_waitcnt vmcnt(0)" ::: "memory");
        } else {
            XB_SPIN(xb_ld(&bar[XB_XGEN(b.x)]) == gen, bar);
            __builtin_amdgcn_fence(__ATOMIC_ACQUIRE, "agent");
            asm volatile("s_waitcnt vmcnt(0)" ::: "memory");
        }
    }
    __syncthreads();
}

namespace pg8 {
constexpr int BM = 256, BK = 64, HALF = 128, HTB = HALF * BK * 2, STAGE_BYTES = 8 * HTB;
DI int lds_byte(int r, int c) { const int st = (r >> 4) * 2 + (c >> 5), rr = r & 15, cc = c & 31, ob = rr * 64 + cc * 2; return st * 1024 + (ob ^ (((ob >> 9) & 1) << 5)); }
DI void stage_rc(int b, int& R, int& C) { const int st = b / 1024, sb = b % 1024, swz = sb ^ (((sb >> 9) & 1) << 5); R = (st >> 1) * 16 + swz / 64; C = (st & 1) * 32 + (swz % 64) / 2; }
DI int perm32(int rho) { const int n = rho >> 4, i = rho & 15; return 8 * (i >> 2) + 4 * n + (i & 3); }
DI int perm32inv(int c) { return 16 * ((c >> 2) & 1) + 4 * (c >> 3) + (c & 3); }
struct Unit { int pm, pn, ui; };

template <class Epi, class Sched, bool GATHER, bool ALIGN_EPI, bool F8>
DI void gemm_phase(LAS unsigned char* lds, const LAS int* idx_lds, const void* A, const int K, const Sched& S, const Epi& E) {
    const int tid = threadIdx.x, wid = __builtin_amdgcn_readfirstlane(tid >> 6), lane = tid & 63, wr = wid >> 2, wc = wid & 3, fr = lane & 15, fq = lane >> 4;
    const int PB = F8 ? K : 2 * K, nt = PB / 128;
    unsigned voffA[2][2], voffB[2];
    int RA[2], CA[2];
#pragma unroll
    for (int i = 0; i < 2; ++i) { int R, C; stage_rc(tid * 16 + i * 8192, R, C); RA[i] = R; CA[i] = C; voffB[i] = (unsigned)(R * PB + C * 2); }
    const size_t kstep = (size_t)(BK * 2);
    const size_t hstep = (size_t)HALF * PB;
    const unsigned ldsw = (unsigned)wid * 1024u;
    const int aoff = lds_byte(wr * 64 + fr, fq * 8), boff = lds_byte(wc * 32 + fr, fq * 8);
#define PG8_SA(b, h) (((b) * 2 + (h)) * HTB)
#define PG8_SB(b, h) ((4 + (b) * 2 + (h)) * HTB)
#define PG8_STAGE(bufoff, gbase, voff) do { _Pragma("unroll") for (int _i = 0; _i < 2; ++_i) \
        __builtin_amdgcn_global_load_lds((const unsigned*)((const char*)(gbase) + (voff)[_i]), (LAS unsigned*)(lds + (bufoff) + ldsw + _i * 8192), 16, 0, 0); } while (0)
#define PG8_LDA(dst, b, h) do { _Pragma("unroll") for (int m = 0; m < 4; ++m) _Pragma("unroll") for (int k = 0; k < 2; ++k) dst[m][k] = *(const LAS bf16x8*)(lds + PG8_SA(b, h) + aoff + m * 2048 + k * 1024); } while (0)
#define PG8_LDB(dst, b, h) do { _Pragma("unroll") for (int n = 0; n < 2; ++n) _Pragma("unroll") for (int k = 0; k < 2; ++k) dst[n][k] = *(const LAS bf16x8*)(lds + PG8_SB(b, h) + boff + n * 2048 + k * 1024); } while (0)
#define PG8_MMA(ai, bj, At, Bt) do { __builtin_amdgcn_s_setprio(1); _Pragma("unroll") for (int m = 0; m < 4; ++m) _Pragma("unroll") for (int n = 0; n < 2; ++n) { \
        if constexpr (F8) acc[ai][bj][m][n] = __builtin_amdgcn_mfma_scale_f32_16x16x128_f8f6f4( \
            __builtin_shufflevector(__builtin_bit_cast(i32x4, Bt[n][0]), __builtin_bit_cast(i32x4, Bt[n][1]), 0, 1, 2, 3, 4, 5, 6, 7), \
            __builtin_shufflevector(__builtin_bit_cast(i32x4, At[m][0]), __builtin_bit_cast(i32x4, At[m][1]), 0, 1, 2, 3, 4, 5, 6, 7), acc[ai][bj][m][n], 0, 0, 0, 0x7f7f7f7f, 0, 0x7f7f7f7f); \
        else { _Pragma("unroll") for (int k = 0; k < 2; ++k) acc[ai][bj][m][n] = __builtin_amdgcn_mfma_f32_16x16x32_bf16(Bt[n][k], At[m][k], acc[ai][bj][m][n], 0, 0, 0); } } \
        __builtin_amdgcn_s_setprio(0); } while (0)
#define PG8_WAIT_V(n) asm volatile("s_waitcnt vmcnt(" #n ")" ::: "memory")
#define PG8_WAIT_L(n) asm volatile("s_waitcnt lgkmcnt(" #n ")" ::: "memory")
#define PG8_BAR __builtin_amdgcn_s_barrier()
#define PG8_SCHED __builtin_amdgcn_sched_barrier(0)
#define PG8_SETA(ui_, u_) do { _Pragma("unroll") for (int _h = 0; _h < 2; ++_h) _Pragma("unroll") for (int _i = 0; _i < 2; ++_i) { \
        const int _row = GATHER ? idx_lds[(ui_) * 256 + _h * 128 + RA[_i]] : (u_).pm * 256 + _h * 128 + RA[_i]; voffA[_h][_i] = (unsigned)(_row * PB + CA[_i] * 2); } } while (0)
    Unit cur, nxt; int ui = 0;
    if (!S.next(0, cur)) return;
    f32x4 acc[2][2][4][2];
#pragma unroll
    for (int a = 0; a < 2; ++a)
#pragma unroll
        for (int b = 0; b < 2; ++b)
#pragma unroll
            for (int m = 0; m < 4; ++m)
#pragma unroll
                for (int n = 0; n < 2; ++n) acc[a][b][m][n] = (f32x4){0.f, 0.f, 0.f, 0.f};
    bf16x8 At[4][2], B0[2][2], B1[2][2];
    const char* const Ab = (const char*)A;
    const char* cB = S.bptr(cur);
    PG8_SETA(0, cur);
    PG8_STAGE(PG8_SB(0, 0), cB, voffB); PG8_STAGE(PG8_SB(0, 1), cB + hstep, voffB); PG8_STAGE(PG8_SA(0, 0), Ab, voffA[0]); PG8_STAGE(PG8_SA(0, 1), Ab, voffA[1]);
    if (wr == 1) PG8_BAR;
    PG8_WAIT_V(2); PG8_BAR;
    PG8_STAGE(PG8_SB(1, 0), cB + kstep, voffB); PG8_STAGE(PG8_SA(1, 0), Ab + kstep, voffA[0]); PG8_STAGE(PG8_SB(1, 1), cB + hstep + kstep, voffB);
    PG8_WAIT_V(6); PG8_BAR;
    for (;;) {
        const bool has_next = S.next(ui + 1, nxt);
        const char* nB = has_next ? S.bptr(nxt) : cB;
        for (int t = 0; t < nt; t += 2) {
            const bool last = (t == nt - 2);
            const char* a1 = Ab + (size_t)(t + 1) * kstep;
            const char* a2 = last ? Ab : Ab + (size_t)(t + 2) * kstep; const char* b2 = last ? nB : cB + (size_t)(t + 2) * kstep;
            const char* a3 = a2 + kstep; const char* b3 = b2 + kstep;
            PG8_LDB(B0, 0, 0); PG8_LDB(B1, 0, 1); PG8_SCHED; PG8_LDA(At, 0, 0); PG8_STAGE(PG8_SA(1, 1), a1, voffA[1]);
            if (last && has_next) PG8_SETA(ui + 1, nxt);
            PG8_WAIT_V(8); PG8_WAIT_L(0); PG8_BAR; PG8_MMA(0, 0, At, B0); PG8_MMA(0, 1, At, B1); PG8_BAR; PG8_SCHED;
            PG8_LDA(At, 0, 1); PG8_STAGE(PG8_SB(0, 0), b2, voffB); PG8_STAGE(PG8_SB(0, 1), b2 + hstep, voffB); PG8_STAGE(PG8_SA(0, 0), a2, voffA[0]);
            PG8_WAIT_V(8); PG8_WAIT_L(0); PG8_BAR; PG8_MMA(1, 0, At, B0); PG8_MMA(1, 1, At, B1); PG8_BAR; PG8_SCHED;
            PG8_LDB(B0, 1, 0); PG8_LDB(B1, 1, 1); PG8_SCHED; PG8_LDA(At, 1, 0); PG8_STAGE(PG8_SA(0, 1), a2, voffA[1]);
            PG8_WAIT_V(8); PG8_WAIT_L(0); PG8_BAR; PG8_MMA(0, 0, At, B0); PG8_MMA(0, 1, At, B1); PG8_BAR; PG8_SCHED;
            PG8_LDA(At, 1, 1); PG8_STAGE(PG8_SB(1, 0), b3, voffB); PG8_STAGE(PG8_SB(1, 1), b3 + hstep, voffB); PG8_STAGE(PG8_SA(1, 0), a3, voffA[0]);
            PG8_WAIT_V(8); PG8_WAIT_L(0); PG8_BAR; PG8_MMA(1, 0, At, B0); PG8_MMA(1, 1, At, B1); PG8_BAR; PG8_SCHED;
        }
        if constexpr (ALIGN_EPI) { if (wr == 0) PG8_BAR; }
        cur.ui = ui;
        if constexpr (!Epi::AFTER_DRAIN) E(acc, cur, wr, wc, fr, fq);
        if (!has_next) break;
#pragma unroll
        for (int a = 0; a < 2; ++a)
#pragma unroll
            for (int b = 0; b < 2; ++b)
#pragma unroll
                for (int m = 0; m < 4; ++m)
#pragma unroll
                    for (int n = 0; n < 2; ++n) acc[a][b][m][n] = (f32x4){0.f, 0.f, 0.f, 0.f};
        cur = nxt; cB = nB; ++ui;
        if constexpr (ALIGN_EPI) { if (wr == 1) PG8_BAR; }
    }
    PG8_WAIT_V(0);
    if constexpr (!ALIGN_EPI) { if (wr == 0) PG8_BAR; }
    PG8_BAR;
    if constexpr (Epi::AFTER_DRAIN) E.fused(acc, cur, wr, wc, fr, fq, lds);
#undef PG8_SA
#undef PG8_SB
#undef PG8_STAGE
#undef PG8_LDA
#undef PG8_LDB
#undef PG8_MMA
#undef PG8_WAIT_V
#undef PG8_WAIT_L
#undef PG8_BAR
#undef PG8_SCHED
#undef PG8_SETA
}

struct DenseOrder {
    int nM, nN, nwg, G, c; const bf16_t* Bt; int K;
    DI void init(int M_, int N_, int G_, int c_, const bf16_t* Bt_, int K_) { nM = M_ / BM; nN = N_ / BM; nwg = nM * nN; G = G_; c = c_; Bt = Bt_; K = K_; }
    DI bool next(int i, Unit& u) const {
        const long L = (long)i * G + c; if (L >= nwg) return false;
        int wgid = (int)L; { const int q = nwg / 8, r = nwg % 8, xcd = wgid % 8, off = wgid / 8; wgid = (xcd < r ? xcd * (q + 1) : r * (q + 1) + (xcd - r) * q) + off; }
        const int nig = 8 * nN, gid = wgid / nig, fm = gid * 8, gsz = (nM - fm) < 8 ? (nM - fm) : 8;
        u.pm = fm + ((wgid % nig) % gsz); u.pn = (wgid % nig) / gsz; return true;
    }
    DI const char* bptr(const Unit& u) const { return (const char*)(Bt + (size_t)u.pn * BM * K); }
};

struct DenseOrder8 : DenseOrder { DI const char* bptr(const Unit& u) const { return (const char*)Bt + (size_t)u.pn * BM * K; } };

struct EpiQKV {
    static constexpr bool AFTER_DRAIN = false;
    bf16_t *Q, *Kb, *Vb; const float *qg, *kg;
    DI void operator()(const f32x4 (&acc)[2][2][4][2], const Unit& u, int wr, int wc, int fr, int fq) const {
        const int pn = u.pn; bf16_t* base; int ld; const float* g; float sc;
        if (pn < 4) { base = Q + (pn * 4 + wc) * 64; ld = 1024; g = qg; sc = 0.125f * LOG2E; }
        else if (pn == 4) { base = Kb + wc * 64; ld = 256; g = kg; sc = 1.f; }
        else { base = Vb + wc * 64; ld = 256; g = kg; sc = 0.f; }
        f32x4 gv[2][2];
#pragma unroll
        for (int bj = 0; bj < 2; ++bj)
#pragma unroll
            for (int n = 0; n < 2; ++n) { gv[bj][n] = *(const f32x4*)(g + 32 * bj + 8 * fq + 4 * n) * sc; if (pn == 5) gv[bj][n] = (f32x4){1.f, 1.f, 1.f, 1.f}; }
#pragma unroll
        for (int ai = 0; ai < 2; ++ai)
#pragma unroll
            for (int m = 0; m < 4; ++m) {
                const int row = u.pm * BM + ai * HALF + wr * 64 + m * 16 + fr;
                float ss = 0.f;
#pragma unroll
                for (int bj = 0; bj < 2; ++bj)
#pragma unroll
                    for (int n = 0; n < 2; ++n) { const f32x4 x = acc[ai][bj][m][n]; ss += (x[0] * x[0] + x[1] * x[1]) + (x[2] * x[2] + x[3] * x[3]); }
                ss += __shfl_xor(ss, 16); ss += __shfl_xor(ss, 32);
                const float rinv = (pn == 5) ? 0.0625f : __builtin_amdgcn_rsqf(ss * (1.f / 64.f) + RMS_EPS);
#pragma unroll
                for (int bj = 0; bj < 2; ++bj) {
                    const f32x4 v0 = acc[ai][bj][m][0] * rinv * gv[bj][0], v1 = acc[ai][bj][m][1] * rinv * gv[bj][1];
                    u32x4 w; w.x = cvt_pk_bf16(v0[0], v0[1]); w.y = cvt_pk_bf16(v0[2], v0[3]); w.z = cvt_pk_bf16(v1[0], v1[1]); w.w = cvt_pk_bf16(v1[2], v1[3]);
                    *(u32x4*)(base + (size_t)row * ld + 32 * bj + 8 * fq) = w; }
            }
    }
};
template <bool RB, bool OB> struct EpiRes {
    static constexpr bool AFTER_DRAIN = false;
    const void* resid; void* out; int ldc; float cscale;
    DI void operator()(const f32x4 (&acc)[2][2][4][2], const Unit& u, int wr, int wc, int fr, int fq) const {
        const int row0 = u.pm * BM + wr * 64 + fr, col0 = u.pn * BM + wc * 32 + 4 * fq;
#pragma unroll
        for (int ai = 0; ai < 2; ++ai)
#pragma unroll
          for (int mp = 0; mp < 4; mp += 2) {
            f32x4 rr[2][2][2];
#pragma unroll
            for (int m = 0; m < 2; ++m) { const size_t off = (size_t)(row0 + ai * HALF + (mp + m) * 16) * ldc + col0;
#pragma unroll
                for (int bj = 0; bj < 2; ++bj)
#pragma unroll
                    for (int n = 0; n < 2; ++n) {
                        if constexpr (RB) { const u32x2 w = *(const u32x2*)((const bf16_t*)resid + off + bj * HALF + n * 16);
                            rr[m][bj][n] = (f32x4){__builtin_bit_cast(float, w.x << 16), __builtin_bit_cast(float, w.x & 0xffff0000u), __builtin_bit_cast(float, w.y << 16), __builtin_bit_cast(float, w.y & 0xffff0000u)}; }
                        else rr[m][bj][n] = *(const f32x4*)((const float*)resid + off + bj * HALF + n * 16); } }
#pragma unroll
            for (int m = 0; m < 2; ++m) { const size_t off = (size_t)(row0 + ai * HALF + (mp + m) * 16) * ldc + col0;
#pragma unroll
                for (int bj = 0; bj < 2; ++bj)
#pragma unroll
                    for (int n = 0; n < 2; ++n) { const f32x4 o = rr[m][bj][n] + acc[ai][bj][mp + m][n] * cscale;
                        if constexpr (OB) { u32x2 w; w.x = cvt_pk_bf16(o[0], o[1]); w.y = cvt_pk_bf16(o[2], o[3]); *(u32x2*)((bf16_t*)out + off + bj * HALF + n * 16) = w; }
                        else *(f32x4*)((float*)out + off + bj * HALF + n * 16) = o; } }
            asm volatile("" ::: "memory"); }
    }
};
template <bool RB> struct EpiResRoute {
    static constexpr bool AFTER_DRAIN = true;
    const void* resid; bf16_t* X1; unsigned char* XG8; float* part; const float* g; const float* Wr; float cscale;
    DI void operator()(const f32x4 (&)[2][2][4][2], const Unit&, int, int, int, int) const {}
    DI void fused(f32x4 (&acc)[2][2][4][2], const Unit& u, int wr, int wc, int fr, int fq, LAS unsigned char* lds) const {
        const int tid = threadIdx.x;
        LAS unsigned short* WH = (LAS unsigned short*)lds;
        LAS unsigned short* WL = WH + 16 * 256;
        LAS float* RED = (LAS float*)(lds + 16384);
#pragma unroll
        for (int i = 0; i < 2; ++i) { const int idx = tid + i * 512, c = idx >> 2, e4 = idx & 3; const int col = u.pn * BM + c;
            const f32x4 w = *(const f32x4*)(Wr + (size_t)col * NE + 4 * e4) * g[col];
#pragma unroll
            for (int q = 0; q < 4; ++q) { const unsigned hb = f2bf(w[q]); const float lo = w[q] - __builtin_bit_cast(float, hb << 16);
                WH[(4 * e4 + q) * 256 + c] = (unsigned short)hb; WL[(4 * e4 + q) * 256 + c] = (unsigned short)f2bf(lo); } }
        const int row0 = u.pm * BM + wr * 64 + fr, col0 = u.pn * BM + wc * 32 + 4 * fq;
        f32x4 gc[2][2];
#pragma unroll
        for (int bj = 0; bj < 2; ++bj)
#pragma unroll
            for (int n = 0; n < 2; ++n) gc[bj][n] = *(const f32x4*)(g + col0 + bj * HALF + n * 16);
#pragma unroll
        for (int ai = 0; ai < 2; ++ai)
#pragma unroll
          for (int mp = 0; mp < 4; mp += 2) {
            f32x4 rr[2][2][2];
#pragma unroll
            for (int m = 0; m < 2; ++m) { const size_t off = (size_t)(row0 + ai * HALF + (mp + m) * 16) * D + col0;
#pragma unroll
                for (int bj = 0; bj < 2; ++bj)
#pragma unroll
                    for (int n = 0; n < 2; ++n) {
                        if constexpr (RB) { const u32x2 w = *(const u32x2*)((const bf16_t*)resid + off + bj * HALF + n * 16);
                            rr[m][bj][n] = (f32x4){__builtin_bit_cast(float, w.x << 16), __builtin_bit_cast(float, w.x & 0xffff0000u), __builtin_bit_cast(float, w.y << 16), __builtin_bit_cast(float, w.y & 0xffff0000u)}; }
                        else rr[m][bj][n] = *(const f32x4*)((const float*)resid + off + bj * HALF + n * 16); } }
#pragma unroll
            for (int m = 0; m < 2; ++m) { const size_t off = (size_t)(row0 + ai * HALF + (mp + m) * 16) * D + col0;
#pragma unroll
                for (int bj = 0; bj < 2; ++bj)
#pragma unroll
                    for (int n = 0; n < 2; ++n) { const f32x4 o = rr[m][bj][n] + acc[ai][bj][mp + m][n] * cscale; acc[ai][bj][mp + m][n] = o;
                        u32x2 w; w.x = cvt_pk_bf16(o[0], o[1]); w.y = cvt_pk_bf16(o[2], o[3]); *(u32x2*)(X1 + off + bj * HALF + n * 16) = w;
                        const f32x4 og = o * gc[bj][n]; *(unsigned*)(XG8 + off + bj * HALF + n * 16) = pk4_fp8(og[0], og[1], og[2], og[3]); } }
            asm volatile("" ::: "memory"); }
        __syncthreads();
#pragma unroll
        for (int ai = 0; ai < 2; ++ai)
#pragma unroll
            for (int m = 0; m < 4; ++m) { float ssl = 0.f;
#pragma unroll
                for (int bj = 0; bj < 2; ++bj)
#pragma unroll
                    for (int n = 0; n < 2; ++n) { const f32x4 x = acc[ai][bj][m][n]; ssl += (x[0] * x[0] + x[1] * x[1]) + (x[2] * x[2] + x[3] * x[3]); }
                ssl += __shfl_xor(ssl, 16); ssl += __shfl_xor(ssl, 32);
                if (fq == 0) RED[((ai * HALF + wr * 64 + m * 16 + fr) * 4 + wc) * 17 + 16] = ssl; }
        bf16x8 bh[2], bl[2];
#pragma unroll
        for (int bj = 0; bj < 2; ++bj) { const int cb = bj * HALF + wc * 32 + 4 * fq;
            const u32x2 h0 = *(const LAS u32x2*)(WH + fr * 256 + cb), h1 = *(const LAS u32x2*)(WH + fr * 256 + cb + 16), l0 = *(const LAS u32x2*)(WL + fr * 256 + cb), l1 = *(const LAS u32x2*)(WL + fr * 256 + cb + 16);
            bh[bj] = __builtin_bit_cast(bf16x8, (u32x4){h0.x, h0.y, h1.x, h1.y}); bl[bj] = __builtin_bit_cast(bf16x8, (u32x4){l0.x, l0.y, l1.x, l1.y}); }
#pragma unroll
        for (int ai = 0; ai < 2; ++ai)
#pragma unroll
            for (int m = 0; m < 4; ++m) { f32x4 lg = (f32x4){0.f, 0.f, 0.f, 0.f};
#pragma unroll
                for (int bj = 0; bj < 2; ++bj) { const f32x4 x0 = acc[ai][bj][m][0], x1v = acc[ai][bj][m][1];
                    u32x4 hi, lo; float r[8] = {x0[0], x0[1], x0[2], x0[3], x1v[0], x1v[1], x1v[2], x1v[3]};
#pragma unroll
                    for (int q = 0; q < 4; ++q) { const unsigned h2 = cvt_pk_bf16(r[2 * q], r[2 * q + 1]); hi[q] = h2;
                        lo[q] = cvt_pk_bf16(r[2 * q] - __builtin_bit_cast(float, h2 << 16), r[2 * q + 1] - __builtin_bit_cast(float, h2 & 0xffff0000u)); }
                    const bf16x8 ah = __builtin_bit_cast(bf16x8, hi), al = __builtin_bit_cast(bf16x8, lo);
                    lg = __builtin_amdgcn_mfma_f32_16x16x32_bf16(ah, bh[bj], lg, 0, 0, 0);
                    lg = __builtin_amdgcn_mfma_f32_16x16x32_bf16(al, bh[bj], lg, 0, 0, 0);
                    lg = __builtin_amdgcn_mfma_f32_16x16x32_bf16(ah, bl[bj], lg, 0, 0, 0); }
#pragma unroll
                for (int j = 0; j < 4; ++j) RED[((ai * HALF + wr * 64 + m * 16 + 4 * fq + j) * 4 + wc) * 17 + fr] = lg[j]; }
        __syncthreads();
        for (int idx = tid; idx < 256 * 17; idx += 512) { const int e17 = idx >> 8, row = idx & 255;
            const float v = (RED[(row * 4 + 0) * 17 + e17] + RED[(row * 4 + 1) * 17 + e17]) + (RED[(row * 4 + 2) * 17 + e17] + RED[(row * 4 + 3) * 17 + e17]);
            part[(size_t)(u.pn * 17 + e17) * M + u.pm * BM + row] = v; }
    }
};
struct EpiSwiGLU {
    static constexpr bool AFTER_DRAIN = false;
    unsigned char* H; const LAS float* rsl;
    DI void operator()(const f32x4 (&acc)[2][2][4][2], const Unit& u, int wr, int wc, int fr, int fq) const {
        const int row0 = u.pm * BM + wr * 64 + fr, col = u.pn * 128 + wc * 32 + 8 * fq;
        float rsv[2][4];
#pragma unroll
        for (int ai = 0; ai < 2; ++ai)
#pragma unroll
            for (int m = 0; m < 4; ++m) rsv[ai][m] = rsl[u.ui * 256 + ai * HALF + wr * 64 + m * 16 + fr] * 0.0625f;
#pragma unroll
        for (int ai = 0; ai < 2; ++ai)
#pragma unroll
            for (int m = 0; m < 4; ++m) {
                float hv[8]; const float rs = rsv[ai][m];
#pragma unroll
                for (int n = 0; n < 2; ++n)
#pragma unroll
                    for (int j = 0; j < 4; ++j) { const float a = acc[ai][0][m][n][j] * rs, uu = acc[ai][1][m][n][j] * rs;
                        const float hh = a * __builtin_amdgcn_rcpf(1.f + __builtin_amdgcn_exp2f(-a * LOG2E)) * uu; hv[4 * n + j] = fminf(fmaxf(hh, -448.f), 448.f); }
                u32x2 w; w.x = pk4_fp8(hv[0], hv[1], hv[2], hv[3]); w.y = pk4_fp8(hv[4], hv[5], hv[6], hv[7]);
                *(u32x2*)(H + (size_t)(row0 + ai * HALF + m * 16) * DE + col) = w;
            }
    }
};
struct EpiBf16 {
    static constexpr bool AFTER_DRAIN = false;
    bf16_t* O; int ldc; const float* rowscale; float cscale;
    DI void operator()(const f32x4 (&acc)[2][2][4][2], const Unit& u, int wr, int wc, int fr, int fq) const {
        const int row0 = u.pm * BM + wr * 64 + fr, col0 = u.pn * BM + wc * 32 + 8 * fq;
#pragma unroll
        for (int ai = 0; ai < 2; ++ai)
#pragma unroll
            for (int m = 0; m < 4; ++m) { const int row = row0 + ai * HALF + m * 16; const float sc = rowscale ? rowscale[row] * cscale : cscale;
#pragma unroll
                for (int bj = 0; bj < 2; ++bj) { const f32x4 v0 = acc[ai][bj][m][0] * sc, v1 = acc[ai][bj][m][1] * sc;
                    u32x4 w; w.x = cvt_pk_bf16(v0[0], v0[1]); w.y = cvt_pk_bf16(v0[2], v0[3]); w.z = cvt_pk_bf16(v1[0], v1[1]); w.w = cvt_pk_bf16(v1[2], v1[3]);
                    *(u32x4*)(O + (size_t)row * ldc + col0 + bj * HALF) = w; } }
    }
};
struct MoeUpOrder {
    int vcu, G; const char* W;
    DI bool next(int i, Unit& u) const { const int L = i * G + vcu; if (L >= 2048) return false; const int ii = L >> 8, v = L & 255, x = v >> 5, j = v & 31, e = 2 * ii + (x >> 2);
        u.pm = 8 * e + (j & 7); u.pn = 4 * (x & 3) + (j >> 3); return true; }
    DI const char* bptr(const Unit& u) const { return W + (size_t)(u.pm >> 3) * 4096 * 1024 + (size_t)u.pn * BM * 1024; }
};
struct MoeDownOrder {
    int vcu, G; const char* W;
    DI bool next(int i, Unit& u) const { const int L = i * G + vcu; if (L >= 512) return false; const int ii = L >> 8, v = L & 255, x = v >> 5, j = v & 31, e = 8 * ii + x;
        u.pm = 8 * e + (j & 7); u.pn = j >> 3; return true; }
    DI const char* bptr(const Unit& u) const { return W + (size_t)(u.pm >> 3) * 1024 * 2048 + (size_t)u.pn * BM * 2048; }
};
}

struct Args { const float* in[19]; float* out; unsigned char* ws; int ph_lo, ph_hi; };
struct Frame {
    LAS unsigned char* lds; volatile LAS unsigned* MISC; unsigned* ctl;
    int tid, lane, wave, vcu, G;
};
enum { IN_X = 0, IN_RELB, IN_ANG, IN_AWIN, IN_AQG, IN_AKG, IN_ASINK, IN_AWOUT, IN_MNG, IN_MWIN, IN_MBI, IN_MBF, IN_MOG, IN_MWOUT, IN_FNG, IN_RW, IN_W1, IN_W3, IN_W2 };

DI void conv_item(const float* W, int ldw, int cbase, bf16_t* dst, int K, int drow0, int k0, bool perm, float scale, LAS float* scr, int lane) {
#pragma unroll 8
    for (int i = 0; i < 32; ++i) { const int kk = 2 * i + (lane >> 5); scr[kk * 33 + (lane & 31)] = W[(size_t)(k0 + kk) * ldw + cbase + (lane & 31)]; }
    LDS_WAIT(); asm volatile("" ::: "memory");
    const int c = lane & 7;
#pragma unroll
    for (int j = 0; j < 4; ++j) { const int n = (lane >> 3) + 8 * j; const LAS float* s = scr + (8 * c) * 33 + n;
        u32x4 o; o.x = pk2(s[0 * 33] * scale, s[1 * 33] * scale); o.y = pk2(s[2 * 33] * scale, s[3 * 33] * scale); o.z = pk2(s[4 * 33] * scale, s[5 * 33] * scale); o.w = pk2(s[6 * 33] * scale, s[7 * 33] * scale);
        const int rho = perm ? pg8::perm32inv(n) : n;
        *(u32x4*)(dst + (size_t)(drow0 + rho) * K + k0 + 8 * c) = o; }
    LDS_WAIT(); asm volatile("" ::: "memory");
}
DI void conv_item8(const float* W, int ldw, int cbase, unsigned char* dst, int K, int drow0, int k0, float scale, LAS float* scr, int lane, bool perm = true) {
    const int a = lane >> 3, b = lane & 7;
    f32x4 v[16];
#pragma unroll
    for (int i = 0; i < 16; ++i) v[i] = __builtin_nontemporal_load((const f32x4*)(W + (size_t)(k0 + 8 * i + a) * ldw + cbase + 4 * b));
#pragma unroll
    for (int i = 0; i < 16; ++i) { const int k = 8 * i + a; LAS float* d = scr + k * 33 + 4 * (k >> 4) + 4 * b; d[0] = v[i].x; d[1] = v[i].y; d[2] = v[i].z; d[3] = v[i].w; }
    LDS_WAIT(); asm volatile("" ::: "memory");
    const int c = lane & 7;
#pragma unroll
    for (int j = 0; j < 4; ++j) { const int n = (lane >> 3) + 8 * j; const LAS float* s = scr + (16 * c) * 33 + 4 * c + n;
        u32x4 o;
#pragma unroll
        for (int q = 0; q < 4; ++q) o[q] = pk4_fp8(s[(4 * q) * 33] * scale, s[(4 * q + 1) * 33] * scale, s[(4 * q + 2) * 33] * scale, s[(4 * q + 3) * 33] * scale);
        __builtin_nontemporal_store(o, (u32x4*)(dst + (size_t)(drow0 + (perm ? pg8::perm32inv(n) : n)) * K + k0 + 16 * c)); }
    LDS_WAIT(); asm volatile("" ::: "memory");
}
DI void rms_row_to_bf16(const float* xrow, const float* g, bf16_t* orow, int lane) {
    const f32x4* xr = (const f32x4*)xrow + lane; const f32x4* gr = (const f32x4*)g + lane;
    f32x4 v[4]; float s = 0.f;
#pragma unroll
    for (int j = 0; j < 4; ++j) { v[j] = xr[64 * j]; s += (v[j].x * v[j].x + v[j].y * v[j].y) + (v[j].z * v[j].z + v[j].w * v[j].w); }
    const float rinv = __builtin_amdgcn_rsqf(wave_sum(s) * (1.f / D) + RMS_EPS);
    unsigned long long* o8 = (unsigned long long*)orow + lane;
#pragma unroll
    for (int j = 0; j < 4; ++j) { const f32x4 gg = gr[64 * j]; const f32x4 y = v[j] * rinv * gg;
        o8[64 * j] = (unsigned long long)pk2(y.x, y.y) | ((unsigned long long)pk2(y.z, y.w) << 32); }
}
constexpr int XI_PER_LE = 1536, XI_TOTAL = 32 * XI_PER_LE;
constexpr int XI_NA = 128 * NWAVES * 6, XI_NB = 192 * NWAVES * 6, XI_NC = 192 * NWAVES * 5, XI_ND = 128 * NWAVES * 16;
constexpr int XI_PRO_END = XI_TOTAL - XI_NA - XI_NB - XI_NC - XI_ND, XI_A_END = XI_PRO_END + XI_NA, XI_B_END = XI_A_END + XI_NB, XI_C_END = XI_TOTAL - XI_ND;
static_assert(XI_B_END >= XI_TOTAL / 2, "the slots after MoE layer 0 may only hold layer-1 items");
DI void expert_conv_items(Frame& F, const Args& a, int it0, int it1, int rank, int nrank) {
    LAS float* scr8 = (LAS float*)(F.lds + F.wave * 17152);
    unsigned char* ws = a.ws;
    for (int it = it0 + rank; it < it1; it += nrank) {
        const int le = it / XI_PER_LE, r = it % XI_PER_LE;
        if (r < 1024) { const int kb = r / 128, g = r % 128, pn = g >> 3, bj = (g >> 2) & 1, wc = g & 3;
            const float* W = (bj ? a.in[IN_W3] : a.in[IN_W1]) + (size_t)le * D * DE;
            conv_item8(W, DE, 128 * pn + 32 * wc, ws + WS_W13 + (size_t)le * 4096 * D, D, 32 * g, 128 * kb, 16.f, scr8, F.lane);
        } else { const int r2 = r - 1024, kb = r2 / 32, g = r2 % 32;
            conv_item8(a.in[IN_W2] + (size_t)le * DE * D, D, 32 * g, ws + WS_W2 + (size_t)le * D * DE, DE, 32 * g, 128 * kb, 32.f, scr8, F.lane); }
    }
}
DI void rms_row_to_fp8(const float* xrow, const float* g, unsigned char* orow, int lane) {
    const f32x4* xr = (const f32x4*)xrow + lane; const f32x4* gr = (const f32x4*)g + lane;
    f32x4 v[4]; float s = 0.f;
#pragma unroll
    for (int j = 0; j < 4; ++j) { v[j] = xr[64 * j]; s += (v[j].x * v[j].x + v[j].y * v[j].y) + (v[j].z * v[j].z + v[j].w * v[j].w); }
    const float rinv = __builtin_amdgcn_rsqf(wave_sum(s) * (1.f / D) + RMS_EPS);
#pragma unroll
    for (int j = 0; j < 4; ++j) { const f32x4 y = v[j] * rinv * gr[64 * j]; *((unsigned*)orow + lane + 64 * j) = pk4_fp8(y.x, y.y, y.z, y.w); }
}
DI void p0_prologue(Frame& F, const Args& a) {
    LAS float* scr = (LAS float*)(F.lds + F.wave * 17152);
    const int gw = F.vcu * NWAVES + F.wave, NGW = F.G * NWAVES;
    unsigned char* ws = a.ws;
    LAS float* scr8 = (LAS float*)(F.lds + F.wave * 17152);
    constexpr int I_QKV = 8 * 48, I_AO = 8 * 32, I_MIN = 16 * 96, I_MO = 16 * 32, I_SMALL = I_QKV + I_AO + I_MIN + I_MO;
    for (int it = gw; it < I_SMALL; it += NGW) {
        int r = it;
        if (r < I_QKV) { const int kb = r / 48, g = r % 48, pn = g >> 3, bj = (g >> 2) & 1, wc = g & 3;
            conv_item8(a.in[IN_AWIN], NQKV, 256 * pn + 64 * wc + 32 * bj, ws + WS_WQKV, D, 32 * g, 128 * kb, 16.f, scr8, F.lane, true); continue; } r -= I_QKV;
        if (r < I_AO) { const int kb = r / 32, g = r % 32; conv_item8(a.in[IN_AWOUT], D, 32 * g, ws + WS_WAO, D, 32 * g, 128 * kb, 16.f, scr8, F.lane, false); continue; } r -= I_AO;
        if (r < I_MIN) { const int kb = r / 96, g = r % 96; const float sc = (g >= 16 && g < 32) ? 0.125f : 1.f;
            conv_item(a.in[IN_MWIN], MIN_LD, 32 * g, (bf16_t*)(ws + WS_WMIN), D, 32 * g, 64 * kb, true, sc, scr, F.lane); continue; } r -= I_MIN;
        { const int kb = r / 32, g = r % 32; conv_item(a.in[IN_MWOUT], D, 32 * g, (bf16_t*)(ws + WS_WMO), D, 32 * g, 64 * kb, false, 1.f, scr, F.lane); }
    }
    for (int m = gw; m < M; m += NGW) rms_row_to_fp8(a.in[IN_X] + (size_t)m * D, a.in[IN_ANG], ws + WS_XN8 + (size_t)m * D, F.lane);
    expert_conv_items(F, a, 0, XI_PRO_END, gw, NGW);
}

constexpr int AT_K = 0, AT_V = 49152, AT_TB = 98304, AT_TB_COPY = 324, AT_TB_HEAD = 4 * AT_TB_COPY;
DI int t5_bucket_dev(int rel) {
    const int n = rel < 0 ? -rel : rel; int b;
    if (n < 8) b = n; else if (n < 12) b = 8; else if (n < 16) b = 9; else if (n < 23) b = 10; else if (n < 32) b = 11; else if (n < 46) b = 12; else if (n < 64) b = 13; else if (n < 91) b = 14; else b = 15;
    return b + (rel > 0 ? 16 : 0);
}
DI bf16x8 pack_step(const f32x16& x, int s) {
    u32x4 p;
    p.x = cvt_pk_bf16(x[8 * s + 0], x[8 * s + 1]); p.y = cvt_pk_bf16(x[8 * s + 2], x[8 * s + 3]); p.z = cvt_pk_bf16(x[8 * s + 4], x[8 * s + 5]); p.w = cvt_pk_bf16(x[8 * s + 6], x[8 * s + 7]);
    return __builtin_bit_cast(bf16x8, p);
}
typedef short v4i16_t __attribute__((ext_vector_type(4)));
DI s16x4 tr_read(const LAS unsigned char* p) { return __builtin_bit_cast(s16x4, __builtin_amdgcn_ds_read_tr16_b64_v4i16((LAS v4i16_t*)p)); }
DI bf16x8 cat8(s16x4 lo, s16x4 hi) { return __builtin_shufflevector(lo, hi, 0, 1, 2, 3, 4, 5, 6, 7); }

DI void attn_phase(Frame& F, const Args& a) {
    LAS unsigned char* lds = F.lds;
    const bf16_t* Qg = (const bf16_t*)(a.ws + WS_Q); const bf16_t* Kg = (const bf16_t*)(a.ws + WS_K); const bf16_t* Vg = (const bf16_t*)(a.ws + WS_V); unsigned char* Og = a.ws + WS_O;
    const float* relb = a.in[IN_RELB]; const float* sink = a.in[IN_ASINK];
    const int lane = F.lane, wave = F.wave, r = lane & 31, h = lane >> 5;
    const int g = wave >> 1, half = wave & 1;
    LAS float* TB = (LAS float*)(lds + AT_TB);
    constexpr int NPF = 6;
    u32x4 kvr[NPF];
#define AT_LOAD(u_) do { const int qb_ = (u_) & 31, kvh_ = ((u_) >> 5) & 3, b_ = (u_) >> 7, kb_ = qb_ * 128 - 128; \
        _Pragma("unroll") for (int i = 0; i < NPF; ++i) { const int idx = F.tid + i * NTHR, isv = idx >= 3072, rem = isv ? idx - 3072 : idx, row = rem >> 3, c = rem & 7; int kp = kb_ + row; kp = kp < 0 ? 0 : (kp >= SEQ ? SEQ - 1 : kp); \
            kvr[i] = *(const u32x4*)((isv ? Vg : Kg) + (size_t)(b_ * SEQ + kp) * 256 + kvh_ * 64 + c * 8); } } while (0)
    int tb_kvh = -1;
    if (F.vcu < 512) AT_LOAD(F.vcu);
    for (int u = F.vcu; u < 512; u += F.G) {
        const int qb = u & 31, kvh = (u >> 5) & 3, b = u >> 7;
        const int kbase = qb * 128 - 128;
        __syncthreads();
        if (kvh != tb_kvh) { tb_kvh = kvh;
#pragma unroll 4
            for (int idx = F.tid; idx < 4 * AT_TB_HEAD; idx += NTHR) {
                const int gg = idx / AT_TB_HEAD, rem = idx % AT_TB_HEAD, c = rem / AT_TB_COPY, i = rem % AT_TB_COPY, rel = i + c - 160;
                float v = -__builtin_inff();
                if (rel >= -128 && rel <= 128) v = relb[t5_bucket_dev(rel) * 16 + kvh * 4 + gg] * LOG2E;
                TB[idx] = v;
            } }
        u32x4 late[12 - NPF];
#pragma unroll
        for (int i = NPF; i < 12; ++i) { const int idx = F.tid + i * NTHR, isv = idx >= 3072, rem = isv ? idx - 3072 : idx, row = rem >> 3, c = rem & 7; int kp = kbase + row; kp = kp < 0 ? 0 : (kp >= SEQ ? SEQ - 1 : kp);
            late[i - NPF] = *(const u32x4*)((isv ? Vg : Kg) + (size_t)(b * SEQ + kp) * 256 + kvh * 64 + c * 8); }
#pragma unroll
        for (int i = 0; i < 12; ++i) { const int idx = F.tid + i * NTHR, isv = idx >= 3072, rem = isv ? idx - 3072 : idx, row = rem >> 3, c = rem & 7;
            const int pos = isv ? (c ^ (((row >> 1) & 1) << 2)) : (c ^ ((row >> 1) & 7));
            *(LAS u32x4*)(lds + (isv ? AT_V : AT_K) + row * 128 + pos * 16) = i < NPF ? kvr[i] : late[i < NPF ? 0 : i - NPF]; }
        if (u + F.G < 512) AT_LOAD(u + F.G);
        const int head = kvh * 4 + g, qw0 = qb * 128 + 64 * half;
        bf16x8 qf[2][4];
#pragma unroll
        for (int qt = 0; qt < 2; ++qt)
#pragma unroll
            for (int s = 0; s < 4; ++s) qf[qt][s] = *(const bf16x8*)(Qg + (size_t)(b * SEQ + qw0 + 32 * qt + r) * 1024 + head * 64 + 16 * s + 8 * h);
        __syncthreads();
        const float sk = sink[head] * LOG2E;
        float mrun[2] = {sk, sk}, lrun[2] = {h == 0 ? 1.f : 0.f, h == 0 ? 1.f : 0.f};
        f32x16 o[2][2];
#pragma unroll
        for (int qt = 0; qt < 2; ++qt)
#pragma unroll
            for (int dt = 0; dt < 2; ++dt)
#pragma unroll
                for (int i = 0; i < 16; ++i) o[qt][dt][i] = 0.f;
        const int cpy = (4 - (r & 3)) & 3;
        const LAS float* tbl = TB + g * AT_TB_HEAD + cpy * AT_TB_COPY + (32 + 4 * h - r - cpy);
        const int q4 = (lane & 15) >> 2, p4 = lane & 3, blk = (lane >> 4) & 1;
        for (int T = 2 * half; T < 2 * half + 10; ++T) {
            const int kp0 = kbase + 32 * T;
            if (kp0 < 0 || kp0 >= SEQ) continue;
            bf16x8 kf[4];
            { const int row = 32 * T + r;
#pragma unroll
              for (int s = 0; s < 4; ++s) kf[s] = *(const LAS bf16x8*)(lds + AT_K + row * 128 + (((2 * s + h) ^ ((row >> 1) & 7)) << 4)); }
            bf16x8 vf[2][2];
#pragma unroll
            for (int dt = 0; dt < 2; ++dt)
#pragma unroll
                for (int s = 0; s < 2; ++s) {
                    const int row0 = 32 * T + 16 * s + 4 * h + q4, row1 = row0 + 8, cb = 64 * dt + 32 * blk + 8 * p4;
                    const s16x4 lo = tr_read(lds + AT_V + row0 * 128 + (cb ^ (((row0 >> 1) & 1) << 6)));
                    const s16x4 hi = tr_read(lds + AT_V + row1 * 128 + (cb ^ (((row1 >> 1) & 1) << 6)));
                    vf[dt][s] = cat8(lo, hi);
                }
#pragma unroll
            for (int qt = 0; qt < 2; ++qt) {
                const int kt = T - 2 * half - qt;
                if (kt < 0 || kt > 8) continue;
                f32x16 sacc;
#pragma unroll
                for (int G4 = 0; G4 < 4; ++G4) { const f32x4 t = *(const LAS f32x4*)(tbl + 32 * kt + 8 * G4);
                    sacc[4 * G4 + 0] = t[0]; sacc[4 * G4 + 1] = t[1]; sacc[4 * G4 + 2] = t[2]; sacc[4 * G4 + 3] = t[3]; }
#pragma unroll
                for (int s = 0; s < 4; ++s) sacc = __builtin_amdgcn_mfma_f32_32x32x16_bf16(kf[s], qf[qt][s], sacc, 0, 0, 0);
                float mx = sacc[0];
#pragma unroll
                for (int i = 1; i < 16; ++i) mx = fmaxf(mx, sacc[i]);
                mx = fmaxf(mx, __shfl_xor(mx, 32));
                const float mnew = fmaxf(mrun[qt], mx), alpha = __builtin_amdgcn_exp2f(mrun[qt] - mnew);
                mrun[qt] = mnew;
                float ls = 0.f;
#pragma unroll
                for (int i = 0; i < 16; ++i) { sacc[i] = __builtin_amdgcn_exp2f(sacc[i] - mnew); ls += sacc[i]; }
                lrun[qt] = lrun[qt] * alpha + ls;
#pragma unroll
                for (int dt = 0; dt < 2; ++dt)
#pragma unroll
                    for (int i = 0; i < 16; ++i) o[qt][dt][i] *= alpha;
                const bf16x8 p0 = pack_step(sacc, 0), p1 = pack_step(sacc, 1);
#pragma unroll
                for (int dt = 0; dt < 2; ++dt) {
                    o[qt][dt] = __builtin_amdgcn_mfma_f32_32x32x16_bf16(vf[dt][0], p0, o[qt][dt], 0, 0, 0);
                    o[qt][dt] = __builtin_amdgcn_mfma_f32_32x32x16_bf16(vf[dt][1], p1, o[qt][dt], 0, 0, 0);
                }
            }
        }
#pragma unroll
        for (int qt = 0; qt < 2; ++qt) {
            const float lt = lrun[qt] + __shfl_xor(lrun[qt], 32), inv = 16.f / lt;
            unsigned char* orow = Og + (size_t)(b * SEQ + qw0 + 32 * qt + r) * 1024 + head * 64;
#pragma unroll
            for (int dt = 0; dt < 2; ++dt)
#pragma unroll
                for (int G4 = 0; G4 < 4; ++G4)
                    *(unsigned*)(orow + 32 * dt + 8 * G4 + 4 * h) = pk4_fp8(o[qt][dt][4 * G4] * inv, o[qt][dt][4 * G4 + 1] * inv, o[qt][dt][4 * G4 + 2] * inv, o[qt][dt][4 * G4 + 3] * inv);
        }
    }
#undef AT_LOAD
}

template <int N> DI int multi_reduce(float (&v)[N], int lane) {
    int idx = 0;
#pragma unroll
    for (int bit = 32, cnt = N / 2; cnt >= 1; bit >>= 1, cnt >>= 1) {
        const bool upper = (lane & bit) != 0;
#pragma unroll
        for (int i = 0; i < cnt; ++i) { const float lo = v[i], hi = v[i + cnt]; const float send = upper ? lo : hi, keep = upper ? hi : lo; v[i] = keep + __shfl_xor(send, bit); }
        idx |= upper ? cnt : 0;
    }
#pragma unroll
    for (int bit = 32 / N; bit >= 1; bit >>= 1) v[0] += __shfl_xor(v[0], bit);
    return idx;
}
DI float log_sigmoid(float x) { return x < 0.f ? x - log1pf(expf(x)) : -log1pf(expf(-x)); }
DI void add_routed_rows(f32x4 (&x)[4], const bf16_t* Y, int sl, int b, int lane) {
    unsigned long long mask = __ballot(sl >= 0);
    while (mask) {
        const bf16_t* yr[4]; float wq[4];
#pragma unroll
        for (int q = 0; q < 4; ++q) { const bool v = mask != 0ull; const int e = v ? __builtin_ctzll(mask) : 0; if (v) mask &= mask - 1;
            const int sv = __builtin_amdgcn_readlane(sl, e); wq[q] = v ? 1.f : 0.f;
            yr[q] = (v || q == 0) ? Y + (size_t)((e * NB + b) * CAP + sv) * D : yr[0]; }
        u32x2 w[4][4];
#pragma unroll
        for (int q = 0; q < 4; ++q)
#pragma unroll
            for (int j = 0; j < 4; ++j) w[q][j] = __builtin_nontemporal_load((const u32x2*)yr[q] + lane + 64 * j);
#pragma unroll
        for (int q = 0; q < 4; ++q)
#pragma unroll
            for (int j = 0; j < 4; ++j) { x[j].x += wq[q] * __builtin_bit_cast(float, w[q][j].x << 16); x[j].y += wq[q] * __builtin_bit_cast(float, w[q][j].x & 0xffff0000u);
                x[j].z += wq[q] * __builtin_bit_cast(float, w[q][j].y << 16); x[j].w += wq[q] * __builtin_bit_cast(float, w[q][j].y & 0xffff0000u); }
    }
}
template <int NEV, bool COMBINE>
DI void nr_phase(Frame& F, const bf16_t* base, const bf16_t* Y, const int* slot, bf16_t* xout, const float* g, bf16_t* XN, unsigned char* XN8,
                 const float* Wsrc, int ldw, int col0, float* outv, const float* b_i, const float* b_f) {
    LAS float* Wt = (LAS float*)F.lds;
    { f32x4 wv[NEV / 2];
#pragma unroll
      for (int i = 0; i < NEV / 2; ++i) { const int idx = F.tid + i * NTHR, d = idx / (NEV / 4), e4 = idx % (NEV / 4); wv[i] = *(const f32x4*)(Wsrc + (size_t)d * ldw + col0 + 4 * e4); }
#pragma unroll
      for (int i = 0; i < NEV / 2; ++i) { const int idx = F.tid + i * NTHR, d = idx / (NEV / 4), e4 = idx % (NEV / 4);
#pragma unroll
          for (int q = 0; q < 4; ++q) Wt[(4 * e4 + q) * 1024 + d] = wv[i][q]; } }
    const int gw = F.vcu * NWAVES + F.wave, NGW = F.G * NWAVES, lane = F.lane;
    LAS float* res = (LAS float*)(F.lds + AUX_OFF) + F.wave * 64;
    f32x4 gg[4];
#pragma unroll
    for (int j = 0; j < 4; ++j) gg[j] = *((const f32x4*)g + lane + 64 * j);
    __syncthreads();
#pragma unroll 1
    for (int m0 = gw; m0 < M; m0 += 4 * NGW) {
        f32x4 x[4][4]; int sl[4];
#pragma unroll
        for (int t4 = 0; t4 < 4; ++t4) { const int m = m0 + t4 * NGW < M ? m0 + t4 * NGW : m0;
#pragma unroll
            for (int j = 0; j < 4; ++j) { const u32x2 w = __builtin_nontemporal_load((const u32x2*)(base + (size_t)m * D) + lane + 64 * j);
                x[t4][j] = (f32x4){__builtin_bit_cast(float, w.x << 16), __builtin_bit_cast(float, w.x & 0xffff0000u), __builtin_bit_cast(float, w.y << 16), __builtin_bit_cast(float, w.y & 0xffff0000u)}; }
            sl[t4] = (COMBINE && lane < NE) ? slot[(size_t)m * NE + lane] : -1; }
#pragma unroll
        for (int pp = 0; pp < 4; pp += 2) {
            int mm[2]; float ssv[2];
#pragma unroll
            for (int u = 0; u < 2; ++u) {
                const int t4 = pp + u; const int m = m0 + t4 * NGW < M ? m0 + t4 * NGW : m0; mm[u] = m;
                if (COMBINE) add_routed_rows(x[t4], Y, sl[t4], m / SEQ, lane);
                if (xout) {
#pragma unroll
                    for (int j = 0; j < 4; ++j) { u32x2 w; w.x = cvt_pk_bf16(x[t4][j].x, x[t4][j].y); w.y = cvt_pk_bf16(x[t4][j].z, x[t4][j].w); *((u32x2*)(xout + (size_t)m * D) + lane + 64 * j) = w;
                        x[t4][j] = (f32x4){__builtin_bit_cast(float, w.x << 16), __builtin_bit_cast(float, w.x & 0xffff0000u), __builtin_bit_cast(float, w.y << 16), __builtin_bit_cast(float, w.y & 0xffff0000u)}; }
                }
                float ss = 0.f;
#pragma unroll
                for (int j = 0; j < 4; ++j) ss += (x[t4][j].x * x[t4][j].x + x[t4][j].y * x[t4][j].y) + (x[t4][j].z * x[t4][j].z + x[t4][j].w * x[t4][j].w);
                const float sst = wave_sum(ss); ssv[u] = sst;
                const float rinv = NEV == 16 ? 1.f : __builtin_amdgcn_rsqf(sst * (1.f / D) + RMS_EPS);
#pragma unroll
                for (int j = 0; j < 4; ++j) { x[t4][j] = x[t4][j] * rinv * gg[j];
                    if (NEV == 32) *((unsigned long long*)(XN + (size_t)m * D) + lane + 64 * j) = (unsigned long long)pk2(x[t4][j].x, x[t4][j].y) | ((unsigned long long)pk2(x[t4][j].z, x[t4][j].w) << 32);
                    else *((unsigned*)(XN8 + (size_t)m * D) + lane + 64 * j) = pk4_fp8(x[t4][j].x, x[t4][j].y, x[t4][j].z, x[t4][j].w); }
            }
#pragma unroll 1
            for (int eg = 0; eg < NEV / 4; ++eg) {
                float v8[8];
#pragma unroll
                for (int e4 = 0; e4 < 4; ++e4) { float s0 = 0.f, s1 = 0.f;
#pragma unroll
                    for (int j = 0; j < 4; ++j) { const f32x4 w = *((const LAS f32x4*)(Wt + (4 * eg + e4) * 1024) + lane + 64 * j);
                        s0 += (x[pp][j].x * w.x + x[pp][j].y * w.y) + (x[pp][j].z * w.z + x[pp][j].w * w.w); s1 += (x[pp + 1][j].x * w.x + x[pp + 1][j].y * w.y) + (x[pp + 1][j].z * w.z + x[pp + 1][j].w * w.w); }
                    v8[e4] = s0; v8[4 + e4] = s1; }
                const int i8 = multi_reduce<8>(v8, lane);
                if ((lane & 7) == 0) res[(i8 >> 2) * 32 + 4 * eg + (i8 & 3)] = v8[0];
            }
            asm volatile("s_waitcnt lgkmcnt(0)" ::: "memory");
            if (NEV == 16) {
                const int u = (lane >> 4) & 1, e = lane & 15, m = mm[u];
                if (lane < 32) { outv[(size_t)e * M + m] = res[u * 32 + e]; if (e == 0) outv[(size_t)16 * M + m] = ssv[u]; }
#pragma unroll
                for (int q = 0; q < 2; ++q) { const int idx = lane + 64 * q; if (idx < 102) { const int uu = idx / 51, r51 = idx % 51; outv[(size_t)(17 + r51) * M + mm[uu]] = 0.f; } }
            } else {
                const int u = lane >> 5, k = lane & 31, m = mm[u];
                const float v = res[u * 32 + k];
                const int kind = k >> 3, hd = k & 7, dir = kind >> 1;
                outv[(size_t)m * 32 + k] = (kind & 1) ? log_sigmoid(v + b_f[dir * 8 + hd]) : v + b_i[dir * 8 + hd];
            }
            asm volatile("" ::: "memory");
        }
    }
}
constexpr int NRM_WB = 0, NRM_WB_LD = 2128, NRM_XR = 32 * NRM_WB_LD, NRM_XR_LD = 2112;
static_assert(NRM_XR + NWAVES * 4 * NRM_XR_LD <= AUX_OFF + AUX_BYTES, "nrm_phase LDS");
DI void nrm_phase(Frame& F, const bf16_t* base, const bf16_t* Y, const int* slot, bf16_t* xout, const float* g, bf16_t* XN,
                  const float* Wsrc, int ldw, int col0, float* outv, const float* b_i, const float* b_f) {
    LAS unsigned char* lds = F.lds;
    { f32x4 wv[16];
#pragma unroll
      for (int i = 0; i < 16; ++i) { const int idx = F.tid + i * NTHR, d = idx >> 3, e4 = idx & 7; wv[i] = *(const f32x4*)(Wsrc + (size_t)d * ldw + col0 + 4 * e4); }
#pragma unroll
      for (int i = 0; i < 16; ++i) { const int idx = F.tid + i * NTHR, d = idx >> 3, e4 = idx & 7;
#pragma unroll
          for (int q = 0; q < 4; ++q) *(LAS unsigned short*)(lds + NRM_WB + (4 * e4 + q) * NRM_WB_LD + d * 2) = (unsigned short)f2bf(wv[i][q]); } }
    const int gw = F.vcu * NWAVES + F.wave, NGW = F.G * NWAVES, lane = F.lane, fr = lane & 15, fq = lane >> 4;
    LAS unsigned char* xr = lds + NRM_XR + F.wave * 4 * NRM_XR_LD;
    f32x4 gg[4];
#pragma unroll
    for (int j = 0; j < 4; ++j) gg[j] = *((const f32x4*)g + lane + 64 * j);
    float bias[2]; bool isf[2];
#pragma unroll
    for (int n = 0; n < 2; ++n) { const int k = fr + 16 * n, kind = k >> 3, hd = k & 7, dir = kind >> 1; isf[n] = (kind & 1) != 0; bias[n] = isf[n] ? b_f[dir * 8 + hd] : b_i[dir * 8 + hd]; }
    __syncthreads();
#pragma unroll 1
    for (int m0 = gw; m0 < M; m0 += 4 * NGW) {
        f32x4 x[4][4]; int sl[4]; int mm[4];
#pragma unroll
        for (int t4 = 0; t4 < 4; ++t4) { const int m = m0 + t4 * NGW < M ? m0 + t4 * NGW : m0; mm[t4] = m;
#pragma unroll
            for (int j = 0; j < 4; ++j) { const u32x2 w = __builtin_nontemporal_load((const u32x2*)(base + (size_t)m * D) + lane + 64 * j);
                x[t4][j] = (f32x4){__builtin_bit_cast(float, w.x << 16), __builtin_bit_cast(float, w.x & 0xffff0000u), __builtin_bit_cast(float, w.y << 16), __builtin_bit_cast(float, w.y & 0xffff0000u)}; }
            sl[t4] = lane < NE ? slot[(size_t)m * NE + lane] : -1; }
#pragma unroll
        for (int t4 = 0; t4 < 4; ++t4) { const int m = mm[t4];
            add_routed_rows(x[t4], Y, sl[t4], m / SEQ, lane);
#pragma unroll
            for (int j = 0; j < 4; ++j) { u32x2 w; w.x = cvt_pk_bf16(x[t4][j].x, x[t4][j].y); w.y = cvt_pk_bf16(x[t4][j].z, x[t4][j].w); *((u32x2*)(xout + (size_t)m * D) + lane + 64 * j) = w;
                x[t4][j] = (f32x4){__builtin_bit_cast(float, w.x << 16), __builtin_bit_cast(float, w.x & 0xffff0000u), __builtin_bit_cast(float, w.y << 16), __builtin_bit_cast(float, w.y & 0xffff0000u)}; }
            float ss = 0.f;
#pragma unroll
            for (int j = 0; j < 4; ++j) ss += (x[t4][j].x * x[t4][j].x + x[t4][j].y * x[t4][j].y) + (x[t4][j].z * x[t4][j].z + x[t4][j].w * x[t4][j].w);
            const float rinv = __builtin_amdgcn_rsqf(wave_sum(ss) * (1.f / D) + RMS_EPS);
#pragma unroll
            for (int j = 0; j < 4; ++j) { const f32x4 hn = x[t4][j] * rinv * gg[j]; u32x2 w; w.x = cvt_pk_bf16(hn.x, hn.y); w.y = cvt_pk_bf16(hn.z, hn.w);
                *((u32x2*)(XN + (size_t)m * D) + lane + 64 * j) = w; *(LAS u32x2*)(xr + t4 * NRM_XR_LD + (4 * lane + 256 * j) * 2) = w; }
        }
        asm volatile("s_waitcnt lgkmcnt(0)" ::: "memory");
        f32x4 ga[2] = {(f32x4){0.f, 0.f, 0.f, 0.f}, (f32x4){0.f, 0.f, 0.f, 0.f}};
#pragma unroll 4
        for (int ks = 0; ks < 32; ++ks) {
            bf16x8 a = (bf16x8){0, 0, 0, 0, 0, 0, 0, 0};
            if (fr < 4) a = *(const LAS bf16x8*)(xr + fr * NRM_XR_LD + (32 * ks + 8 * fq) * 2);
            const bf16x8 b0 = *(const LAS bf16x8*)(lds + NRM_WB + fr * NRM_WB_LD + (32 * ks + 8 * fq) * 2), b1 = *(const LAS bf16x8*)(lds + NRM_WB + (16 + fr) * NRM_WB_LD + (32 * ks + 8 * fq) * 2);
            ga[0] = __builtin_amdgcn_mfma_f32_16x16x32_bf16(a, b0, ga[0], 0, 0, 0); ga[1] = __builtin_amdgcn_mfma_f32_16x16x32_bf16(a, b1, ga[1], 0, 0, 0);
        }
        if (fq == 0) {
#pragma unroll
            for (int n = 0; n < 2; ++n)
#pragma unroll
                for (int j = 0; j < 4; ++j) { const float v = ga[n][j] + bias[n]; outv[(size_t)mm[j] * 32 + fr + 16 * n] = isf[n] ? log_sigmoid(v) : v; } }
        asm volatile("" ::: "memory");
    }
}
DI int block_excl_scan(int v, LAS int* wsum, int lane, int wave, int& total) {
    int inc = v;
#pragma unroll
    for (int o = 1; o < 64; o <<= 1) { const int t = __shfl_up(inc, o); if (lane >= o) inc += t; }
    if (lane == 63) wsum[wave] = inc;
    __syncthreads();
    int basev = 0, tot = 0;
#pragma unroll
    for (int w = 0; w < NWAVES; ++w) { const int x = wsum[w]; basev += (w < wave) ? x : 0; tot += x; }
    __syncthreads();
    total = tot;
    return basev + inc - v;
}
DI void topk_phase(Frame& F, const float* part, int* idxrow, float* gate, float* rsc, int* slot) {
    LAS unsigned* hist = (LAS unsigned*)F.lds; LAS unsigned* sh = hist + 4096; LAS int* wsum = (LAS int*)(hist + 4112);
    const int tid = F.tid;
    for (int p = blockIdx.x; p < NB * NE; p += F.G) {
        const int b = p / NE, e = p % NE;
        unsigned v[8]; float rinv8[8];
        { const float* pb = part + (size_t)b * SEQ + 8 * tid;
          float ssum[8], mx[8], sm[8], lm[8];
#pragma unroll
          for (int i = 0; i < 8; ++i) { ssum[i] = 0.f; mx[i] = -__builtin_inff(); sm[i] = 0.f; lm[i] = 0.f; }
#pragma unroll
          for (int pn = 0; pn < 4; ++pn) { const f32x4 a0 = *(const f32x4*)(pb + (size_t)(pn * 17 + 16) * M), a1 = *(const f32x4*)(pb + (size_t)(pn * 17 + 16) * M + 4);
#pragma unroll
              for (int i = 0; i < 4; ++i) { ssum[i] += a0[i]; ssum[4 + i] += a1[i]; } }
#pragma unroll
          for (int i = 0; i < 8; ++i) rinv8[i] = __builtin_amdgcn_rsqf(ssum[i] * (1.f / D) + RMS_EPS);
#pragma unroll 4
          for (int ee = 0; ee < NE; ++ee) { float l[8];
#pragma unroll
              for (int i = 0; i < 8; ++i) l[i] = 0.f;
#pragma unroll
              for (int pn = 0; pn < 4; ++pn) { const f32x4 a0 = *(const f32x4*)(pb + (size_t)(pn * 17 + ee) * M), a1 = *(const f32x4*)(pb + (size_t)(pn * 17 + ee) * M + 4);
#pragma unroll
                  for (int i = 0; i < 4; ++i) { l[i] += a0[i]; l[4 + i] += a1[i]; } }
#pragma unroll
              for (int i = 0; i < 8; ++i) { const float li = l[i] * rinv8[i], mn = fmaxf(mx[i], li); sm[i] = sm[i] * __expf(mx[i] - mn) + __expf(li - mn); mx[i] = mn; lm[i] = ee == e ? li : lm[i]; } }
#pragma unroll
          for (int i = 0; i < 8; ++i) v[i] = __builtin_bit_cast(unsigned, __expf(lm[i] - mx[i]) / sm[i]); }
        unsigned prefix = 0u; int need = CAP;
#pragma unroll 1
        for (int pass = 0; pass < 3; ++pass) {
            const int shift = pass == 0 ? 20 : (pass == 1 ? 8 : 0), hs = pass == 0 ? 31 : (pass == 1 ? 20 : 8);
            *((LAS u32x4*)hist + 2 * tid) = (u32x4){0u, 0u, 0u, 0u}; *((LAS u32x4*)hist + 2 * tid + 1) = (u32x4){0u, 0u, 0u, 0u};
            __syncthreads();
#pragma unroll
            for (int i = 0; i < 8; ++i) if (pass == 0 || (v[i] >> hs) == prefix) __hip_atomic_fetch_add(&hist[(v[i] >> shift) & (pass == 2 ? 0xffu : 0xfffu)], 1u, __ATOMIC_RELAXED, __HIP_MEMORY_SCOPE_WORKGROUP);
            __syncthreads();
            const u32x4 c0 = *((const LAS u32x4*)hist + 2 * tid), c1 = *((const LAS u32x4*)hist + 2 * tid + 1);
            const int cnt[8] = {(int)c0.x, (int)c0.y, (int)c0.z, (int)c0.w, (int)c1.x, (int)c1.y, (int)c1.z, (int)c1.w};
            const int ls = ((cnt[0] + cnt[1]) + (cnt[2] + cnt[3])) + ((cnt[4] + cnt[5]) + (cnt[6] + cnt[7]));
            int tot; const int pre = block_excl_scan(ls, wsum, F.lane, F.wave, tot);
            int run = tot - pre - ls;
#pragma unroll
            for (int j = 7; j >= 0; --j) { if (run < need && run + cnt[j] >= need) { sh[0] = (unsigned)(8 * tid + j); sh[1] = (unsigned)(need - run); } run += cnt[j]; }
            __syncthreads();
            prefix = pass == 0 ? sh[0] : ((prefix << (pass == 1 ? 12 : 8)) | sh[0]); need = (int)sh[1];
        }
        const unsigned T = prefix;
        int ce = 0;
#pragma unroll
        for (int i = 0; i < 8; ++i) ce += (v[i] == T) ? 1 : 0;
        int tot;
        int eqr = block_excl_scan(ce, wsum, F.lane, F.wave, tot);
        unsigned selm = 0u; int cs = 0;
#pragma unroll
        for (int i = 0; i < 8; ++i) { bool sel = v[i] > T; if (v[i] == T) { sel = eqr < need; ++eqr; } if (sel) { selm |= 1u << i; ++cs; } }
        int pos = block_excl_scan(cs, wsum, F.lane, F.wave, tot);
#pragma unroll
        for (int i = 0; i < 8; ++i) { const int t = 8 * tid + i; int sv = -1;
            if (selm & (1u << i)) { const int row = (e * NB + b) * CAP + pos; idxrow[row] = b * SEQ + t; gate[row] = __builtin_bit_cast(float, v[i]); rsc[row] = rinv8[i]; sv = pos; ++pos; }
            slot[(size_t)(b * SEQ + t) * NE + e] = sv; }
        __syncthreads();
    }
}
DI void combine_phase(Frame& F, const bf16_t* base, const bf16_t* Y, const int* slot, float* out) {
    const int gw = F.vcu * NWAVES + F.wave, NGW = F.G * NWAVES, lane = F.lane;
    for (int m0 = gw; m0 < M; m0 += 4 * NGW) {
        f32x4 x[4][4]; int sl[4];
#pragma unroll
        for (int t4 = 0; t4 < 4; ++t4) { const int m = m0 + t4 * NGW < M ? m0 + t4 * NGW : m0;
#pragma unroll
            for (int j = 0; j < 4; ++j) { const u32x2 w = __builtin_nontemporal_load((const u32x2*)(base + (size_t)m * D) + lane + 64 * j);
                x[t4][j] = (f32x4){__builtin_bit_cast(float, w.x << 16), __builtin_bit_cast(float, w.x & 0xffff0000u), __builtin_bit_cast(float, w.y << 16), __builtin_bit_cast(float, w.y & 0xffff0000u)}; }
            sl[t4] = lane < NE ? slot[(size_t)m * NE + lane] : -1; }
#pragma unroll
        for (int t4 = 0; t4 < 4; ++t4) { const int m = m0 + t4 * NGW < M ? m0 + t4 * NGW : m0;
            add_routed_rows(x[t4], Y, sl[t4], m / SEQ, lane);
#pragma unroll
            for (int j = 0; j < 4; ++j) __builtin_nontemporal_store(x[t4][j], (f32x4*)(out + (size_t)m * D) + lane + 64 * j); }
    }
}
DI void moe_up_phase(Frame& F, unsigned char* ws, int l) {
    pg8::MoeUpOrder S{F.vcu, F.G, (const char*)(ws + WS_W13 + (size_t)l * W13_LAYER)};
    LAS int* il = (LAS int*)(F.lds + AUX_OFF); const int* idxrow = (const int*)(ws + WS_IDX);
    pg8::Unit u;
    LAS float* rl = (LAS float*)(F.lds + AUX_OFF + 8192); const float* rsc = (const float*)(ws + WS_RSC);
    for (int i = 0; i < 8 && S.next(i, u); ++i) { if (F.tid < 256) il[i * 256 + F.tid] = idxrow[u.pm * 256 + F.tid]; else rl[i * 256 + F.tid - 256] = rsc[u.pm * 256 + F.tid - 256]; }
    __syncthreads();
    pg8::EpiSwiGLU E{(unsigned char*)(ws + WS_H), rl};
    pg8::gemm_phase<pg8::EpiSwiGLU, pg8::MoeUpOrder, true, true, true>(F.lds, il, (const void*)(ws + WS_XN8), D, S, E);
}
DI void moe_down_phase(Frame& F, unsigned char* ws, int l) {
    pg8::MoeDownOrder S{F.vcu, F.G, (const char*)(ws + WS_W2 + (size_t)l * W2_LAYER)};
    pg8::EpiBf16 E{(bf16_t*)(ws + WS_Y), D, (const float*)(ws + WS_GATE), 0.03125f};
    pg8::gemm_phase<pg8::EpiBf16, pg8::MoeDownOrder, false, true, true>(F.lds, nullptr, (const void*)(ws + WS_H), DE, S, E);
}

DI int off128r(int row, int chunk) { return row * 128 + ((chunk ^ ((row >> 1) & 7)) << 4); }
DI int off128t(int row, int colbyte) { return row * 128 + (colbyte ^ (((row >> 1) & 1) << 6)); }
DI int off256t(int row, int colbyte) { return row * 256 + (colbyte ^ ((row & 3) << 6)); }
DI float wave_max(float v) {
#pragma unroll
    for (int o = 1; o < 64; o <<= 1) v = fmaxf(v, __shfl_xor(v, o));
    return v;
}
DI float incl_prefix(float v, int lane) {
#pragma unroll
    for (int o = 1; o < 64; o <<= 1) { const float t = __shfl_up(v, o); if (lane >= o) v += t; }
    return v;
}
DI float incl_suffix(float v, int lane) {
#pragma unroll
    for (int o = 1; o < 64; o <<= 1) { const float t = __shfl_down(v, o); if (lane + o < 64) v += t; }
    return v;
}
DI u32x4 scale_bf16x8(u32x4 v, float w) {
    u32x4 o;
#pragma unroll
    for (int i = 0; i < 4; ++i) { const float lo = __builtin_bit_cast(float, v[i] << 16) * w, hi = __builtin_bit_cast(float, v[i] & 0xffff0000u) * w; o[i] = cvt_pk_bf16(lo, hi); }
    return o;
}
constexpr int SS_KW = 0, SS_V = 32768, SS_WS = 98304, SS_SC = 114688;
DI int ss_kw_off(int row, int colbyte) { return row * 128 + (colbyte ^ ((((row >> 1) & 1) | (((row >> 3) & 1) << 1)) << 5)); }
DI int ss_v_off(int row, int colbyte) { return row * 256 + (colbyte ^ ((row & 3) << 6) ^ (((row >> 3) & 1) << 5)); }
template <int ES> DI void mlstm_scan_seq(Frame& F, unsigned char* ws, int seq, int half) {
    constexpr int NT = 4 / ES, VB = 16384 / ES; const int eoff = half * (128 / ES);
    LAS unsigned char* lds = F.lds;
    const bf16_t* P = (const bf16_t*)(ws + WS_PROJ); const float* MG = (const float*)(ws + WS_MG);
    bf16_t* STATE = (bf16_t*)(ws + WS_STATE); float* NST = (float*)(ws + WS_NST); float* MST = (float*)(ws + WS_MST);
    const int tid = F.tid, lane = F.lane, wave = F.wave, fr = lane & 15, fq = lane >> 4;
    LAS float* WS = (LAS float*)(lds + SS_WS); LAS float* ML = (LAS float*)(lds + SS_SC); LAS float* BL = ML + 64; LAS float* DEC = ML + 128; LAS float* LINJ = ML + 192; LAS float* MENT = ML + 256;
    {
        const int dir = seq >> 5, bh = seq & 31, b = bh >> 3, hd = bh & 7;
        __syncthreads();
        float igv[8], lfv[8];
#pragma unroll
        for (int i = 0; i < 8; ++i) { const float* mg = MG + ((size_t)b * SEQ + 64 * (8 * wave + i) + lane) * 32 + hd; igv[i] = mg[dir ? 16 : 0]; lfv[i] = mg[dir ? 24 : 8]; }
#pragma unroll
        for (int i = 0; i < 8; ++i) { const int c = 8 * wave + i; const float ig = igv[i], lf = lfv[i];
            float g, bl;
            if (dir == 0) { const float bf = incl_prefix(lf, lane); bl = __shfl(bf, 63); g = bl - bf + ig; }
            else { const float sb = incl_suffix(lf, lane); bl = __shfl(sb, 0); g = (bl - sb) + ig; }
            const float ml = wave_max(g);
            WS[c * 64 + lane] = g - ml; if (lane == 0) { ML[c] = ml; BL[c] = bl; } }
        __syncthreads();
        if (wave == 0) { const int cl = dir ? 63 - lane : lane; const float mlv = ML[cl], blv = BL[cl];
            float m = 0.f, dec = 0.f, linj = 0.f, ment = 0.f;
            for (int k = 0; k < 64; ++k) { const float ml = __shfl(mlv, k), bl = __shfl(blv, k); const float mn = fmaxf(bl + m, ml);
                if (lane == k) { dec = __expf(bl + m - mn); linj = ml - mn; ment = m; } m = mn; }
            DEC[lane] = dec; LINJ[cl] = linj; MENT[lane] = ment;
            if (half == 0) MST[(size_t)seq * 64 + cl] = ment; }
        __syncthreads();
#pragma unroll
        for (int i = 0; i < 8; ++i) { const int idx = tid + i * NTHR; WS[idx] = __expf(WS[idx] + LINJ[idx >> 6]); }
        const int krow = tid >> 3, kc = tid & 7;
        const int eh = wave >> 2, dt = wave & 3;
        f32x4 C[NT], Nacc = (f32x4){0.f, 0.f, 0.f, 0.f};
#pragma unroll
        for (int i = 0; i < NT; ++i) C[i] = (f32x4){0.f, 0.f, 0.f, 0.f};
        const bf16x8 ones = (bf16x8){0x3f80, 0x3f80, 0x3f80, 0x3f80, 0x3f80, 0x3f80, 0x3f80, 0x3f80};
        const size_t tokb = (size_t)b * SEQ;
        u32x4 kreg[2][2], vreg[2][2][2 / ES];
#define SS_LOAD(st_, kp_) do { _Pragma("unroll") for (int sb_ = 0; sb_ < 2; ++sb_) { const int kk_ = 2 * (kp_) + sb_; const int cn_ = dir ? 63 - kk_ : kk_; \
            kreg[st_][sb_] = *(const u32x4*)(P + (tokb + 64 * cn_ + krow) * MIN_N + 512 + hd * 64 + kc * 8); \
            _Pragma("unroll") for (int i_ = 0; i_ < 2 / ES; ++i_) { const int idx_ = tid + i_ * NTHR, vr_ = ES == 1 ? idx_ >> 4 : idx_ >> 3, vc_ = ES == 1 ? idx_ & 15 : idx_ & 7; \
                vreg[st_][sb_][i_] = *(const u32x4*)(P + (tokb + 64 * cn_ + vr_) * MIN_N + 1024 + hd * 128 + eoff + vc_ * 8); } } } while (0)
#define SS_PAIR(st, kp) do { const int buf = (kp) & 1; \
            _Pragma("unroll") for (int sb = 0; sb < 2; ++sb) { const int k = 2 * (kp) + sb, c = dir ? 63 - k : k; \
                *(LAS u32x4*)(lds + SS_KW + (buf * 2 + sb) * 8192 + ss_kw_off(krow, kc * 16)) = scale_bf16x8(kreg[st][sb], WS[c * 64 + krow]); \
                _Pragma("unroll") for (int i = 0; i < 2 / ES; ++i) { const int idx = tid + i * NTHR; \
                    *(LAS u32x4*)(lds + SS_V + (buf * 2 + sb) * VB + (ES == 1 ? ss_v_off(idx >> 4, (idx & 15) * 16) : ss_kw_off(idx >> 3, (idx & 7) * 16))) = vreg[st][sb][i]; } } \
            if ((kp) + 2 < 32) SS_LOAD(st, (kp) + 2); \
            asm volatile("s_waitcnt lgkmcnt(0)" ::: "memory"); __builtin_amdgcn_s_barrier(); asm volatile("" ::: "memory"); \
            _Pragma("unroll") for (int sb = 0; sb < 2; ++sb) { const int k = 2 * (kp) + sb, c = dir ? 63 - k : k; \
                _Pragma("unroll") for (int i = 0; i < NT; ++i) { u32x2 w; w.x = cvt_pk_bf16(C[i].x, C[i].y); w.y = cvt_pk_bf16(C[i].z, C[i].w); \
                    *(u32x2*)(STATE + ((size_t)seq * 64 + c) * 8192 + (size_t)(eoff + 16 * (eh + 2 * i) + fr) * 64 + 16 * dt + 4 * fq) = w; } \
                if (half == 0 && eh == 0 && fr == 0) *(f32x4*)(NST + ((size_t)seq * 64 + c) * 64 + 16 * dt + 4 * fq) = Nacc; \
                const float dec = DEC[k]; Nacc = Nacc * dec; \
                _Pragma("unroll") for (int i = 0; i < NT; ++i) C[i] = C[i] * dec; \
                _Pragma("unroll") for (int s2 = 0; s2 < 2; ++s2) { \
                    const int r0 = 32 * s2 + 8 * fq + ((lane & 15) >> 2), r1 = r0 + 4, cbk = 32 * dt + 8 * (lane & 3); \
                    const bf16x8 af = cat8(tr_read(lds + SS_KW + (buf * 2 + sb) * 8192 + ss_kw_off(r0, cbk)), tr_read(lds + SS_KW + (buf * 2 + sb) * 8192 + ss_kw_off(r1, cbk))); \
                    _Pragma("unroll") for (int i = 0; i < NT; ++i) { const int cbv = 32 * (eh + 2 * i) + 8 * (lane & 3); \
                        const bf16x8 bfv = cat8(tr_read(lds + SS_V + (buf * 2 + sb) * VB + (ES == 1 ? ss_v_off(r0, cbv) : ss_kw_off(r0, cbv))), tr_read(lds + SS_V + (buf * 2 + sb) * VB + (ES == 1 ? ss_v_off(r1, cbv) : ss_kw_off(r1, cbv)))); \
                        C[i] = __builtin_amdgcn_mfma_f32_16x16x32_bf16(af, bfv, C[i], 0, 0, 0); } \
                    if (eh == 0) Nacc = __builtin_amdgcn_mfma_f32_16x16x32_bf16(af, ones, Nacc, 0, 0, 0); } } } while (0)
        SS_LOAD(0, 0); SS_LOAD(1, 1);
        __syncthreads();
#pragma unroll 1
        for (int kp2 = 0; kp2 < 32; kp2 += 2) { SS_PAIR(0, kp2); SS_PAIR(1, kp2 + 1); }
#undef SS_PAIR
#undef SS_LOAD
    }
}
constexpr int SCAN_ES = 2, SCAN_WGS = 64 * SCAN_ES, SCAN_STRIDE = 256 / SCAN_WGS;
DI void mlstm_scan_phase(Frame& F, const Args& a) {
    if (F.G == 256) {
        if (F.vcu % SCAN_STRIDE == 0) { const int sw = F.vcu / SCAN_STRIDE; mlstm_scan_seq<SCAN_ES>(F, a.ws, sw / SCAN_ES, sw % SCAN_ES); }
        else expert_conv_items(F, a, XI_C_END, XI_TOTAL, ((F.vcu / SCAN_STRIDE) * (SCAN_STRIDE - 1) + F.vcu % SCAN_STRIDE - 1) * NWAVES + F.wave, (256 - SCAN_WGS) * NWAVES);
    } else {
        for (int sw = F.vcu; sw < SCAN_WGS; sw += F.G) mlstm_scan_seq<SCAN_ES>(F, a.ws, sw / SCAN_ES, sw % SCAN_ES);
        if (F.vcu == 0) expert_conv_items(F, a, XI_C_END, XI_TOTAL, F.wave, NWAVES);
    }
}
constexpr int S3_Q = 0, S3_KF = 8192, S3_KB = 16384, S3_V = 24576, S3_CF = 40960, S3_CB = 57344, S3_HS = 73728, S3_HS_LD = 132, S3_SM = 108544;
DI float incl_prefix_max(float v, int lane) {
#pragma unroll
    for (int o = 1; o < 64; o <<= 1) { const float t = __shfl_up(v, o); if (lane >= o) v = fmaxf(v, t); }
    return v;
}
DI float incl_suffix_max(float v, int lane) {
#pragma unroll
    for (int o = 1; o < 64; o <<= 1) { const float t = __shfl_down(v, o); if (lane + o < 64) v = fmaxf(v, t); }
    return v;
}
DI void mlstm_s3_phase(Frame& F, const Args& a) {
    unsigned char* ws = a.ws; LAS unsigned char* lds = F.lds;
    const bf16_t* P = (const bf16_t*)(ws + WS_PROJ); const float* MG = (const float*)(ws + WS_MG);
    const bf16_t* STATE = (const bf16_t*)(ws + WS_STATE); const float* NST = (const float*)(ws + WS_NST); const float* MST = (const float*)(ws + WS_MST);
    bf16_t* Y2 = (bf16_t*)(ws + WS_Y2); const float* outg = a.in[IN_MOG];
    const int tid = F.tid, lane = F.lane, wave = F.wave, r = lane & 31, h = lane >> 5;
    const int q4 = (lane & 15) >> 2, p4 = lane & 3, blk = (lane >> 4) & 1;
    LAS float* ALPHA = (LAS float*)(lds + S3_SM); LAS float* EA = ALPHA + 128; LAS float* EMT = ALPHA + 256; LAS unsigned short* NB16 = (LAS unsigned short*)(ALPHA + 384);
    LAS float* HS = (LAS float*)(lds + S3_HS);
    u32x4 rq, rk, rv[2], rcf[2], rcb[2], rog[2]; float pg[4], pn[2], pm_f = 0.f, pm_b = 0.f;
#define S3_LOAD(u_) do { const int c_ = (u_) & 63, bh_ = (u_) >> 6, b_ = bh_ >> 3, hd_ = bh_ & 7; const size_t tk_ = (size_t)b_ * SEQ + 64 * c_; \
        { const int row = tid >> 3, kc = tid & 7; rq = *(const u32x4*)(P + (tk_ + row) * MIN_N + hd_ * 64 + kc * 8); rk = *(const u32x4*)(P + (tk_ + row) * MIN_N + 512 + hd_ * 64 + kc * 8); } \
        _Pragma("unroll") for (int i = 0; i < 2; ++i) { const int idx = tid + i * NTHR, row = idx >> 4, c16 = idx & 15; \
            rv[i] = *(const u32x4*)(P + (tk_ + row) * MIN_N + 1024 + hd_ * 128 + c16 * 8); \
            rcf[i] = __builtin_nontemporal_load((const u32x4*)(STATE + ((size_t)(0 * 32 + bh_) * 64 + c_) * 8192) + idx); rcb[i] = __builtin_nontemporal_load((const u32x4*)(STATE + ((size_t)(1 * 32 + bh_) * 64 + c_) * 8192) + idx); } \
        { const bf16_t* ogp_ = P + (tk_ + (tid >> 3)) * MIN_N + 2048 + hd_ * 128 + (tid & 7) * 16; rog[0] = *(const u32x4*)ogp_; rog[1] = *(const u32x4*)(ogp_ + 8); } \
        pm_f = MST[(size_t)(0 * 32 + bh_) * 64 + c_]; pm_b = MST[(size_t)(1 * 32 + bh_) * 64 + c_]; \
        { const float* mg = MG + (tk_ + lane) * 32; pg[0] = mg[hd_]; pg[1] = mg[8 + hd_]; pg[2] = mg[16 + hd_]; pg[3] = mg[24 + hd_]; \
          pn[0] = NST[((size_t)(0 * 32 + bh_) * 64 + c_) * 64 + lane]; pn[1] = NST[((size_t)(1 * 32 + bh_) * 64 + c_) * 64 + lane]; } } while (0)
    if (F.vcu < 2048) S3_LOAD(F.vcu);
    for (int u = F.vcu; u < 2048; u += F.G) {
        const int c = u & 63, bh = u >> 6, b = bh >> 3, hd = bh & 7; const size_t tok0 = (size_t)b * SEQ + 64 * c;
        const float m_f = pm_f, m_b = pm_b;
        const float bf = incl_prefix(pg[1], lane), uf = pg[0] - bf, umf = wave_max(uf), cmf = incl_prefix_max(uf, lane);
        const float sb = incl_suffix(pg[3], lane), ub = pg[2] - sb, umb = wave_max(ub), cmb = incl_suffix_max(ub, lane);
        const float beta_f = __expf(uf - umf), beta_b = __expf(ub - umb);
        const float af_ = bf + m_f, mtf = fmaxf(af_, bf + cmf), ab_ = sb + m_b, mtb = fmaxf(ab_, sb + cmb);
        __syncthreads();
        if (wave == 0) { ALPHA[lane] = __expf(bf + umf - mtf); EA[lane] = __expf(af_ - mtf); EMT[lane] = __expf(-mtf);
            ALPHA[64 + lane] = __expf(sb + umb - mtb); EA[64 + lane] = __expf(ab_ - mtb); EMT[64 + lane] = __expf(-mtb);
            NB16[lane] = (unsigned short)f2bf(pn[0]); NB16[64 + lane] = (unsigned short)f2bf(pn[1]); }
        { const int row = tid >> 3, kc = tid & 7; const float wf = __shfl(beta_f, row & 63), wb = __shfl(beta_b, row & 63);
          *(LAS u32x4*)(lds + S3_Q + off128r(row, kc)) = rq;
          *(LAS u32x4*)(lds + S3_KF + off128r(row, kc)) = scale_bf16x8(rk, wf); *(LAS u32x4*)(lds + S3_KB + off128r(row, kc)) = scale_bf16x8(rk, wb); }
#pragma unroll
        for (int i = 0; i < 2; ++i) { const int idx = tid + i * NTHR, row = idx >> 4, c16 = idx & 15, erow = idx >> 3, ec = idx & 7;
            *(LAS u32x4*)(lds + S3_V + off256t(row, c16 * 16)) = rv[i];
            *(LAS u32x4*)(lds + S3_CF + off128r(erow, ec)) = rcf[i]; *(LAS u32x4*)(lds + S3_CB + off128r(erow, ec)) = rcb[i]; }
        const u32x4 og0 = rog[0], og1 = rog[1];
        if (u + F.G < 2048) S3_LOAD(u + F.G);
        __syncthreads();
        const int et = wave >> 1, tt = wave & 1, t = 32 * tt + r;
        bf16x8 qf[4];
#pragma unroll
        for (int s4 = 0; s4 < 4; ++s4) qf[s4] = *(const LAS bf16x8*)(lds + S3_Q + off128r(t, 2 * s4 + h));
        f32x16 pF, pB, pO;
#pragma unroll
        for (int i = 0; i < 16; ++i) { pF[i] = 0.f; pB[i] = 0.f; pO[i] = 0.f; }
        const int so = 1 - tt; const int koff = tt == 0 ? S3_KB : S3_KF;
#pragma unroll
        for (int s4 = 0; s4 < 4; ++s4) {
            const bf16x8 kF = *(const LAS bf16x8*)(lds + S3_KF + off128r(32 * tt + r, 2 * s4 + h)), kB = *(const LAS bf16x8*)(lds + S3_KB + off128r(32 * tt + r, 2 * s4 + h));
            const bf16x8 kO = *(const LAS bf16x8*)(lds + koff + off128r(32 * so + r, 2 * s4 + h));
            pF = __builtin_amdgcn_mfma_f32_32x32x16_bf16(kF, qf[s4], pF, 0, 0, 0);
            pB = __builtin_amdgcn_mfma_f32_32x32x16_bf16(kB, qf[s4], pB, 0, 0, 0);
            pO = __builtin_amdgcn_mfma_f32_32x32x16_bf16(kO, qf[s4], pO, 0, 0, 0);
        }
        float rsF = 0.f, rsB = 0.f, rsO = 0.f;
#pragma unroll
        for (int i = 0; i < 16; ++i) { const int sl_ = (i & 3) + 8 * (i >> 2) + 4 * h;
            pF[i] = sl_ <= r ? pF[i] : 0.f; pB[i] = sl_ >= r ? pB[i] : 0.f; rsF += pF[i]; rsB += pB[i]; rsO += pO[i]; }
        rsF += __shfl_xor(rsF, 32); rsB += __shfl_xor(rsB, 32); rsO += __shfl_xor(rsO, 32);
        if (tt == 0) rsB += rsO; else rsF += rsO;
        asm volatile("" ::: "memory");
        float qnf, qnb;
        {   f32x16 qn;
#pragma unroll
            for (int i = 0; i < 16; ++i) qn[i] = 0.f;
#pragma unroll
            for (int s4 = 0; s4 < 4; ++s4) { const bf16x8 nF = *(const LAS bf16x8*)(NB16 + 16 * s4 + 8 * h); qn = __builtin_amdgcn_mfma_f32_32x32x16_bf16(nF, qf[s4], qn, 0, 0, 0); }
            qnf = qn[0];
#pragma unroll
            for (int i = 0; i < 16; ++i) qn[i] = 0.f;
#pragma unroll
            for (int s4 = 0; s4 < 4; ++s4) { const bf16x8 nB = *(const LAS bf16x8*)(NB16 + 64 + 16 * s4 + 8 * h); qn = __builtin_amdgcn_mfma_f32_32x32x16_bf16(nB, qf[s4], qn, 0, 0, 0); }
            qnb = qn[0]; }
        const float alF = ALPHA[t], eaF = EA[t], emF = EMT[t], alB = ALPHA[64 + t], eaB = EA[64 + t], emB = EMT[64 + t];
        const float invF = 1.f / fmaxf(fabsf(eaF * qnf + alF * rsF), emF), invB = 1.f / fmaxf(fabsf(eaB * qnb + alB * rsB), emB);
        asm volatile("" ::: "memory");
        f32x16 hs;
        const int cbv = 64 * et + 32 * blk + 8 * p4;
        {   f32x16 it, in;
#pragma unroll
            for (int i = 0; i < 16; ++i) { it[i] = 0.f; in[i] = 0.f; }
#pragma unroll
            for (int s4 = 0; s4 < 4; ++s4) { const bf16x8 cF = *(const LAS bf16x8*)(lds + S3_CF + off128r(32 * et + r, 2 * s4 + h)); it = __builtin_amdgcn_mfma_f32_32x32x16_bf16(cF, qf[s4], it, 0, 0, 0); }
#pragma unroll
            for (int s2 = 0; s2 < 2; ++s2) { const int rd0 = 32 * tt + 16 * s2 + 4 * h + q4;
                const bf16x8 vD = cat8(tr_read(lds + S3_V + off256t(rd0, cbv)), tr_read(lds + S3_V + off256t(rd0 + 8, cbv)));
                in = __builtin_amdgcn_mfma_f32_32x32x16_bf16(vD, pack_step(pF, s2), in, 0, 0, 0);
                if (tt == 1) { const int ro0 = 16 * s2 + 4 * h + q4; const bf16x8 vO = cat8(tr_read(lds + S3_V + off256t(ro0, cbv)), tr_read(lds + S3_V + off256t(ro0 + 8, cbv)));
                    in = __builtin_amdgcn_mfma_f32_32x32x16_bf16(vO, pack_step(pO, s2), in, 0, 0, 0); } }
#pragma unroll
            for (int i = 0; i < 16; ++i) hs[i] = (eaF * it[i] + alF * in[i]) * invF;
        }
        asm volatile("" ::: "memory");
        {   f32x16 it, in;
#pragma unroll
            for (int i = 0; i < 16; ++i) { it[i] = 0.f; in[i] = 0.f; }
#pragma unroll
            for (int s4 = 0; s4 < 4; ++s4) { const bf16x8 cB = *(const LAS bf16x8*)(lds + S3_CB + off128r(32 * et + r, 2 * s4 + h)); it = __builtin_amdgcn_mfma_f32_32x32x16_bf16(cB, qf[s4], it, 0, 0, 0); }
#pragma unroll
            for (int s2 = 0; s2 < 2; ++s2) { const int rd0 = 32 * tt + 16 * s2 + 4 * h + q4;
                const bf16x8 vD = cat8(tr_read(lds + S3_V + off256t(rd0, cbv)), tr_read(lds + S3_V + off256t(rd0 + 8, cbv)));
                in = __builtin_amdgcn_mfma_f32_32x32x16_bf16(vD, pack_step(pB, s2), in, 0, 0, 0);
                if (tt == 0) { const int ro0 = 32 + 16 * s2 + 4 * h + q4; const bf16x8 vO = cat8(tr_read(lds + S3_V + off256t(ro0, cbv)), tr_read(lds + S3_V + off256t(ro0 + 8, cbv)));
                    in = __builtin_amdgcn_mfma_f32_32x32x16_bf16(vO, pack_step(pO, s2), in, 0, 0, 0); } }
#pragma unroll
            for (int i = 0; i < 16; ++i) hs[i] += (eaB * it[i] + alB * in[i]) * invB;
        }
#pragma unroll
        for (int i = 0; i < 16; ++i) HS[t * S3_HS_LD + 32 * et + (i & 3) + 8 * (i >> 2) + 4 * h] = hs[i];
        __syncthreads();
        { const int tr = tid >> 3, e0 = (tid & 7) * 16; float vv[16]; float ss = 0.f;
#pragma unroll
          for (int i = 0; i < 4; ++i) { const f32x4 x = *(const LAS f32x4*)(HS + tr * S3_HS_LD + e0 + 4 * i); vv[4 * i] = x[0]; vv[4 * i + 1] = x[1]; vv[4 * i + 2] = x[2]; vv[4 * i + 3] = x[3]; ss += (x[0] * x[0] + x[1] * x[1]) + (x[2] * x[2] + x[3] * x[3]); }
          ss += __shfl_xor(ss, 1); ss += __shfl_xor(ss, 2); ss += __shfl_xor(ss, 4);
          const float rinv = __builtin_amdgcn_rsqf(ss * (1.f / 128.f) + RMS_EPS);
          unsigned ow[8];
#pragma unroll
          for (int i = 0; i < 8; ++i) { const unsigned w = i < 4 ? og0[i] : og1[i - 4];
              const float o0 = __builtin_bit_cast(float, w << 16), o1 = __builtin_bit_cast(float, w & 0xffff0000u);
              const float g0 = outg[hd * 128 + e0 + 2 * i], g1 = outg[hd * 128 + e0 + 2 * i + 1];
              const float y0 = vv[2 * i] * rinv * g0 / (1.f + __expf(-o0)), y1 = vv[2 * i + 1] * rinv * g1 / (1.f + __expf(-o1));
              ow[i] = cvt_pk_bf16(y0, y1); }
          bf16_t* yp = Y2 + (tok0 + tr) * D + hd * 128 + e0;
          *(u32x4*)yp = (u32x4){ow[0], ow[1], ow[2], ow[3]}; *(u32x4*)(yp + 8) = (u32x4){ow[4], ow[5], ow[6], ow[7]}; }
    }
#undef S3_LOAD
}

__global__ void __launch_bounds__(NTHR, 2) fwd_kernel(Args args) {
    extern __shared__ __attribute__((aligned(16))) unsigned char lds_raw[];
    Frame F;
    F.lds = (LAS unsigned char*)lds_raw;
    F.MISC = (volatile LAS unsigned*)(F.lds + MISC_OFF);
    F.tid = threadIdx.x; F.lane = F.tid & 63; F.wave = __builtin_amdgcn_readfirstlane(F.tid >> 6);
    F.G = gridDim.x; { const int bx = blockIdx.x; F.vcu = (F.G % 8 == 0) ? (bx % 8) * (F.G / 8) + bx / 8 : bx; }
    F.ctl = (unsigned*)(args.ws + WS_CTL);
    if (F.tid < 64) F.MISC[F.tid] = 0u;
    __syncthreads();
    XcdBarrier bar = xcd_barrier_post(F.ctl + CW_BAR, F.MISC + 8);
    const int lo = args.ph_lo, hi = args.ph_hi;
    unsigned char* ws = args.ws;
#define IN(k) (lo <= (k) && (k) < hi)
#define SEAM(k) do { if (IN(k) && IN((k) + 1)) xcd_barrier(bar); } while (0)

    if (IN(0)) { p0_prologue(F, args); } SEAM(0);
    if (IN(1)) {
        pg8::DenseOrder8 S; S.init(M, NQKV, F.G, (int)blockIdx.x, (const bf16_t*)(ws + WS_WQKV), D);
        pg8::EpiQKV E{(bf16_t*)(ws + WS_Q), (bf16_t*)(ws + WS_K), (bf16_t*)(ws + WS_V), args.in[IN_AQG], args.in[IN_AKG]};
        pg8::gemm_phase<pg8::EpiQKV, pg8::DenseOrder8, false, true, true>(F.lds, nullptr, (const void*)(ws + WS_XN8), D, S, E);
        if ((int)blockIdx.x >= 128 && F.G == 256) expert_conv_items(F, args, XI_PRO_END, XI_A_END, ((int)blockIdx.x - 128) * NWAVES + F.wave, 128 * NWAVES);
        else if (F.G != 256 && (int)blockIdx.x == 0) expert_conv_items(F, args, XI_PRO_END, XI_A_END, F.wave, NWAVES);
    } SEAM(1);
    if (IN(2)) { attn_phase(F, args); } SEAM(2);
    if (IN(3)) {
        pg8::DenseOrder8 S; S.init(M, D, F.G, (int)blockIdx.x, (const bf16_t*)(ws + WS_WAO), D);
        if (F.G == 256) { pg8::EpiResRoute<false> E{args.in[IN_X], (bf16_t*)(ws + WS_X1), ws + WS_XN8, (float*)(ws + WS_PART), args.in[IN_FNG], args.in[IN_RW], 1.f / 256.f};
            pg8::gemm_phase<pg8::EpiResRoute<false>, pg8::DenseOrder8, false, false, true>(F.lds, nullptr, (const void*)(ws + WS_O), D, S, E); }
        else { pg8::EpiRes<false, true> E{args.in[IN_X], (void*)(ws + WS_X1), D, 1.f / 256.f};
            pg8::gemm_phase<pg8::EpiRes<false, true>, pg8::DenseOrder8, false, false, true>(F.lds, nullptr, (const void*)(ws + WS_O), D, S, E); }
    } SEAM(3);
    if (IN(4) && F.G != 256) { nr_phase<16, false>(F, (const bf16_t*)(ws + WS_X1), nullptr, nullptr, nullptr, args.in[IN_FNG], nullptr, (unsigned char*)(ws + WS_XN8), args.in[IN_RW], NE, 0, (float*)(ws + WS_PART), nullptr, nullptr); }
    if (F.G != 256) SEAM(4);
    if (IN(5)) { topk_phase(F, (const float*)(ws + WS_PART), (int*)(ws + WS_IDX), (float*)(ws + WS_GATE), (float*)(ws + WS_RSC), (int*)(ws + WS_SLOT));
        if ((int)blockIdx.x >= 64) expert_conv_items(F, args, XI_A_END, XI_B_END, ((int)blockIdx.x - 64) * NWAVES + F.wave, (F.G - 64) * NWAVES); } SEAM(5);
    if (IN(6)) { moe_up_phase(F, ws, 0); } SEAM(6);
    if (IN(7)) { moe_down_phase(F, ws, 0); } SEAM(7);
    if (IN(8)) { nrm_phase(F, (const bf16_t*)(ws + WS_X1), (const bf16_t*)(ws + WS_Y), (const int*)(ws + WS_SLOT), (bf16_t*)(ws + WS_X2), args.in[IN_MNG], (bf16_t*)(ws + WS_XN),
                           args.in[IN_MWIN], MIN_LD, MIN_N, (float*)(ws + WS_MG), args.in[IN_MBI], args.in[IN_MBF]); } SEAM(8);
    if (IN(9)) {
        pg8::DenseOrder S; S.init(M, MIN_N, F.G, (int)blockIdx.x, (const bf16_t*)(ws + WS_WMIN), D);
        pg8::EpiBf16 E{(bf16_t*)(ws + WS_PROJ), MIN_N, nullptr, 1.f};
        pg8::gemm_phase<pg8::EpiBf16, pg8::DenseOrder, false, true, false>(F.lds, nullptr, (const bf16_t*)(ws + WS_XN), D, S, E);
    } SEAM(9);
    if (IN(10)) { mlstm_scan_phase(F, args); } SEAM(10);
    if (IN(12)) { mlstm_s3_phase(F, args); } SEAM(12);
    if (IN(13)) {
        pg8::DenseOrder S; S.init(M, D, F.G, (int)blockIdx.x, (const bf16_t*)(ws + WS_WMO), D);
        if (F.G == 256) { pg8::EpiResRoute<true> E{(const void*)(ws + WS_X2), (bf16_t*)(ws + WS_X3), ws + WS_XN8, (float*)(ws + WS_PART), args.in[IN_FNG] + D, args.in[IN_RW] + D * NE, 1.f};
            pg8::gemm_phase<pg8::EpiResRoute<true>, pg8::DenseOrder, false, false, false>(F.lds, nullptr, (const bf16_t*)(ws + WS_Y2), D, S, E); }
        else { pg8::EpiRes<true, true> E{(const void*)(ws + WS_X2), (void*)(ws + WS_X3), D, 1.f};
            pg8::gemm_phase<pg8::EpiRes<true, true>, pg8::DenseOrder, false, false, false>(F.lds, nullptr, (const bf16_t*)(ws + WS_Y2), D, S, E); }
    } SEAM(13);
    if (IN(14) && F.G != 256) { nr_phase<16, false>(F, (const bf16_t*)(ws + WS_X3), nullptr, nullptr, nullptr, args.in[IN_FNG] + D, nullptr, (unsigned char*)(ws + WS_XN8), args.in[IN_RW] + D * NE, NE, 0, (float*)(ws + WS_PART), nullptr, nullptr); }
    if (F.G != 256) SEAM(14);
    if (IN(15)) { topk_phase(F, (const float*)(ws + WS_PART), (int*)(ws + WS_IDX), (float*)(ws + WS_GATE), (float*)(ws + WS_RSC), (int*)(ws + WS_SLOT));
        if ((int)blockIdx.x >= 64) expert_conv_items(F, args, XI_C_END - XI_NC, XI_C_END, ((int)blockIdx.x - 64) * NWAVES + F.wave, (F.G - 64) * NWAVES); } SEAM(15);
    if (IN(16)) { moe_up_phase(F, ws, 1); } SEAM(16);
    if (IN(17)) { moe_down_phase(F, ws, 1); } SEAM(17);
    if (IN(18)) { combine_phase(F, (const bf16_t*)(ws + WS_X3), (const bf16_t*)(ws + WS_Y), (const int*)(ws + WS_SLOT), args.out); }
#undef IN
#undef SEAM
}

extern "C" void kernel_launch(void* const* d_in, const int* in_sizes, int n_in, void* d_out, int out_size, void* d_ws, size_t ws_size, hipStream_t stream) {
    static int grid = 0;
    if (grid == 0) {
        if (n_in != 19 || out_size != M * D || ws_size < WS_END) { fprintf(stderr, "kernel_launch: unexpected problem (n_in %d, out %d, ws %zu)\n", n_in, out_size, ws_size); grid = -1; return; }
        int dev = 0, cus = 0, per_cu = 0;
        if (hipGetDevice(&dev) != hipSuccess || hipDeviceGetAttribute(&cus, hipDeviceAttributeMultiprocessorCount, dev) != hipSuccess) { grid = -1; return; }
        if (hipFuncSetAttribute((const void*)fwd_kernel, hipFuncAttributeMaxDynamicSharedMemorySize, LDS_BYTES) != hipSuccess) { fprintf(stderr, "kernel_launch: hipFuncSetAttribute failed\n"); grid = -1; return; }
        if (hipOccupancyMaxActiveBlocksPerMultiprocessor(&per_cu, (const void*)fwd_kernel, NTHR, LDS_BYTES) != hipSuccess || per_cu < 1) fprintf(stderr, "kernel_launch: occupancy query reports %d\n", per_cu);
        (void)hipGetLastError();
        grid = cus;
    }
    if (grid < 0) return;
    if (hipMemsetAsync((char*)d_ws + WS_CTL, 0, CTL_ZERO_BYTES, stream) != hipSuccess) return;
    Args a{};
    for (int i = 0; i < 19; ++i) a.in[i] = (const float*)d_in[i];
    a.out = (float*)d_out; a.ws = (unsigned char*)d_ws; a.ph_lo = 0; a.ph_hi = 19;
#ifndef EXP_LO
    hipLaunchKernelGGL(fwd_kernel, dim3(grid), dim3(NTHR), LDS_BYTES, stream, a);
#else
    a.ph_lo = 0; a.ph_hi = EXP_HI; hipLaunchKernelGGL(fwd_kernel, dim3(grid), dim3(NTHR), LDS_BYTES, stream, a);
    hipMemsetAsync((char*)d_ws + WS_CTL, 0, CTL_ZERO_BYTES, stream);
    a.ph_lo = EXP_LO; a.ph_hi = 19; hipLaunchKernelGGL(fwd_kernel, dim3(grid), dim3(NTHR), LDS_BYTES, stream, a);
#endif
}
```

```cpp
#include <hip/hip_runtime.h>
#include <cstdio>
#include <cstdint>

#define GAS __attribute__((address_space(1)))
#define LAS __attribute__((address_space(3)))
typedef unsigned short bf16_t;
typedef short bf16x8 __attribute__((ext_vector_type(8)));
typedef short s16x4 __attribute__((ext_vector_type(4)));
typedef float f32x4 __attribute__((ext_vector_type(4)));
typedef float f32x2 __attribute__((ext_vector_type(2)));
typedef float f32x16 __attribute__((ext_vector_type(16)));
typedef unsigned u32x4 __attribute__((ext_vector_type(4)));
typedef unsigned u32x2 __attribute__((ext_vector_type(2)));
typedef int i32x4 __attribute__((ext_vector_type(4)));
typedef int i32x8 __attribute__((ext_vector_type(8)));
#define LDS_WAIT() asm volatile("s_waitcnt lgkmcnt(0)" ::: "memory")
#define VM_WAIT() asm volatile("s_waitcnt vmcnt(0)" ::: "memory")
#define DI __device__ __forceinline__

constexpr int NB = 4, SEQ = 4096, D = 1024, M = NB * SEQ;
constexpr int NQKV = 1536;
constexpr int MIN_N = 3072, MIN_LD = 3104;
constexpr int NE = 16, CAP = 512, DE = 2048, MROWS = NB * NE * CAP;
constexpr float RMS_EPS = 1e-6f, LOG2E = 1.4426950408889634f;
constexpr int NWAVES = 8, NTHR = 512;

constexpr size_t MiB = 1u << 20;
constexpr size_t WS_CTL = 0, CTL_ZERO_BYTES = 1 * MiB;
constexpr size_t WS_WQKV = 2 * MiB, WS_WAO = 6 * MiB, WS_WMIN = 8 * MiB, WS_WMIN8 = 11 * MiB, WS_WMO = 14 * MiB;
constexpr size_t WS_W13 = 16 * MiB, W13_LAYER = 64 * MiB;
constexpr size_t WS_W2 = 272 * MiB, W2_LAYER = 32 * MiB;
constexpr size_t WS_XN = 400 * MiB, WS_X1 = 432 * MiB, WS_X2 = 496 * MiB, WS_X3 = 464 * MiB;
constexpr size_t WS_XN8 = 904 * MiB;
constexpr size_t WS_AFF = 560 * MiB, WS_IDX = 561 * MiB, WS_GATE = 562 * MiB, WS_SLOT = 563 * MiB, WS_MG = 564 * MiB;
constexpr size_t WS_ACT = 568 * MiB;
constexpr size_t WS_Q = WS_ACT, WS_K = WS_ACT + 32 * MiB, WS_V = WS_ACT + 40 * MiB, WS_O = WS_ACT + 48 * MiB;
constexpr size_t WS_H = WS_ACT, WS_Y = WS_ACT + 128 * MiB;
constexpr size_t WS_PROJ = WS_ACT, WS_CLOC = WS_ACT + 96 * MiB, WS_STATE = WS_ACT + 232 * MiB, WS_Y2 = WS_ACT + 300 * MiB;
constexpr size_t WS_NLOC = WS_ACT + 332 * MiB, WS_MLB = WS_ACT + 333 * MiB, WS_NST = WS_ACT + 334 * MiB, WS_MST = WS_ACT + 335 * MiB;
constexpr size_t WS_PART = 920 * MiB;
constexpr size_t WS_RSC = WS_AFF;
constexpr size_t WS_END = 928 * MiB;
constexpr int CW_BAR = 4096;

constexpr int RING_BYTES = 131072;
constexpr int AUX_OFF = RING_BYTES, AUX_BYTES = 24576;
constexpr int MISC_OFF = AUX_OFF + AUX_BYTES;
constexpr int LDS_BYTES = MISC_OFF + 256;

DI unsigned f2bf(float f) { unsigned u = __builtin_bit_cast(unsigned, f); return (u + 0x7fffu + ((u >> 16) & 1u)) >> 16; }
DI unsigned pk2(float lo, float hi) { return f2bf(lo) | (f2bf(hi) << 16); }
DI unsigned cvt_pk_bf16(float lo, float hi) { unsigned r; asm volatile("v_cvt_pk_bf16_f32 %0, %1, %2" : "=v"(r) : "v"(lo), "v"(hi)); return r; }
DI unsigned pk4_fp8(float a, float b, float c, float d) { unsigned w = 0u; w = __builtin_amdgcn_cvt_pk_fp8_f32(a, b, w, false); w = __builtin_amdgcn_cvt_pk_fp8_f32(c, d, w, true); return w; }
DI float bf2f(unsigned short b) { return __builtin_bit_cast(float, ((unsigned)b) << 16); }
DI float wave_sum(float v) {
#pragma unroll
    for (int o = 1; o < 64; o <<= 1) v += __shfl_xor(v, o);
    return v;
}

#define XB_TMO      128
#define XB_XCNT(j)  (256  + 64 * (j))
#define XB_XSUB(j)  (1280 + 64 * (j))
#define XB_XGEN(j)  (2304 + 64 * (j))
#define XB_TOP      3328
#define XB_TOPGEN   3392
#define XCD_BAR_WORDS 3456
#define XB_SPIN_CAP (1u << 18)
DI unsigned xb_ld(unsigned* p)              { return __hip_atomic_load(p, __ATOMIC_RELAXED, __HIP_MEMORY_SCOPE_AGENT); }
DI unsigned xb_add(unsigned* p, unsigned v) { return __hip_atomic_fetch_add(p, v, __ATOMIC_RELAXED, __HIP_MEMORY_SCOPE_AGENT); }
DI unsigned xb_xcc_id() { return (unsigned)__builtin_amdgcn_s_getreg((3 << 11) | 20) & 0xFu; }
#define XB_SPIN(cond, bar) do { unsigned _sp = 0; while (cond) { __builtin_amdgcn_s_sleep(1); \
    if ((++_sp & 255u) == 0u) { if (xb_ld(&(bar)[XB_TMO])) break; if (_sp > XB_SPIN_CAP) { atomicAdd(&(bar)[XB_TMO], 1u); break; } } } } while (0)
struct XcdBarrier { unsigned* bar; unsigned x; volatile LAS unsigned* st; };
DI XcdBarrier xcd_barrier_post(unsigned* bar, volatile LAS unsigned* st) {
    XcdBarrier b; b.bar = bar; b.x = xb_xcc_id(); b.st = st;
    if (threadIdx.x == 0) (void)xb_add(&bar[XB_XCNT(b.x)], 1u);
    return b;
}
DI void xcd_barrier_complete(unsigned* bar, unsigned x, unsigned& nloc, unsigned& nx) {
    const unsigned G = gridDim.x * gridDim.y * gridDim.z;
    unsigned sum, cnt, mine, sp = 0u;
    for (;;) {
        sum = 0u; cnt = 0u; mine = 0u;
#pragma unroll
        for (unsigned j = 0; j < 16; ++j) { const unsigned c = xb_ld(&bar[XB_XCNT(j)]); sum += c; cnt += (c > 0u) ? 1u : 0u; mine = (j == x) ? c : mine; }
        if (sum == G) break;
        __builtin_amdgcn_s_sleep(1);
        if ((++sp & 255u) == 0u) { if (xb_ld(&bar[XB_TMO])) break; if (sp > XB_SPIN_CAP) { atomicAdd(&bar[XB_TMO], 1u); break; } }
    }
    nloc = mine > 0u ? mine : 1u; nx = cnt > 0u ? cnt : 1u;
}
DI void xcd_barrier(const XcdBarrier& b) {
    asm volatile("s_waitcnt vmcnt(0)" ::: "memory");
    __syncthreads();
    if (threadIdx.x == 0) {
        unsigned* bar = b.bar;
        __builtin_amdgcn_s_waitcnt(0);
        unsigned nloc = b.st[0], nx = b.st[1];
        if (nloc == 0u) { xcd_barrier_complete(bar, b.x, nloc, nx); b.st[0] = nloc; b.st[1] = nx; }
        const unsigned old = xb_add(&bar[XB_XSUB(b.x)], 1u);
        const unsigned gen = old / nloc;
        if (old + 1u == (gen + 1u) * nloc) {
            __builtin_amdgcn_fence(__ATOMIC_RELEASE, "agent");
            asm volatile("s_waitcnt vmcnt(0)" ::: "memory");
            const unsigned og = xb_add(&bar[XB_TOP], 1u);
            const unsigned tg = og / nx;
            if (og + 1u == (tg + 1u) * nx) xb_add(&bar[XB_TOPGEN], 1u);
            else XB_SPIN(xb_ld(&bar[XB_TOPGEN]) == tg, bar);
            __builtin_amdgcn_fence(__ATOMIC_ACQUIRE, "agent");
            xb_add(&bar[XB_XGEN(b.x)], 1u);
            asm volatile("s_waitcnt vmcnt(0)" ::: "memory");
        } else {
            XB_SPIN(xb_ld(&bar[XB_XGEN(b.x)]) == gen, bar);
            __builtin_amdgcn_fence(__ATOMIC_ACQUIRE, "agent");
            asm volatile("s_waitcnt vmcnt(0)" ::: "memory");
        }
    }
    __syncthreads();
}

namespace pg8 {
constexpr int BM = 256, BK = 64, HALF = 128, HTB = HALF * BK * 2, STAGE_BYTES = 8 * HTB;
DI int lds_byte(int r, int c) { const int st = (r >> 4) * 2 + (c >> 5), rr = r & 15, cc = c & 31, ob = rr * 64 + cc * 2; return st * 1024 + (ob ^ (((ob >> 9) & 1) << 5)); }
DI void stage_rc(int b, int& R, int& C) { const int st = b / 1024, sb = b % 1024, swz = sb ^ (((sb >> 9) & 1) << 5); R = (st >> 1) * 16 + swz / 64; C = (st & 1) * 32 + (swz % 64) / 2; }
DI int perm32(int rho) { const int n = rho >> 4, i = rho & 15; return 8 * (i >> 2) + 4 * n + (i & 3); }
DI int perm32inv(int c) { return 16 * ((c >> 2) & 1) + 4 * (c >> 3) + (c & 3); }
struct Unit { int pm, pn, ui; };

template <class Epi, class Sched, bool GATHER, bool ALIGN_EPI, bool F8>
DI void gemm_phase(LAS unsigned char* lds, const LAS int* idx_lds, const void* A, const int K, const Sched& S, const Epi& E) {
    const int tid = threadIdx.x, wid = __builtin_amdgcn_readfirstlane(tid >> 6), lane = tid & 63, wr = wid >> 2, wc = wid & 3, fr = lane & 15, fq = lane >> 4;
    const int PB = F8 ? K : 2 * K, nt = PB / 128;
    unsigned voffA[2][2], voffB[2];
    int RA[2], CA[2];
#pragma unroll
    for (int i = 0; i < 2; ++i) { int R, C; stage_rc(tid * 16 + i * 8192, R, C); RA[i] = R; CA[i] = C; voffB[i] = (unsigned)(R * PB + C * 2); }
    const size_t kstep = (size_t)(BK * 2);
    const size_t hstep = (size_t)HALF * PB;
    const unsigned ldsw = (unsigned)wid * 1024u;
    const int aoff = lds_byte(wr * 64 + fr, fq * 8), boff = lds_byte(wc * 32 + fr, fq * 8);
#define PG8_SA(b, h) (((b) * 2 + (h)) * HTB)
#define PG8_SB(b, h) ((4 + (b) * 2 + (h)) * HTB)
#define PG8_STAGE(bufoff, gbase, voff) do { _Pragma("unroll") for (int _i = 0; _i < 2; ++_i) \
        __builtin_amdgcn_global_load_lds((const unsigned*)((const char*)(gbase) + (voff)[_i]), (LAS unsigned*)(lds + (bufoff) + ldsw + _i * 8192), 16, 0, 0); } while (0)
#define PG8_LDA(dst, b, h) do { _Pragma("unroll") for (int m = 0; m < 4; ++m) _Pragma("unroll") for (int k = 0; k < 2; ++k) dst[m][k] = *(const LAS bf16x8*)(lds + PG8_SA(b, h) + aoff + m * 2048 + k * 1024); } while (0)
#define PG8_LDB(dst, b, h) do { _Pragma("unroll") for (int n = 0; n < 2; ++n) _Pragma("unroll") for (int k = 0; k < 2; ++k) dst[n][k] = *(const LAS bf16x8*)(lds + PG8_SB(b, h) + boff + n * 2048 + k * 1024); } while (0)
#define PG8_MMA(ai, bj, At, Bt) do { __builtin_amdgcn_s_setprio(1); _Pragma("unroll") for (int m = 0; m < 4; ++m) _Pragma("unroll") for (int n = 0; n < 2; ++n) { \
        if constexpr (F8) acc[ai][bj][m][n] = __builtin_amdgcn_mfma_scale_f32_16x16x128_f8f6f4( \
            __builtin_shufflevector(__builtin_bit_cast(i32x4, Bt[n][0]), __builtin_bit_cast(i32x4, Bt[n][1]), 0, 1, 2, 3, 4, 5, 6, 7), \
            __builtin_shufflevector(__builtin_bit_cast(i32x4, At[m][0]), __builtin_bit_cast(i32x4, At[m][1]), 0, 1, 2, 3, 4, 5, 6, 7), acc[ai][bj][m][n], 0, 0, 0, 0x7f7f7f7f, 0, 0x7f7f7f7f); \
        else { _Pragma("unroll") for (int k = 0; k < 2; ++k) acc[ai][bj][m][n] = __builtin_amdgcn_mfma_f32_16x16x32_bf16(Bt[n][k], At[m][k], acc[ai][bj][m][n], 0, 0, 0); } } \
        __builtin_amdgcn_s_setprio(0); } while (0)
#define PG8_WAIT_V(n) asm volatile("s_waitcnt vmcnt(" #n ")" ::: "memory")
#define PG8_WAIT_L(n) asm volatile("s_waitcnt lgkmcnt(" #n ")" ::: "memory")
#define PG8_BAR __builtin_amdgcn_s_barrier()
#define PG8_SCHED __builtin_amdgcn_sched_barrier(0)
#define PG8_SETA(ui_, u_) do { _Pragma("unroll") for (int _h = 0; _h < 2; ++_h) _Pragma("unroll") for (int _i = 0; _i < 2; ++_i) { \
        const int _row = GATHER ? idx_lds[(ui_) * 256 + _h * 128 + RA[_i]] : (u_).pm * 256 + _h * 128 + RA[_i]; voffA[_h][_i] = (unsigned)(_row * PB + CA[_i] * 2); } } while (0)
    Unit cur, nxt; int ui = 0;
    if (!S.next(0, cur)) return;
    f32x4 acc[2][2][4][2];
#pragma unroll
    for (int a = 0; a < 2; ++a)
#pragma unroll
        for (int b = 0; b < 2; ++b)
#pragma unroll
            for (int m = 0; m < 4; ++m)
#pragma unroll
                for (int n = 0; n < 2; ++n) acc[a][b][m][n] = (f32x4){0.f, 0.f, 0.f, 0.f};
    bf16x8 At[4][2], B0[2][2], B1[2][2];
    const char* const Ab = (const char*)A;
    const char* cB = S.bptr(cur);
    PG8_SETA(0, cur);
    PG8_STAGE(PG8_SB(0, 0), cB, voffB); PG8_STAGE(PG8_SB(0, 1), cB + hstep, voffB); PG8_STAGE(PG8_SA(0, 0), Ab, voffA[0]); PG8_STAGE(PG8_SA(0, 1), Ab, voffA[1]);
    if (wr == 1) PG8_BAR;
    PG8_WAIT_V(2); PG8_BAR;
    PG8_STAGE(PG8_SB(1, 0), cB + kstep, voffB); PG8_STAGE(PG8_SA(1, 0), Ab + kstep, voffA[0]); PG8_STAGE(PG8_SB(1, 1), cB + hstep + kstep, voffB);
    PG8_WAIT_V(6); PG8_BAR;
    for (;;) {
        const bool has_next = S.next(ui + 1, nxt);
        const char* nB = has_next ? S.bptr(nxt) : cB;
        for (int t = 0; t < nt; t += 2) {
            const bool last = (t == nt - 2);
            const char* a1 = Ab + (size_t)(t + 1) * kstep;
            const char* a2 = last ? Ab : Ab + (size_t)(t + 2) * kstep; const char* b2 = last ? nB : cB + (size_t)(t + 2) * kstep;
            const char* a3 = a2 + kstep; const char* b3 = b2 + kstep;
            PG8_LDB(B0, 0, 0); PG8_LDB(B1, 0, 1); PG8_SCHED; PG8_LDA(At, 0, 0); PG8_STAGE(PG8_SA(1, 1), a1, voffA[1]);
            if (last && has_next) PG8_SETA(ui + 1, nxt);
            PG8_WAIT_V(8); PG8_WAIT_L(0); PG8_BAR; PG8_MMA(0, 0, At, B0); PG8_MMA(0, 1, At, B1); PG8_BAR; PG8_SCHED;
            PG8_LDA(At, 0, 1); PG8_STAGE(PG8_SB(0, 0), b2, voffB); PG8_STAGE(PG8_SB(0, 1), b2 + hstep, voffB); PG8_STAGE(PG8_SA(0, 0), a2, voffA[0]);
            PG8_WAIT_V(8); PG8_WAIT_L(0); PG8_BAR; PG8_MMA(1, 0, At, B0); PG8_MMA(1, 1, At, B1); PG8_BAR; PG8_SCHED;
            PG8_LDB(B0, 1, 0); PG8_LDB(B1, 1, 1); PG8_SCHED; PG8_LDA(At, 1, 0); PG8_STAGE(PG8_SA(0, 1), a2, voffA[1]);
            PG8_WAIT_V(8); PG8_WAIT_L(0); PG8_BAR; PG8_MMA(0, 0, At, B0); PG8_MMA(0, 1, At, B1); PG8_BAR; PG8_SCHED;
            PG8_LDA(At, 1, 1); PG8_STAGE(PG8_SB(1, 0), b3, voffB); PG8_STAGE(PG8_SB(1, 1), b3 + hstep, voffB); PG8_STAGE(PG8_SA(1, 0), a3, voffA[0]);
            PG8_WAIT_V(8); PG8_WAIT_L(0); PG8_BAR; PG8_MMA(1, 0, At, B0); PG8_MMA(1, 1, At, B1); PG8_BAR; PG8_SCHED;
        }
        if constexpr (ALIGN_EPI) { if (wr == 0) PG8_BAR; }
        cur.ui = ui;
        if constexpr (!Epi::AFTER_DRAIN) E(acc, cur, wr, wc, fr, fq);
        if (!has_next) break;
#pragma unroll
        for (int a = 0; a < 2; ++a)
#pragma unroll
            for (int b = 0; b < 2; ++b)
#pragma unroll
                for (int m = 0; m < 4; ++m)
#pragma unroll
                    for (int n = 0; n < 2; ++n) acc[a][b][m][n] = (f32x4){0.f, 0.f, 0.f, 0.f};
        cur = nxt; cB = nB; ++ui;
        if constexpr (ALIGN_EPI) { if (wr == 1) PG8_BAR; }
    }
    PG8_WAIT_V(0);
    if constexpr (!ALIGN_EPI) { if (wr == 0) PG8_BAR; }
    PG8_BAR;
    if constexpr (Epi::AFTER_DRAIN) E.fused(acc, cur, wr, wc, fr, fq, lds);
#undef PG8_SA
#undef PG8_SB
#undef PG8_STAGE
#undef PG8_LDA
#undef PG8_LDB
#undef PG8_MMA
#undef PG8_WAIT_V
#undef PG8_WAIT_L
#undef PG8_BAR
#undef PG8_SCHED
#undef PG8_SETA
}

struct DenseOrder {
    int nM, nN, nwg, G, c; const bf16_t* Bt; int K;
    DI void init(int M_, int N_, int G_, int c_, const bf16_t* Bt_, int K_) { nM = M_ / BM; nN = N_ / BM; nwg = nM * nN; G = G_; c = c_; Bt = Bt_; K = K_; }
    DI bool next(int i, Unit& u) const {
        const long L = (long)i * G + c; if (L >= nwg) return false;
        int wgid = (int)L; { const int q = nwg / 8, r = nwg % 8, xcd = wgid % 8, off = wgid / 8; wgid = (xcd < r ? xcd * (q + 1) : r * (q + 1) + (xcd - r) * q) + off; }
        const int nig = 8 * nN, gid = wgid / nig, fm = gid * 8, gsz = (nM - fm) < 8 ? (nM - fm) : 8;
        u.pm = fm + ((wgid % nig) % gsz); u.pn = (wgid % nig) / gsz; return true;
    }
    DI const char* bptr(const Unit& u) const { return (const char*)(Bt + (size_t)u.pn * BM * K); }
};

struct DenseOrder8 : DenseOrder { DI const char* bptr(const Unit& u) const { return (const char*)Bt + (size_t)u.pn * BM * K; } };

struct EpiQKV {
    static constexpr bool AFTER_DRAIN = false;
    bf16_t *Q, *Kb, *Vb; const float *qg, *kg;
    DI void operator()(const f32x4 (&acc)[2][2][4][2], const Unit& u, int wr, int wc, int fr, int fq) const {
        const int pn = u.pn; bf16_t* base; int ld; const float* g; float sc;
        if (pn < 4) { base = Q + (pn * 4 + wc) * 64; ld = 1024; g = qg; sc = 0.125f * LOG2E; }
        else if (pn == 4) { base = Kb + wc * 64; ld = 256; g = kg; sc = 1.f; }
        else { base = Vb + wc * 64; ld = 256; g = kg; sc = 0.f; }
        f32x4 gv[2][2];
#pragma unroll
        for (int bj = 0; bj < 2; ++bj)
#pragma unroll
            for (int n = 0; n < 2; ++n) { gv[bj][n] = *(const f32x4*)(g + 32 * bj + 8 * fq + 4 * n) * sc; if (pn == 5) gv[bj][n] = (f32x4){1.f, 1.f, 1.f, 1.f}; }
#pragma unroll
        for (int ai = 0; ai < 2; ++ai)
#pragma unroll
            for (int m = 0; m < 4; ++m) {
                const int row = u.pm * BM + ai * HALF + wr * 64 + m * 16 + fr;
                float ss = 0.f;
#pragma unroll
                for (int bj = 0; bj < 2; ++bj)
#pragma unroll
                    for (int n = 0; n < 2; ++n) { const f32x4 x = acc[ai][bj][m][n]; ss += (x[0] * x[0] + x[1] * x[1]) + (x[2] * x[2] + x[3] * x[3]); }
                ss += __shfl_xor(ss, 16); ss += __shfl_xor(ss, 32);
                const float rinv = (pn == 5) ? 0.0625f : __builtin_amdgcn_rsqf(ss * (1.f / 64.f) + RMS_EPS);
#pragma unroll
                for (int bj = 0; bj < 2; ++bj) {
                    const f32x4 v0 = acc[ai][bj][m][0] * rinv * gv[bj][0], v1 = acc[ai][bj][m][1] * rinv * gv[bj][1];
                    u32x4 w; w.x = cvt_pk_bf16(v0[0], v0[1]); w.y = cvt_pk_bf16(v0[2], v0[3]); w.z = cvt_pk_bf16(v1[0], v1[1]); w.w = cvt_pk_bf16(v1[2], v1[3]);
                    *(u32x4*)(base + (size_t)row * ld + 32 * bj + 8 * fq) = w; }
            }
    }
};
template <bool RB, bool OB> struct EpiRes {
    static constexpr bool AFTER_DRAIN = false;
    const void* resid; void* out; int ldc; float cscale;
    DI void operator()(const f32x4 (&acc)[2][2][4][2], const Unit& u, int wr, int wc, int fr, int fq) const {
        const int row0 = u.pm * BM + wr * 64 + fr, col0 = u.pn * BM + wc * 32 + 4 * fq;
#pragma unroll
        for (int ai = 0; ai < 2; ++ai)
#pragma unroll
          for (int mp = 0; mp < 4; mp += 2) {
            f32x4 rr[2][2][2];
#pragma unroll
            for (int m = 0; m < 2; ++m) { const size_t off = (size_t)(row0 + ai * HALF + (mp + m) * 16) * ldc + col0;
#pragma unroll
                for (int bj = 0; bj < 2; ++bj)
#pragma unroll
                    for (int n = 0; n < 2; ++n) {
                        if constexpr (RB) { const u32x2 w = *(const u32x2*)((const bf16_t*)resid + off + bj * HALF + n * 16);
                            rr[m][bj][n] = (f32x4){__builtin_bit_cast(float, w.x << 16), __builtin_bit_cast(float, w.x & 0xffff0000u), __builtin_bit_cast(float, w.y << 16), __builtin_bit_cast(float, w.y & 0xffff0000u)}; }
                        else rr[m][bj][n] = *(const f32x4*)((const float*)resid + off + bj * HALF + n * 16); } }
#pragma unroll
            for (int m = 0; m < 2; ++m) { const size_t off = (size_t)(row0 + ai * HALF + (mp + m) * 16) * ldc + col0;
#pragma unroll
                for (int bj = 0; bj < 2; ++bj)
#pragma unroll
                    for (int n = 0; n < 2; ++n) { const f32x4 o = rr[m][bj][n] + acc[ai][bj][mp + m][n] * cscale;
                        if constexpr (OB) { u32x2 w; w.x = cvt_pk_bf16(o[0], o[1]); w.y = cvt_pk_bf16(o[2], o[3]); *(u32x2*)((bf16_t*)out + off + bj * HALF + n * 16) = w; }
                        else *(f32x4*)((float*)out + off + bj * HALF + n * 16) = o; } }
            asm volatile("" ::: "memory"); }
    }
};
template <bool RB> struct EpiResRoute {
    static constexpr bool AFTER_DRAIN = true;
    const void* resid; bf16_t* X1; unsigned char* XG8; float* part; const float* g; const float* Wr; float cscale;
    DI void operator()(const f32x4 (&)[2][2][4][2], const Unit&, int, int, int, int) const {}
    DI void fused(f32x4 (&acc)[2][2][4][2], const Unit& u, int wr, int wc, int fr, int fq, LAS unsigned char* lds) const {
        const int tid = threadIdx.x;
        LAS unsigned short* WH = (LAS unsigned short*)lds;
        LAS unsigned short* WL = WH + 16 * 256;
        LAS float* RED = (LAS float*)(lds + 16384);
#pragma unroll
        for (int i = 0; i < 2; ++i) { const int idx = tid + i * 512, c = idx >> 2, e4 = idx & 3; const int col = u.pn * BM + c;
            const f32x4 w = *(const f32x4*)(Wr + (size_t)col * NE + 4 * e4) * g[col];
#pragma unroll
            for (int q = 0; q < 4; ++q) { const unsigned hb = f2bf(w[q]); const float lo = w[q] - __builtin_bit_cast(float, hb << 16);
                WH[(4 * e4 + q) * 256 + c] = (unsigned short)hb; WL[(4 * e4 + q) * 256 + c] = (unsigned short)f2bf(lo); } }
        const int row0 = u.pm * BM + wr * 64 + fr, col0 = u.pn * BM + wc * 32 + 4 * fq;
        f32x4 gc[2][2];
#pragma unroll
        for (int bj = 0; bj < 2; ++bj)
#pragma unroll
            for (int n = 0; n < 2; ++n) gc[bj][n] = *(const f32x4*)(g + col0 + bj * HALF + n * 16);
#pragma unroll
        for (int ai = 0; ai < 2; ++ai)
#pragma unroll
          for (int mp = 0; mp < 4; mp += 2) {
            f32x4 rr[2][2][2];
#pragma unroll
            for (int m = 0; m < 2; ++m) { const size_t off = (size_t)(row0 + ai * HALF + (mp + m) * 16) * D + col0;
#pragma unroll
                for (int bj = 0; bj < 2; ++bj)
#pragma unroll
                    for (int n = 0; n < 2; ++n) {
                        if constexpr (RB) { const u32x2 w = *(const u32x2*)((const bf16_t*)resid + off + bj * HALF + n * 16);
                            rr[m][bj][n] = (f32x4){__builtin_bit_cast(float, w.x << 16), __builtin_bit_cast(float, w.x & 0xffff0000u), __builtin_bit_cast(float, w.y << 16), __builtin_bit_cast(float, w.y & 0xffff0000u)}; }
                        else rr[m][bj][n] = *(const f32x4*)((const float*)resid + off + bj * HALF + n * 16); } }
#pragma unroll
            for (int m = 0; m < 2; ++m) { const size_t off = (size_t)(row0 + ai * HALF + (mp + m) * 16) * D + col0;
#pragma unroll
                for (int bj = 0; bj < 2; ++bj)
#pragma unroll
                    for (int n = 0; n < 2; ++n) { const f32x4 o = rr[m][bj][n] + acc[ai][bj][mp + m][n] * cscale; acc[ai][bj][mp + m][n] = o;
                        u32x2 w; w.x = cvt_pk_bf16(o[0], o[1]); w.y = cvt_pk_bf16(o[2], o[3]); *(u32x2*)(X1 + off + bj * HALF + n * 16) = w;
                        const f32x4 og = o * gc[bj][n]; *(unsigned*)(XG8 + off + bj * HALF + n * 16) = pk4_fp8(og[0], og[1], og[2], og[3]); } }
            asm volatile("" ::: "memory"); }
        __syncthreads();
#pragma unroll
        for (int ai = 0; ai < 2; ++ai)
#pragma unroll
            for (int m = 0; m < 4; ++m) { float ssl = 0.f;
#pragma unroll
                for (int bj = 0; bj < 2; ++bj)
#pragma unroll
                    for (int n = 0; n < 2; ++n) { const f32x4 x = acc[ai][bj][m][n]; ssl += (x[0] * x[0] + x[1] * x[1]) + (x[2] * x[2] + x[3] * x[3]); }
                ssl += __shfl_xor(ssl, 16); ssl += __shfl_xor(ssl, 32);
                if (fq == 0) RED[((ai * HALF + wr * 64 + m * 16 + fr) * 4 + wc) * 17 + 16] = ssl; }
        bf16x8 bh[2], bl[2];
#pragma unroll
        for (int bj = 0; bj < 2; ++bj) { const int cb = bj * HALF + wc * 32 + 4 * fq;
            const u32x2 h0 = *(const LAS u32x2*)(WH + fr * 256 + cb), h1 = *(const LAS u32x2*)(WH + fr * 256 + cb + 16), l0 = *(const LAS u32x2*)(WL + fr * 256 + cb), l1 = *(const LAS u32x2*)(WL + fr * 256 + cb + 16);
            bh[bj] = __builtin_bit_cast(bf16x8, (u32x4){h0.x, h0.y, h1.x, h1.y}); bl[bj] = __builtin_bit_cast(bf16x8, (u32x4){l0.x, l0.y, l1.x, l1.y}); }
#pragma unroll
        for (int ai = 0; ai < 2; ++ai)
#pragma unroll
            for (int m = 0; m < 4; ++m) { f32x4 lg = (f32x4){0.f, 0.f, 0.f, 0.f};
#pragma unroll
                for (int bj = 0; bj < 2; ++bj) { const f32x4 x0 = acc[ai][bj][m][0], x1v = acc[ai][bj][m][1];
                    u32x4 hi, lo; float r[8] = {x0[0], x0[1], x0[2], x0[3], x1v[0], x1v[1], x1v[2], x1v[3]};
#pragma unroll
                    for (int q = 0; q < 4; ++q) { const unsigned h2 = cvt_pk_bf16(r[2 * q], r[2 * q + 1]); hi[q] = h2;
                        lo[q] = cvt_pk_bf16(r[2 * q] - __builtin_bit_cast(float, h2 << 16), r[2 * q + 1] - __builtin_bit_cast(float, h2 & 0xffff0000u)); }
                    const bf16x8 ah = __builtin_bit_cast(bf16x8, hi), al = __builtin_bit_cast(bf16x8, lo);
                    lg = __builtin_amdgcn_mfma_f32_16x16x32_bf16(ah, bh[bj], lg, 0, 0, 0);
                    lg = __builtin_amdgcn_mfma_f32_16x16x32_bf16(al, bh[bj], lg, 0, 0, 0);
                    lg = __builtin_amdgcn_mfma_f32_16x16x32_bf16(ah, bl[bj], lg, 0, 0, 0); }
#pragma unroll
                for (int j = 0; j < 4; ++j) RED[((ai * HALF + wr * 64 + m * 16 + 4 * fq + j) * 4 + wc) * 17 + fr] = lg[j]; }
        __syncthreads();
        for (int idx = tid; idx < 256 * 17; idx += 512) { const int e17 = idx >> 8, row = idx & 255;
            const float v = (RED[(row * 4 + 0) * 17 + e17] + RED[(row * 4 + 1) * 17 + e17]) + (RED[(row * 4 + 2) * 17 + e17] + RED[(row * 4 + 3) * 17 + e17]);
            part[(size_t)(u.pn * 17 + e17) * M + u.pm * BM + row] = v; }
    }
};
struct EpiSwiGLU {
    static constexpr bool AFTER_DRAIN = false;
    unsigned char* H; const LAS float* rsl;
    DI void operator()(const f32x4 (&acc)[2][2][4][2], const Unit& u, int wr, int wc, int fr, int fq) const {
        const int row0 = u.pm * BM + wr * 64 + fr, col = u.pn * 128 + wc * 32 + 8 * fq;
        float rsv[2][4];
#pragma unroll
        for (int ai = 0; ai < 2; ++ai)
#pragma unroll
            for (int m = 0; m < 4; ++m) rsv[ai][m] = rsl[u.ui * 256 + ai * HALF + wr * 64 + m * 16 + fr] * 0.0625f;
#pragma unroll
        for (int ai = 0; ai < 2; ++ai)
#pragma unroll
            for (int m = 0; m < 4; ++m) {
                float hv[8]; const float rs = rsv[ai][m];
#pragma unroll
                for (int n = 0; n < 2; ++n)
#pragma unroll
                    for (int j = 0; j < 4; ++j) { const float a = acc[ai][0][m][n][j] * rs, uu = acc[ai][1][m][n][j] * rs;
                        const float hh = a * __builtin_amdgcn_rcpf(1.f + __builtin_amdgcn_exp2f(-a * LOG2E)) * uu; hv[4 * n + j] = fminf(fmaxf(hh, -448.f), 448.f); }
                u32x2 w; w.x = pk4_fp8(hv[0], hv[1], hv[2], hv[3]); w.y = pk4_fp8(hv[4], hv[5], hv[6], hv[7]);
                *(u32x2*)(H + (size_t)(row0 + ai * HALF + m * 16) * DE + col) = w;
            }
    }
};
struct EpiBf16 {
    static constexpr bool AFTER_DRAIN = false;
    bf16_t* O; int ldc; const float* rowscale; float cscale; int coloff;
    DI void operator()(const f32x4 (&acc)[2][2][4][2], const Unit& u, int wr, int wc, int fr, int fq) const {
        const int row0 = u.pm * BM + wr * 64 + fr, col0 = coloff + u.pn * BM + wc * 32 + 8 * fq;
#pragma unroll
        for (int ai = 0; ai < 2; ++ai)
#pragma unroll
            for (int m = 0; m < 4; ++m) { const int row = row0 + ai * HALF + m * 16; const float sc = rowscale ? rowscale[row] * cscale : cscale;
#pragma unroll
                for (int bj = 0; bj < 2; ++bj) { const f32x4 v0 = acc[ai][bj][m][0] * sc, v1 = acc[ai][bj][m][1] * sc;
                    u32x4 w; w.x = cvt_pk_bf16(v0[0], v0[1]); w.y = cvt_pk_bf16(v0[2], v0[3]); w.z = cvt_pk_bf16(v1[0], v1[1]); w.w = cvt_pk_bf16(v1[2], v1[3]);
                    *(u32x4*)(O + (size_t)row * ldc + col0 + bj * HALF) = w; } }
    }
};
struct MoeUpOrder {
    int vcu, G; const char* W;
    DI bool next(int i, Unit& u) const { const int L = i * G + vcu; if (L >= 2048) return false; const int ii = L >> 8, v = L & 255, x = v >> 5, j = v & 31, e = 2 * ii + (x >> 2);
        u.pm = 8 * e + (j & 7); u.pn = 4 * (x & 3) + (j >> 3); return true; }
    DI const char* bptr(const Unit& u) const { return W + (size_t)(u.pm >> 3) * 4096 * 1024 + (size_t)u.pn * BM * 1024; }
};
struct MoeDownOrder {
    int vcu, G; const char* W;
    DI bool next(int i, Unit& u) const { const int L = i * G + vcu; if (L >= 512) return false; const int ii = L >> 8, v = L & 255, x = v >> 5, j = v & 31, e = 8 * ii + x;
        u.pm = 8 * e + (j & 7); u.pn = j >> 3; return true; }
    DI const char* bptr(const Unit& u) const { return W + (size_t)(u.pm >> 3) * 1024 * 2048 + (size_t)u.pn * BM * 2048; }
};
}

struct Args { const float* in[19]; float* out; unsigned char* ws; int ph_lo, ph_hi; };
struct Frame {
    LAS unsigned char* lds; volatile LAS unsigned* MISC; unsigned* ctl;
    int tid, lane, wave, vcu, G;
};
enum { IN_X = 0, IN_RELB, IN_ANG, IN_AWIN, IN_AQG, IN_AKG, IN_ASINK, IN_AWOUT, IN_MNG, IN_MWIN, IN_MBI, IN_MBF, IN_MOG, IN_MWOUT, IN_FNG, IN_RW, IN_W1, IN_W3, IN_W2 };

DI void conv_item(const float* W, int ldw, int cbase, bf16_t* dst, int K, int drow0, int k0, bool perm, float scale, LAS float* scr, int lane) {
#pragma unroll 8
    for (int i = 0; i < 32; ++i) { const int kk = 2 * i + (lane >> 5); scr[kk * 33 + (lane & 31)] = W[(size_t)(k0 + kk) * ldw + cbase + (lane & 31)]; }
    LDS_WAIT(); asm volatile("" ::: "memory");
    const int c = lane & 7;
#pragma unroll
    for (int j = 0; j < 4; ++j) { const int n = (lane >> 3) + 8 * j; const LAS float* s = scr + (8 * c) * 33 + n;
        u32x4 o; o.x = pk2(s[0 * 33] * scale, s[1 * 33] * scale); o.y = pk2(s[2 * 33] * scale, s[3 * 33] * scale); o.z = pk2(s[4 * 33] * scale, s[5 * 33] * scale); o.w = pk2(s[6 * 33] * scale, s[7 * 33] * scale);
        const int rho = perm ? pg8::perm32inv(n) : n;
        *(u32x4*)(dst + (size_t)(drow0 + rho) * K + k0 + 8 * c) = o; }
    LDS_WAIT(); asm volatile("" ::: "memory");
}
DI void conv_item8(const float* W, int ldw, int cbase, unsigned char* dst, int K, int drow0, int k0, float scale, LAS float* scr, int lane, bool perm = true) {
    const int a = lane >> 3, b = lane & 7;
    f32x4 v[16];
#pragma unroll
    for (int i = 0; i < 16; ++i) v[i] = __builtin_nontemporal_load((const f32x4*)(W + (size_t)(k0 + 8 * i + a) * ldw + cbase + 4 * b));
#pragma unroll
    for (int i = 0; i < 16; ++i) { const int k = 8 * i + a; LAS float* d = scr + k * 33 + 4 * (k >> 4) + 4 * b; d[0] = v[i].x; d[1] = v[i].y; d[2] = v[i].z; d[3] = v[i].w; }
    LDS_WAIT(); asm volatile("" ::: "memory");
    const int c = lane & 7;
#pragma unroll
    for (int j = 0; j < 4; ++j) { const int n = (lane >> 3) + 8 * j; const LAS float* s = scr + (16 * c) * 33 + 4 * c + n;
        u32x4 o;
#pragma unroll
        for (int q = 0; q < 4; ++q) o[q] = pk4_fp8(s[(4 * q) * 33] * scale, s[(4 * q + 1) * 33] * scale, s[(4 * q + 2) * 33] * scale, s[(4 * q + 3) * 33] * scale);
        __builtin_nontemporal_store(o, (u32x4*)(dst + (size_t)(drow0 + (perm ? pg8::perm32inv(n) : n)) * K + k0 + 16 * c)); }
    LDS_WAIT(); asm volatile("" ::: "memory");
}
DI void rms_row_to_bf16(const float* xrow, const float* g, bf16_t* orow, int lane) {
    const f32x4* xr = (const f32x4*)xrow + lane; const f32x4* gr = (const f32x4*)g + lane;
    f32x4 v[4]; float s = 0.f;
#pragma unroll
    for (int j = 0; j < 4; ++j) { v[j] = xr[64 * j]; s += (v[j].x * v[j].x + v[j].y * v[j].y) + (v[j].z * v[j].z + v[j].w * v[j].w); }
    const float rinv = __builtin_amdgcn_rsqf(wave_sum(s) * (1.f / D) + RMS_EPS);
    unsigned long long* o8 = (unsigned long long*)orow + lane;
#pragma unroll
    for (int j = 0; j < 4; ++j) { const f32x4 gg = gr[64 * j]; const f32x4 y = v[j] * rinv * gg;
        o8[64 * j] = (unsigned long long)pk2(y.x, y.y) | ((unsigned long long)pk2(y.z, y.w) << 32); }
}
constexpr int XI_PER_LE = 1536, XI_TOTAL = 32 * XI_PER_LE;
constexpr int XI_NA = 128 * NWAVES * 6, XI_NB = 192 * NWAVES * 6, XI_NC = 192 * NWAVES * 5, XI_ND = 128 * NWAVES * 16;
constexpr int XI_PRO_END = XI_TOTAL - XI_NA - XI_NB - XI_NC - XI_ND, XI_A_END = XI_PRO_END + XI_NA, XI_B_END = XI_A_END + XI_NB, XI_C_END = XI_TOTAL - XI_ND;
static_assert(XI_B_END >= XI_TOTAL / 2, "the slots after MoE layer 0 may only hold layer-1 items");
DI void expert_conv_items(Frame& F, const Args& a, int it0, int it1, int rank, int nrank) {
    LAS float* scr8 = (LAS float*)(F.lds + F.wave * 17152);
    unsigned char* ws = a.ws;
    for (int it = it0 + rank; it < it1; it += nrank) {
        const int le = it / XI_PER_LE, r = it % XI_PER_LE;
        if (r < 1024) { const int kb = r / 128, g = r % 128, pn = g >> 3, bj = (g >> 2) & 1, wc = g & 3;
            const float* W = (bj ? a.in[IN_W3] : a.in[IN_W1]) + (size_t)le * D * DE;
            conv_item8(W, DE, 128 * pn + 32 * wc, ws + WS_W13 + (size_t)le * 4096 * D, D, 32 * g, 128 * kb, 16.f, scr8, F.lane);
        } else { const int r2 = r - 1024, kb = r2 / 32, g = r2 % 32;
            conv_item8(a.in[IN_W2] + (size_t)le * DE * D, D, 32 * g, ws + WS_W2 + (size_t)le * D * DE, DE, 32 * g, 128 * kb, 32.f, scr8, F.lane); }
    }
}
DI void rms_row_to_fp8(const float* xrow, const float* g, unsigned char* orow, int lane) {
    const f32x4* xr = (const f32x4*)xrow + lane; const f32x4* gr = (const f32x4*)g + lane;
    f32x4 v[4]; float s = 0.f;
#pragma unroll
    for (int j = 0; j < 4; ++j) { v[j] = xr[64 * j]; s += (v[j].x * v[j].x + v[j].y * v[j].y) + (v[j].z * v[j].z + v[j].w * v[j].w); }
    const float rinv = __builtin_amdgcn_rsqf(wave_sum(s) * (1.f / D) + RMS_EPS);
#pragma unroll
    for (int j = 0; j < 4; ++j) { const f32x4 y = v[j] * rinv * gr[64 * j]; *((unsigned*)orow + lane + 64 * j) = pk4_fp8(y.x, y.y, y.z, y.w); }
}
DI void p0_prologue(Frame& F, const Args& a) {
    LAS float* scr = (LAS float*)(F.lds + F.wave * 17152);
    const int gw = F.vcu * NWAVES + F.wave, NGW = F.G * NWAVES;
    unsigned char* ws = a.ws;
    LAS float* scr8 = (LAS float*)(F.lds + F.wave * 17152);
    constexpr int I_QKV = 8 * 48, I_AO = 8 * 32, I_MINA = 16 * 32, I_MINB = 8 * 64, I_MO = 16 * 32, I_SMALL = I_QKV + I_AO + I_MINA + I_MINB + I_MO;
    for (int it = gw; it < I_SMALL; it += NGW) {
        int r = it;
        if (r < I_QKV) { const int kb = r / 48, g = r % 48, pn = g >> 3, bj = (g >> 2) & 1, wc = g & 3;
            conv_item8(a.in[IN_AWIN], NQKV, 256 * pn + 64 * wc + 32 * bj, ws + WS_WQKV, D, 32 * g, 128 * kb, 16.f, scr8, F.lane, true); continue; } r -= I_QKV;
        if (r < I_AO) { const int kb = r / 32, g = r % 32; conv_item8(a.in[IN_AWOUT], D, 32 * g, ws + WS_WAO, D, 32 * g, 128 * kb, 16.f, scr8, F.lane, false); continue; } r -= I_AO;
        if (r < I_MINA) { const int kb = r / 32, g = r % 32; const float sc = g >= 16 ? 0.125f : 1.f;
            conv_item(a.in[IN_MWIN], MIN_LD, 32 * g, (bf16_t*)(ws + WS_WMIN), D, 32 * g, 64 * kb, true, sc, scr, F.lane); continue; } r -= I_MINA;
        if (r < I_MINB) { const int kb = r / 64, g = r % 64;
            conv_item8(a.in[IN_MWIN], MIN_LD, 1024 + 32 * g, ws + WS_WMIN8, D, 32 * g, 128 * kb, 16.f, scr8, F.lane, true); continue; } r -= I_MINB;
        { const int kb = r / 32, g = r % 32; conv_item(a.in[IN_MWOUT], D, 32 * g, (bf16_t*)(ws + WS_WMO), D, 32 * g, 64 * kb, false, 1.f, scr, F.lane); }
    }
    for (int m = gw; m < M; m += NGW) rms_row_to_fp8(a.in[IN_X] + (size_t)m * D, a.in[IN_ANG], ws + WS_XN8 + (size_t)m * D, F.lane);
    expert_conv_items(F, a, 0, XI_PRO_END, gw, NGW);
}

constexpr int AT_K = 0, AT_V = 49152, AT_TB = 98304, AT_TB_COPY = 324, AT_TB_HEAD = 4 * AT_TB_COPY;
DI int t5_bucket_dev(int rel) {
    const int n = rel < 0 ? -rel : rel; int b;
    if (n < 8) b = n; else if (n < 12) b = 8; else if (n < 16) b = 9; else if (n < 23) b = 10; else if (n < 32) b = 11; else if (n < 46) b = 12; else if (n < 64) b = 13; else if (n < 91) b = 14; else b = 15;
    return b + (rel > 0 ? 16 : 0);
}
DI bf16x8 pack_step(const f32x16& x, int s) {
    u32x4 p;
    p.x = cvt_pk_bf16(x[8 * s + 0], x[8 * s + 1]); p.y = cvt_pk_bf16(x[8 * s + 2], x[8 * s + 3]); p.z = cvt_pk_bf16(x[8 * s + 4], x[8 * s + 5]); p.w = cvt_pk_bf16(x[8 * s + 6], x[8 * s + 7]);
    return __builtin_bit_cast(bf16x8, p);
}
typedef short v4i16_t __attribute__((ext_vector_type(4)));
DI s16x4 tr_read(const LAS unsigned char* p) { return __builtin_bit_cast(s16x4, __builtin_amdgcn_ds_read_tr16_b64_v4i16((LAS v4i16_t*)p)); }
DI bf16x8 cat8(s16x4 lo, s16x4 hi) { return __builtin_shufflevector(lo, hi, 0, 1, 2, 3, 4, 5, 6, 7); }

DI void attn_phase(Frame& F, const Args& a) {
    LAS unsigned char* lds = F.lds;
    const bf16_t* Qg = (const bf16_t*)(a.ws + WS_Q); const bf16_t* Kg = (const bf16_t*)(a.ws + WS_K); const bf16_t* Vg = (const bf16_t*)(a.ws + WS_V); unsigned char* Og = a.ws + WS_O;
    const float* relb = a.in[IN_RELB]; const float* sink = a.in[IN_ASINK];
    const int lane = F.lane, wave = F.wave, r = lane & 31, h = lane >> 5;
    const int g = wave >> 1, half = wave & 1;
    LAS float* TB = (LAS float*)(lds + AT_TB);
    constexpr int NPF = 6;
    u32x4 kvr[NPF];
#define AT_LOAD(u_) do { const int qb_ = (u_) & 31, kvh_ = ((u_) >> 5) & 3, b_ = (u_) >> 7, kb_ = qb_ * 128 - 128; \
        _Pragma("unroll") for (int i = 0; i < NPF; ++i) { const int idx = F.tid + i * NTHR, isv = idx >= 3072, rem = isv ? idx - 3072 : idx, row = rem >> 3, c = rem & 7; int kp = kb_ + row; kp = kp < 0 ? 0 : (kp >= SEQ ? SEQ - 1 : kp); \
            kvr[i] = *(const u32x4*)((isv ? Vg : Kg) + (size_t)(b_ * SEQ + kp) * 256 + kvh_ * 64 + c * 8); } } while (0)
    int tb_kvh = -1;
    if (F.vcu < 512) AT_LOAD(F.vcu);
    for (int u = F.vcu; u < 512; u += F.G) {
        const int qb = u & 31, kvh = (u >> 5) & 3, b = u >> 7;
        const int kbase = qb * 128 - 128;
        __syncthreads();
        if (kvh != tb_kvh) { tb_kvh = kvh;
#pragma unroll 4
            for (int idx = F.tid; idx < 4 * AT_TB_HEAD; idx += NTHR) {
                const int gg = idx / AT_TB_HEAD, rem = idx % AT_TB_HEAD, c = rem / AT_TB_COPY, i = rem % AT_TB_COPY, rel = i + c - 160;
                float v = -__builtin_inff();
                if (rel >= -128 && rel <= 128) v = relb[t5_bucket_dev(rel) * 16 + kvh * 4 + gg] * LOG2E;
                TB[idx] = v;
            } }
        u32x4 late[12 - NPF];
#pragma unroll
        for (int i = NPF; i < 12; ++i) { const int idx = F.tid + i * NTHR, isv = idx >= 3072, rem = isv ? idx - 3072 : idx, row = rem >> 3, c = rem & 7; int kp = kbase + row; kp = kp < 0 ? 0 : (kp >= SEQ ? SEQ - 1 : kp);
            late[i - NPF] = *(const u32x4*)((isv ? Vg : Kg) + (size_t)(b * SEQ + kp) * 256 + kvh * 64 + c * 8); }
#pragma unroll
        for (int i = 0; i < 12; ++i) { const int idx = F.tid + i * NTHR, isv = idx >= 3072, rem = isv ? idx - 3072 : idx, row = rem >> 3, c = rem & 7;
            const int pos = isv ? (c ^ (((row >> 1) & 1) << 2)) : (c ^ ((row >> 1) & 7));
            *(LAS u32x4*)(lds + (isv ? AT_V : AT_K) + row * 128 + pos * 16) = i < NPF ? kvr[i] : late[i < NPF ? 0 : i - NPF]; }
        if (u + F.G < 512) AT_LOAD(u + F.G);
        const int head = kvh * 4 + g, qw0 = qb * 128 + 64 * half;
        bf16x8 qf[2][4];
#pragma unroll
        for (int qt = 0; qt < 2; ++qt)
#pragma unroll
            for (int s = 0; s < 4; ++s) qf[qt][s] = *(const bf16x8*)(Qg + (size_t)(b * SEQ + qw0 + 32 * qt + r) * 1024 + head * 64 + 16 * s + 8 * h);
        __syncthreads();
        const float sk = sink[head] * LOG2E;
        float mrun[2] = {sk, sk}, lrun[2] = {h == 0 ? 1.f : 0.f, h == 0 ? 1.f : 0.f};
        f32x16 o[2][2];
#pragma unroll
        for (int qt = 0; qt < 2; ++qt)
#pragma unroll
            for (int dt = 0; dt < 2; ++dt)
#pragma unroll
                for (int i = 0; i < 16; ++i) o[qt][dt][i] = 0.f;
        const int cpy = (4 - (r & 3)) & 3;
        const LAS float* tbl = TB + g * AT_TB_HEAD + cpy * AT_TB_COPY + (32 + 4 * h - r - cpy);
        const int q4 = (lane & 15) >> 2, p4 = lane & 3, blk = (lane >> 4) & 1;
        for (int T = 2 * half; T < 2 * half + 10; ++T) {
            const int kp0 = kbase + 32 * T;
            if (kp0 < 0 || kp0 >= SEQ) continue;
            bf16x8 kf[4];
            { const int row = 32 * T + r;
#pragma unroll
              for (int s = 0; s < 4; ++s) kf[s] = *(const LAS bf16x8*)(lds + AT_K + row * 128 + (((2 * s + h) ^ ((row >> 1) & 7)) << 4)); }
            bf16x8 vf[2][2];
#pragma unroll
            for (int dt = 0; dt < 2; ++dt)
#pragma unroll
                for (int s = 0; s < 2; ++s) {
                    const int row0 = 32 * T + 16 * s + 4 * h + q4, row1 = row0 + 8, cb = 64 * dt + 32 * blk + 8 * p4;
                    const s16x4 lo = tr_read(lds + AT_V + row0 * 128 + (cb ^ (((row0 >> 1) & 1) << 6)));
                    const s16x4 hi = tr_read(lds + AT_V + row1 * 128 + (cb ^ (((row1 >> 1) & 1) << 6)));
                    vf[dt][s] = cat8(lo, hi);
                }
#pragma unroll
            for (int qt = 0; qt < 2; ++qt) {
                const int kt = T - 2 * half - qt;
                if (kt < 0 || kt > 8) continue;
                f32x16 sacc;
#pragma unroll
                for (int G4 = 0; G4 < 4; ++G4) { const f32x4 t = *(const LAS f32x4*)(tbl + 32 * kt + 8 * G4);
                    sacc[4 * G4 + 0] = t[0]; sacc[4 * G4 + 1] = t[1]; sacc[4 * G4 + 2] = t[2]; sacc[4 * G4 + 3] = t[3]; }
#pragma unroll
                for (int s = 0; s < 4; ++s) sacc = __builtin_amdgcn_mfma_f32_32x32x16_bf16(kf[s], qf[qt][s], sacc, 0, 0, 0);
                float mx = sacc[0];
#pragma unroll
                for (int i = 1; i < 16; ++i) mx = fmaxf(mx, sacc[i]);
                mx = fmaxf(mx, __shfl_xor(mx, 32));
                const float mnew = fmaxf(mrun[qt], mx), alpha = __builtin_amdgcn_exp2f(mrun[qt] - mnew);
                mrun[qt] = mnew;
                float ls = 0.f;
#pragma unroll
                for (int i = 0; i < 16; ++i) { sacc[i] = __builtin_amdgcn_exp2f(sacc[i] - mnew); ls += sacc[i]; }
                lrun[qt] = lrun[qt] * alpha + ls;
#pragma unroll
                for (int dt = 0; dt < 2; ++dt)
#pragma unroll
                    for (int i = 0; i < 16; ++i) o[qt][dt][i] *= alpha;
                const bf16x8 p0 = pack_step(sacc, 0), p1 = pack_step(sacc, 1);
#pragma unroll
                for (int dt = 0; dt < 2; ++dt) {
                    o[qt][dt] = __builtin_amdgcn_mfma_f32_32x32x16_bf16(vf[dt][0], p0, o[qt][dt], 0, 0, 0);
                    o[qt][dt] = __builtin_amdgcn_mfma_f32_32x32x16_bf16(vf[dt][1], p1, o[qt][dt], 0, 0, 0);
                }
            }
        }
#pragma unroll
        for (int qt = 0; qt < 2; ++qt) {
            const float lt = lrun[qt] + __shfl_xor(lrun[qt], 32), inv = 16.f / lt;
            unsigned char* orow = Og + (size_t)(b * SEQ + qw0 + 32 * qt + r) * 1024 + head * 64;
#pragma unroll
            for (int dt = 0; dt < 2; ++dt)
#pragma unroll
                for (int G4 = 0; G4 < 4; ++G4)
                    *(unsigned*)(orow + 32 * dt + 8 * G4 + 4 * h) = pk4_fp8(o[qt][dt][4 * G4] * inv, o[qt][dt][4 * G4 + 1] * inv, o[qt][dt][4 * G4 + 2] * inv, o[qt][dt][4 * G4 + 3] * inv);
        }
    }
#undef AT_LOAD
}

template <int N> DI int multi_reduce(float (&v)[N], int lane) {
    int idx = 0;
#pragma unroll
    for (int bit = 32, cnt = N / 2; cnt >= 1; bit >>= 1, cnt >>= 1) {
        const bool upper = (lane & bit) != 0;
#pragma unroll
        for (int i = 0; i < cnt; ++i) { const float lo = v[i], hi = v[i + cnt]; const float send = upper ? lo : hi, keep = upper ? hi : lo; v[i] = keep + __shfl_xor(send, bit); }
        idx |= upper ? cnt : 0;
    }
#pragma unroll
    for (int bit = 32 / N; bit >= 1; bit >>= 1) v[0] += __shfl_xor(v[0], bit);
    return idx;
}
DI float log_sigmoid(float x) { return x < 0.f ? x - log1pf(expf(x)) : -log1pf(expf(-x)); }
DI void add_routed_rows(f32x4 (&x)[4], const bf16_t* Y, int sl, int b, int lane) {
    unsigned long long mask = __ballot(sl >= 0);
    while (mask) {
        const bf16_t* yr[4]; float wq[4];
#pragma unroll
        for (int q = 0; q < 4; ++q) { const bool v = mask != 0ull; const int e = v ? __builtin_ctzll(mask) : 0; if (v) mask &= mask - 1;
            const int sv = __builtin_amdgcn_readlane(sl, e); wq[q] = v ? 1.f : 0.f;
            yr[q] = (v || q == 0) ? Y + (size_t)((e * NB + b) * CAP + sv) * D : yr[0]; }
        u32x2 w[4][4];
#pragma unroll
        for (int q = 0; q < 4; ++q)
#pragma unroll
            for (int j = 0; j < 4; ++j) w[q][j] = __builtin_nontemporal_load((const u32x2*)yr[q] + lane + 64 * j);
#pragma unroll
        for (int q = 0; q < 4; ++q)
#pragma unroll
            for (int j = 0; j < 4; ++j) { x[j].x += wq[q] * __builtin_bit_cast(float, w[q][j].x << 16); x[j].y += wq[q] * __builtin_bit_cast(float, w[q][j].x & 0xffff0000u);
                x[j].z += wq[q] * __builtin_bit_cast(float, w[q][j].y << 16); x[j].w += wq[q] * __builtin_bit_cast(float, w[q][j].y & 0xffff0000u); }
    }
}
template <int NEV, bool COMBINE>
DI void nr_phase(Frame& F, const bf16_t* base, const bf16_t* Y, const int* slot, bf16_t* xout, const float* g, bf16_t* XN, unsigned char* XN8,
                 const float* Wsrc, int ldw, int col0, float* outv, const float* b_i, const float* b_f) {
    LAS float* Wt = (LAS float*)F.lds;
    { f32x4 wv[NEV / 2];
#pragma unroll
      for (int i = 0; i < NEV / 2; ++i) { const int idx = F.tid + i * NTHR, d = idx / (NEV / 4), e4 = idx % (NEV / 4); wv[i] = *(const f32x4*)(Wsrc + (size_t)d * ldw + col0 + 4 * e4); }
#pragma unroll
      for (int i = 0; i < NEV / 2; ++i) { const int idx = F.tid + i * NTHR, d = idx / (NEV / 4), e4 = idx % (NEV / 4);
#pragma unroll
          for (int q = 0; q < 4; ++q) Wt[(4 * e4 + q) * 1024 + d] = wv[i][q]; } }
    const int gw = F.vcu * NWAVES + F.wave, NGW = F.G * NWAVES, lane = F.lane;
    LAS float* res = (LAS float*)(F.lds + AUX_OFF) + F.wave * 64;
    f32x4 gg[4];
#pragma unroll
    for (int j = 0; j < 4; ++j) gg[j] = *((const f32x4*)g + lane + 64 * j);
    __syncthreads();
#pragma unroll 1
    for (int m0 = gw; m0 < M; m0 += 4 * NGW) {
        f32x4 x[4][4]; int sl[4];
#pragma unroll
        for (int t4 = 0; t4 < 4; ++t4) { const int m = m0 + t4 * NGW < M ? m0 + t4 * NGW : m0;
#pragma unroll
            for (int j = 0; j < 4; ++j) { const u32x2 w = __builtin_nontemporal_load((const u32x2*)(base + (size_t)m * D) + lane + 64 * j);
                x[t4][j] = (f32x4){__builtin_bit_cast(float, w.x << 16), __builtin_bit_cast(float, w.x & 0xffff0000u), __builtin_bit_cast(float, w.y << 16), __builtin_bit_cast(float, w.y & 0xffff0000u)}; }
            sl[t4] = (COMBINE && lane < NE) ? slot[(size_t)m * NE + lane] : -1; }
#pragma unroll
        for (int pp = 0; pp < 4; pp += 2) {
            int mm[2]; float ssv[2];
#pragma unroll
            for (int u = 0; u < 2; ++u) {
                const int t4 = pp + u; const int m = m0 + t4 * NGW < M ? m0 + t4 * NGW : m0; mm[u] = m;
                if (COMBINE) add_routed_rows(x[t4], Y, sl[t4], m / SEQ, lane);
                if (xout) {
#pragma unroll
                    for (int j = 0; j < 4; ++j) { u32x2 w; w.x = cvt_pk_bf16(x[t4][j].x, x[t4][j].y); w.y = cvt_pk_bf16(x[t4][j].z, x[t4][j].w); *((u32x2*)(xout + (size_t)m * D) + lane + 64 * j) = w;
                        x[t4][j] = (f32x4){__builtin_bit_cast(float, w.x << 16), __builtin_bit_cast(float, w.x & 0xffff0000u), __builtin_bit_cast(float, w.y << 16), __builtin_bit_cast(float, w.y & 0xffff0000u)}; }
                }
                float ss = 0.f;
#pragma unroll
                for (int j = 0; j < 4; ++j) ss += (x[t4][j].x * x[t4][j].x + x[t4][j].y * x[t4][j].y) + (x[t4][j].z * x[t4][j].z + x[t4][j].w * x[t4][j].w);
                const float sst = wave_sum(ss); ssv[u] = sst;
                const float rinv = NEV == 16 ? 1.f : __builtin_amdgcn_rsqf(sst * (1.f / D) + RMS_EPS);
#pragma unroll
                for (int j = 0; j < 4; ++j) { x[t4][j] = x[t4][j] * rinv * gg[j];
                    if (NEV == 32) *((unsigned long long*)(XN + (size_t)m * D) + lane + 64 * j) = (unsigned long long)pk2(x[t4][j].x, x[t4][j].y) | ((unsigned long long)pk2(x[t4][j].z, x[t4][j].w) << 32);
                    else *((unsigned*)(XN8 + (size_t)m * D) + lane + 64 * j) = pk4_fp8(x[t4][j].x, x[t4][j].y, x[t4][j].z, x[t4][j].w); }
            }
#pragma unroll 1
            for (int eg = 0; eg < NEV / 4; ++eg) {
                float v8[8];
#pragma unroll
                for (int e4 = 0; e4 < 4; ++e4) { float s0 = 0.f, s1 = 0.f;
#pragma unroll
                    for (int j = 0; j < 4; ++j) { const f32x4 w = *((const LAS f32x4*)(Wt + (4 * eg + e4) * 1024) + lane + 64 * j);
                        s0 += (x[pp][j].x * w.x + x[pp][j].y * w.y) + (x[pp][j].z * w.z + x[pp][j].w * w.w); s1 += (x[pp + 1][j].x * w.x + x[pp + 1][j].y * w.y) + (x[pp + 1][j].z * w.z + x[pp + 1][j].w * w.w); }
                    v8[e4] = s0; v8[4 + e4] = s1; }
                const int i8 = multi_reduce<8>(v8, lane);
                if ((lane & 7) == 0) res[(i8 >> 2) * 32 + 4 * eg + (i8 & 3)] = v8[0];
            }
            asm volatile("s_waitcnt lgkmcnt(0)" ::: "memory");
            if (NEV == 16) {
                const int u = (lane >> 4) & 1, e = lane & 15, m = mm[u];
                if (lane < 32) { outv[(size_t)e * M + m] = res[u * 32 + e]; if (e == 0) outv[(size_t)16 * M + m] = ssv[u]; }
#pragma unroll
                for (int q = 0; q < 2; ++q) { const int idx = lane + 64 * q; if (idx < 102) { const int uu = idx / 51, r51 = idx % 51; outv[(size_t)(17 + r51) * M + mm[uu]] = 0.f; } }
            } else {
                const int u = lane >> 5, k = lane & 31, m = mm[u];
                const float v = res[u * 32 + k];
                const int kind = k >> 3, hd = k & 7, dir = kind >> 1;
                outv[(size_t)m * 32 + k] = (kind & 1) ? log_sigmoid(v + b_f[dir * 8 + hd]) : v + b_i[dir * 8 + hd];
            }
            asm volatile("" ::: "memory");
        }
    }
}
constexpr int NRM_WB = 0, NRM_WB_LD = 2128, NRM_XR = 32 * NRM_WB_LD, NRM_XR_LD = 2112;
static_assert(NRM_XR + NWAVES * 4 * NRM_XR_LD <= AUX_OFF + AUX_BYTES, "nrm_phase LDS");
DI void nrm_phase(Frame& F, const bf16_t* base, const bf16_t* Y, const int* slot, bf16_t* xout, const float* g, bf16_t* XN, unsigned char* XN8,
                  const float* Wsrc, int ldw, int col0, float* outv, const float* b_i, const float* b_f) {
    LAS unsigned char* lds = F.lds;
    { f32x4 wv[16];
#pragma unroll
      for (int i = 0; i < 16; ++i) { const int idx = F.tid + i * NTHR, d = idx >> 3, e4 = idx & 7; wv[i] = *(const f32x4*)(Wsrc + (size_t)d * ldw + col0 + 4 * e4); }
#pragma unroll
      for (int i = 0; i < 16; ++i) { const int idx = F.tid + i * NTHR, d = idx >> 3, e4 = idx & 7;
#pragma unroll
          for (int q = 0; q < 4; ++q) *(LAS unsigned short*)(lds + NRM_WB + (4 * e4 + q) * NRM_WB_LD + d * 2) = (unsigned short)f2bf(wv[i][q]); } }
    const int gw = F.vcu * NWAVES + F.wave, NGW = F.G * NWAVES, lane = F.lane, fr = lane & 15, fq = lane >> 4;
    LAS unsigned char* xr = lds + NRM_XR + F.wave * 4 * NRM_XR_LD;
    f32x4 gg[4];
#pragma unroll
    for (int j = 0; j < 4; ++j) gg[j] = *((const f32x4*)g + lane + 64 * j);
    float bias[2]; bool isf[2];
#pragma unroll
    for (int n = 0; n < 2; ++n) { const int k = fr + 16 * n, kind = k >> 3, hd = k & 7, dir = kind >> 1; isf[n] = (kind & 1) != 0; bias[n] = isf[n] ? b_f[dir * 8 + hd] : b_i[dir * 8 + hd]; }
    __syncthreads();
#pragma unroll 1
    for (int m0 = gw; m0 < M; m0 += 4 * NGW) {
        f32x4 x[4][4]; int sl[4]; int mm[4];
#pragma unroll
        for (int t4 = 0; t4 < 4; ++t4) { const int m = m0 + t4 * NGW < M ? m0 + t4 * NGW : m0; mm[t4] = m;
#pragma unroll
            for (int j = 0; j < 4; ++j) { const u32x2 w = __builtin_nontemporal_load((const u32x2*)(base + (size_t)m * D) + lane + 64 * j);
                x[t4][j] = (f32x4){__builtin_bit_cast(float, w.x << 16), __builtin_bit_cast(float, w.x & 0xffff0000u), __builtin_bit_cast(float, w.y << 16), __builtin_bit_cast(float, w.y & 0xffff0000u)}; }
            sl[t4] = lane < NE ? slot[(size_t)m * NE + lane] : -1; }
#pragma unroll
        for (int t4 = 0; t4 < 4; ++t4) { const int m = mm[t4];
            add_routed_rows(x[t4], Y, sl[t4], m / SEQ, lane);
#pragma unroll
            for (int j = 0; j < 4; ++j) { u32x2 w; w.x = cvt_pk_bf16(x[t4][j].x, x[t4][j].y); w.y = cvt_pk_bf16(x[t4][j].z, x[t4][j].w); *((u32x2*)(xout + (size_t)m * D) + lane + 64 * j) = w;
                x[t4][j] = (f32x4){__builtin_bit_cast(float, w.x << 16), __builtin_bit_cast(float, w.x & 0xffff0000u), __builtin_bit_cast(float, w.y << 16), __builtin_bit_cast(float, w.y & 0xffff0000u)}; }
            float ss = 0.f;
#pragma unroll
            for (int j = 0; j < 4; ++j) ss += (x[t4][j].x * x[t4][j].x + x[t4][j].y * x[t4][j].y) + (x[t4][j].z * x[t4][j].z + x[t4][j].w * x[t4][j].w);
            const float rinv = __builtin_amdgcn_rsqf(wave_sum(ss) * (1.f / D) + RMS_EPS);
#pragma unroll
            for (int j = 0; j < 4; ++j) { const f32x4 hn = x[t4][j] * rinv * gg[j]; u32x2 w; w.x = cvt_pk_bf16(hn.x, hn.y); w.y = cvt_pk_bf16(hn.z, hn.w);
                *((u32x2*)(XN + (size_t)m * D) + lane + 64 * j) = w; *(LAS u32x2*)(xr + t4 * NRM_XR_LD + (4 * lane + 256 * j) * 2) = w;
                *((unsigned*)(XN8 + (size_t)m * D) + lane + 64 * j) = pk4_fp8(hn.x, hn.y, hn.z, hn.w); }
        }
        asm volatile("s_waitcnt lgkmcnt(0)" ::: "memory");
        f32x4 ga[2] = {(f32x4){0.f, 0.f, 0.f, 0.f}, (f32x4){0.f, 0.f, 0.f, 0.f}};
#pragma unroll 4
        for (int ks = 0; ks < 32; ++ks) {
            bf16x8 a = (bf16x8){0, 0, 0, 0, 0, 0, 0, 0};
            if (fr < 4) a = *(const LAS bf16x8*)(xr + fr * NRM_XR_LD + (32 * ks + 8 * fq) * 2);
            const bf16x8 b0 = *(const LAS bf16x8*)(lds + NRM_WB + fr * NRM_WB_LD + (32 * ks + 8 * fq) * 2), b1 = *(const LAS bf16x8*)(lds + NRM_WB + (16 + fr) * NRM_WB_LD + (32 * ks + 8 * fq) * 2);
            ga[0] = __builtin_amdgcn_mfma_f32_16x16x32_bf16(a, b0, ga[0], 0, 0, 0); ga[1] = __builtin_amdgcn_mfma_f32_16x16x32_bf16(a, b1, ga[1], 0, 0, 0);
        }
        if (fq == 0) {
#pragma unroll
            for (int n = 0; n < 2; ++n)
#pragma unroll
                for (int j = 0; j < 4; ++j) { const float v = ga[n][j] + bias[n]; outv[(size_t)mm[j] * 32 + fr + 16 * n] = isf[n] ? log_sigmoid(v) : v; } }
        asm volatile("" ::: "memory");
    }
}
DI int block_excl_scan(int v, LAS int* wsum, int lane, int wave, int& total) {
    int inc = v;
#pragma unroll
    for (int o = 1; o < 64; o <<= 1) { const int t = __shfl_up(inc, o); if (lane >= o) inc += t; }
    if (lane == 63) wsum[wave] = inc;
    __syncthreads();
    int basev = 0, tot = 0;
#pragma unroll
    for (int w = 0; w < NWAVES; ++w) { const int x = wsum[w]; basev += (w < wave) ? x : 0; tot += x; }
    __syncthreads();
    total = tot;
    return basev + inc - v;
}
DI void topk_phase(Frame& F, const float* part, int* idxrow, float* gate, float* rsc, int* slot) {
    LAS unsigned* hist = (LAS unsigned*)F.lds; LAS unsigned* sh = hist + 4096; LAS int* wsum = (LAS int*)(hist + 4112);
    const int tid = F.tid;
    for (int p = blockIdx.x; p < NB * NE; p += F.G) {
        const int b = p / NE, e = p % NE;
        unsigned v[8]; float rinv8[8];
        { const float* pb = part + (size_t)b * SEQ + 8 * tid;
          float ssum[8], mx[8], sm[8], lm[8];
#pragma unroll
          for (int i = 0; i < 8; ++i) { ssum[i] = 0.f; mx[i] = -__builtin_inff(); sm[i] = 0.f; lm[i] = 0.f; }
#pragma unroll
          for (int pn = 0; pn < 4; ++pn) { const f32x4 a0 = *(const f32x4*)(pb + (size_t)(pn * 17 + 16) * M), a1 = *(const f32x4*)(pb + (size_t)(pn * 17 + 16) * M + 4);
#pragma unroll
              for (int i = 0; i < 4; ++i) { ssum[i] += a0[i]; ssum[4 + i] += a1[i]; } }
#pragma unroll
          for (int i = 0; i < 8; ++i) rinv8[i] = __builtin_amdgcn_rsqf(ssum[i] * (1.f / D) + RMS_EPS);
#pragma unroll 4
          for (int ee = 0; ee < NE; ++ee) { float l[8];
#pragma unroll
              for (int i = 0; i < 8; ++i) l[i] = 0.f;
#pragma unroll
              for (int pn = 0; pn < 4; ++pn) { const f32x4 a0 = *(const f32x4*)(pb + (size_t)(pn * 17 + ee) * M), a1 = *(const f32x4*)(pb + (size_t)(pn * 17 + ee) * M + 4);
#pragma unroll
                  for (int i = 0; i < 4; ++i) { l[i] += a0[i]; l[4 + i] += a1[i]; } }
#pragma unroll
              for (int i = 0; i < 8; ++i) { const float li = l[i] * rinv8[i], mn = fmaxf(mx[i], li); sm[i] = sm[i] * __expf(mx[i] - mn) + __expf(li - mn); mx[i] = mn; lm[i] = ee == e ? li : lm[i]; } }
#pragma unroll
          for (int i = 0; i < 8; ++i) v[i] = __builtin_bit_cast(unsigned, __expf(lm[i] - mx[i]) / sm[i]); }
        unsigned prefix = 0u; int need = CAP;
#pragma unroll 1
        for (int pass = 0; pass < 3; ++pass) {
            const int shift = pass == 0 ? 20 : (pass == 1 ? 8 : 0), hs = pass == 0 ? 31 : (pass == 1 ? 20 : 8);
            *((LAS u32x4*)hist + 2 * tid) = (u32x4){0u, 0u, 0u, 0u}; *((LAS u32x4*)hist + 2 * tid + 1) = (u32x4){0u, 0u, 0u, 0u};
            __syncthreads();
#pragma unroll
            for (int i = 0; i < 8; ++i) if (pass == 0 || (v[i] >> hs) == prefix) __hip_atomic_fetch_add(&hist[(v[i] >> shift) & (pass == 2 ? 0xffu : 0xfffu)], 1u, __ATOMIC_RELAXED, __HIP_MEMORY_SCOPE_WORKGROUP);
            __syncthreads();
            const u32x4 c0 = *((const LAS u32x4*)hist + 2 * tid), c1 = *((const LAS u32x4*)hist + 2 * tid + 1);
            const int cnt[8] = {(int)c0.x, (int)c0.y, (int)c0.z, (int)c0.w, (int)c1.x, (int)c1.y, (int)c1.z, (int)c1.w};
            const int ls = ((cnt[0] + cnt[1]) + (cnt[2] + cnt[3])) + ((cnt[4] + cnt[5]) + (cnt[6] + cnt[7]));
            int tot; const int pre = block_excl_scan(ls, wsum, F.lane, F.wave, tot);
            int run = tot - pre - ls;
#pragma unroll
            for (int j = 7; j >= 0; --j) { if (run < need && run + cnt[j] >= need) { sh[0] = (unsigned)(8 * tid + j); sh[1] = (unsigned)(need - run); } run += cnt[j]; }
            __syncthreads();
            prefix = pass == 0 ? sh[0] : ((prefix << (pass == 1 ? 12 : 8)) | sh[0]); need = (int)sh[1];
        }
        const unsigned T = prefix;
        int ce = 0;
#pragma unroll
        for (int i = 0; i < 8; ++i) ce += (v[i] == T) ? 1 : 0;
        int tot;
        int eqr = block_excl_scan(ce, wsum, F.lane, F.wave, tot);
        unsigned selm = 0u; int cs = 0;
#pragma unroll
        for (int i = 0; i < 8; ++i) { bool sel = v[i] > T; if (v[i] == T) { sel = eqr < need; ++eqr; } if (sel) { selm |= 1u << i; ++cs; } }
        int pos = block_excl_scan(cs, wsum, F.lane, F.wave, tot);
#pragma unroll
        for (int i = 0; i < 8; ++i) { const int t = 8 * tid + i; int sv = -1;
            if (selm & (1u << i)) { const int row = (e * NB + b) * CAP + pos; idxrow[row] = b * SEQ + t; gate[row] = __builtin_bit_cast(float, v[i]); rsc[row] = rinv8[i]; sv = pos; ++pos; }
            slot[(size_t)(b * SEQ + t) * NE + e] = sv; }
        __syncthreads();
    }
}
DI void combine_phase(Frame& F, const bf16_t* base, const bf16_t* Y, const int* slot, float* out) {
    const int gw = F.vcu * NWAVES + F.wave, NGW = F.G * NWAVES, lane = F.lane;
    for (int m0 = gw; m0 < M; m0 += 4 * NGW) {
        f32x4 x[4][4]; int sl[4];
#pragma unroll
        for (int t4 = 0; t4 < 4; ++t4) { const int m = m0 + t4 * NGW < M ? m0 + t4 * NGW : m0;
#pragma unroll
            for (int j = 0; j < 4; ++j) { const u32x2 w = __builtin_nontemporal_load((const u32x2*)(base + (size_t)m * D) + lane + 64 * j);
                x[t4][j] = (f32x4){__builtin_bit_cast(float, w.x << 16), __builtin_bit_cast(float, w.x & 0xffff0000u), __builtin_bit_cast(float, w.y << 16), __builtin_bit_cast(float, w.y & 0xffff0000u)}; }
            sl[t4] = lane < NE ? slot[(size_t)m * NE + lane] : -1; }
#pragma unroll
        for (int t4 = 0; t4 < 4; ++t4) { const int m = m0 + t4 * NGW < M ? m0 + t4 * NGW : m0;
            add_routed_rows(x[t4], Y, sl[t4], m / SEQ, lane);
#pragma unroll
            for (int j = 0; j < 4; ++j) __builtin_nontemporal_store(x[t4][j], (f32x4*)(out + (size_t)m * D) + lane + 64 * j); }
    }
}
DI void moe_up_phase(Frame& F, unsigned char* ws, int l) {
    pg8::MoeUpOrder S{F.vcu, F.G, (const char*)(ws + WS_W13 + (size_t)l * W13_LAYER)};
    LAS int* il = (LAS int*)(F.lds + AUX_OFF); const int* idxrow = (const int*)(ws + WS_IDX);
    pg8::Unit u;
    LAS float* rl = (LAS float*)(F.lds + AUX_OFF + 8192); const float* rsc = (const float*)(ws + WS_RSC);
    for (int i = 0; i < 8 && S.next(i, u); ++i) { if (F.tid < 256) il[i * 256 + F.tid] = idxrow[u.pm * 256 + F.tid]; else rl[i * 256 + F.tid - 256] = rsc[u.pm * 256 + F.tid - 256]; }
    __syncthreads();
    pg8::EpiSwiGLU E{(unsigned char*)(ws + WS_H), rl};
    pg8::gemm_phase<pg8::EpiSwiGLU, pg8::MoeUpOrder, true, true, true>(F.lds, il, (const void*)(ws + WS_XN8), D, S, E);
}
DI void moe_down_phase(Frame& F, unsigned char* ws, int l) {
    pg8::MoeDownOrder S{F.vcu, F.G, (const char*)(ws + WS_W2 + (size_t)l * W2_LAYER)};
    pg8::EpiBf16 E{(bf16_t*)(ws + WS_Y), D, (const float*)(ws + WS_GATE), 0.03125f, 0};
    pg8::gemm_phase<pg8::EpiBf16, pg8::MoeDownOrder, false, true, true>(F.lds, nullptr, (const void*)(ws + WS_H), DE, S, E);
}

DI int off128r(int row, int chunk) { return row * 128 + ((chunk ^ ((row >> 1) & 7)) << 4); }
DI int off128t(int row, int colbyte) { return row * 128 + (colbyte ^ (((row >> 1) & 1) << 6)); }
DI int off256t(int row, int colbyte) { return row * 256 + (colbyte ^ ((row & 3) << 6)); }
DI float wave_max(float v) {
#pragma unroll
    for (int o = 1; o < 64; o <<= 1) v = fmaxf(v, __shfl_xor(v, o));
    return v;
}
DI float incl_prefix(float v, int lane) {
#pragma unroll
    for (int o = 1; o < 64; o <<= 1) { const float t = __shfl_up(v, o); if (lane >= o) v += t; }
    return v;
}
DI float incl_suffix(float v, int lane) {
#pragma unroll
    for (int o = 1; o < 64; o <<= 1) { const float t = __shfl_down(v, o); if (lane + o < 64) v += t; }
    return v;
}
DI u32x4 scale_bf16x8(u32x4 v, float w) {
    u32x4 o;
#pragma unroll
    for (int i = 0; i < 4; ++i) { const float lo = __builtin_bit_cast(float, v[i] << 16) * w, hi = __builtin_bit_cast(float, v[i] & 0xffff0000u) * w; o[i] = cvt_pk_bf16(lo, hi); }
    return o;
}
constexpr int SS_KW = 0, SS_V = 32768, SS_WS = 98304, SS_SC = 114688;
DI int ss_kw_off(int row, int colbyte) { return row * 128 + (colbyte ^ ((((row >> 1) & 1) | (((row >> 3) & 1) << 1)) << 5)); }
DI int ss_v_off(int row, int colbyte) { return row * 256 + (colbyte ^ ((row & 3) << 6) ^ (((row >> 3) & 1) << 5)); }
template <int ES> DI void mlstm_scan_seq(Frame& F, unsigned char* ws, int seq, int half) {
    constexpr int NT = 4 / ES, VB = 16384 / ES; const int eoff = half * (128 / ES);
    LAS unsigned char* lds = F.lds;
    const bf16_t* P = (const bf16_t*)(ws + WS_PROJ); const float* MG = (const float*)(ws + WS_MG);
    bf16_t* STATE = (bf16_t*)(ws + WS_STATE); float* NST = (float*)(ws + WS_NST); float* MST = (float*)(ws + WS_MST);
    const int tid = F.tid, lane = F.lane, wave = F.wave, fr = lane & 15, fq = lane >> 4;
    LAS float* WS = (LAS float*)(lds + SS_WS); LAS float* ML = (LAS float*)(lds + SS_SC); LAS float* BL = ML + 64; LAS float* DEC = ML + 128; LAS float* LINJ = ML + 192; LAS float* MENT = ML + 256;
    {
        const int dir = seq >> 5, bh = seq & 31, b = bh >> 3, hd = bh & 7;
        __syncthreads();
        float igv[8], lfv[8];
#pragma unroll
        for (int i = 0; i < 8; ++i) { const float* mg = MG + ((size_t)b * SEQ + 64 * (8 * wave + i) + lane) * 32 + hd; igv[i] = mg[dir ? 16 : 0]; lfv[i] = mg[dir ? 24 : 8]; }
#pragma unroll
        for (int i = 0; i < 8; ++i) { const int c = 8 * wave + i; const float ig = igv[i], lf = lfv[i];
            float g, bl;
            if (dir == 0) { const float bf = incl_prefix(lf, lane); bl = __shfl(bf, 63); g = bl - bf + ig; }
            else { const float sb = incl_suffix(lf, lane); bl = __shfl(sb, 0); g = (bl - sb) + ig; }
            const float ml = wave_max(g);
            WS[c * 64 + lane] = g - ml; if (lane == 0) { ML[c] = ml; BL[c] = bl; } }
        __syncthreads();
        if (wave == 0) { const int cl = dir ? 63 - lane : lane; const float mlv = ML[cl], blv = BL[cl];
            float m = 0.f, dec = 0.f, linj = 0.f, ment = 0.f;
            for (int k = 0; k < 64; ++k) { const float ml = __shfl(mlv, k), bl = __shfl(blv, k); const float mn = fmaxf(bl + m, ml);
                if (lane == k) { dec = __expf(bl + m - mn); linj = ml - mn; ment = m; } m = mn; }
            DEC[lane] = dec; LINJ[cl] = linj; MENT[lane] = ment;
            if (half == 0) MST[(size_t)seq * 64 + cl] = ment; }
        __syncthreads();
#pragma unroll
        for (int i = 0; i < 8; ++i) { const int idx = tid + i * NTHR; WS[idx] = __expf(WS[idx] + LINJ[idx >> 6]); }
        const int krow = tid >> 3, kc = tid & 7;
        const int eh = wave >> 2, dt = wave & 3;
        f32x4 C[NT], Nacc = (f32x4){0.f, 0.f, 0.f, 0.f};
#pragma unroll
        for (int i = 0; i < NT; ++i) C[i] = (f32x4){0.f, 0.f, 0.f, 0.f};
        const bf16x8 ones = (bf16x8){0x3f80, 0x3f80, 0x3f80, 0x3f80, 0x3f80, 0x3f80, 0x3f80, 0x3f80};
        const size_t tokb = (size_t)b * SEQ;
        u32x4 kreg[2][2], vreg[2][2][2 / ES];
#define SS_LOAD(st_, kp_) do { _Pragma("unroll") for (int sb_ = 0; sb_ < 2; ++sb_) { const int kk_ = 2 * (kp_) + sb_; const int cn_ = dir ? 63 - kk_ : kk_; \
            kreg[st_][sb_] = *(const u32x4*)(P + (tokb + 64 * cn_ + krow) * MIN_N + 512 + hd * 64 + kc * 8); \
            _Pragma("unroll") for (int i_ = 0; i_ < 2 / ES; ++i_) { const int idx_ = tid + i_ * NTHR, vr_ = ES == 1 ? idx_ >> 4 : idx_ >> 3, vc_ = ES == 1 ? idx_ & 15 : idx_ & 7; \
                vreg[st_][sb_][i_] = *(const u32x4*)(P + (tokb + 64 * cn_ + vr_) * MIN_N + 1024 + hd * 128 + eoff + vc_ * 8); } } } while (0)
#define SS_PAIR(st, kp) do { const int buf = (kp) & 1; \
            _Pragma("unroll") for (int sb = 0; sb < 2; ++sb) { const int k = 2 * (kp) + sb, c = dir ? 63 - k : k; \
                *(LAS u32x4*)(lds + SS_KW + (buf * 2 + sb) * 8192 + ss_kw_off(krow, kc * 16)) = scale_bf16x8(kreg[st][sb], WS[c * 64 + krow]); \
                _Pragma("unroll") for (int i = 0; i < 2 / ES; ++i) { const int idx = tid + i * NTHR; \
                    *(LAS u32x4*)(lds + SS_V + (buf * 2 + sb) * VB + (ES == 1 ? ss_v_off(idx >> 4, (idx & 15) * 16) : ss_kw_off(idx >> 3, (idx & 7) * 16))) = vreg[st][sb][i]; } } \
            if ((kp) + 2 < 32) SS_LOAD(st, (kp) + 2); \
            asm volatile("s_waitcnt lgkmcnt(0)" ::: "memory"); __builtin_amdgcn_s_barrier(); asm volatile("" ::: "memory"); \
            _Pragma("unroll") for (int sb = 0; sb < 2; ++sb) { const int k = 2 * (kp) + sb, c = dir ? 63 - k : k; \
                _Pragma("unroll") for (int i = 0; i < NT; ++i) { u32x2 w; w.x = cvt_pk_bf16(C[i].x, C[i].y); w.y = cvt_pk_bf16(C[i].z, C[i].w); \
                    *(u32x2*)(STATE + ((size_t)seq * 64 + c) * 8192 + (size_t)(eoff + 16 * (eh + 2 * i) + fr) * 64 + 16 * dt + 4 * fq) = w; } \
                if (half == 0 && eh == 0 && fr == 0) *(f32x4*)(NST + ((size_t)seq * 64 + c) * 64 + 16 * dt + 4 * fq) = Nacc; \
                const float dec = DEC[k]; Nacc = Nacc * dec; \
                _Pragma("unroll") for (int i = 0; i < NT; ++i) C[i] = C[i] * dec; \
                _Pragma("unroll") for (int s2 = 0; s2 < 2; ++s2) { \
                    const int r0 = 32 * s2 + 8 * fq + ((lane & 15) >> 2), r1 = r0 + 4, cbk = 32 * dt + 8 * (lane & 3); \
                    const bf16x8 af = cat8(tr_read(lds + SS_KW + (buf * 2 + sb) * 8192 + ss_kw_off(r0, cbk)), tr_read(lds + SS_KW + (buf * 2 + sb) * 8192 + ss_kw_off(r1, cbk))); \
                    _Pragma("unroll") for (int i = 0; i < NT; ++i) { const int cbv = 32 * (eh + 2 * i) + 8 * (lane & 3); \
                        const bf16x8 bfv = cat8(tr_read(lds + SS_V + (buf * 2 + sb) * VB + (ES == 1 ? ss_v_off(r0, cbv) : ss_kw_off(r0, cbv))), tr_read(lds + SS_V + (buf * 2 + sb) * VB + (ES == 1 ? ss_v_off(r1, cbv) : ss_kw_off(r1, cbv)))); \
                        C[i] = __builtin_amdgcn_mfma_f32_16x16x32_bf16(af, bfv, C[i], 0, 0, 0); } \
                    if (eh == 0) Nacc = __builtin_amdgcn_mfma_f32_16x16x32_bf16(af, ones, Nacc, 0, 0, 0); } } } while (0)
        SS_LOAD(0, 0); SS_LOAD(1, 1);
        __syncthreads();
#pragma unroll 1
        for (int kp2 = 0; kp2 < 32; kp2 += 2) { SS_PAIR(0, kp2); SS_PAIR(1, kp2 + 1); }
#undef SS_PAIR
#undef SS_LOAD
    }
}
constexpr int SCAN_ES = 2, SCAN_WGS = 64 * SCAN_ES, SCAN_STRIDE = 256 / SCAN_WGS;
DI void mlstm_scan_phase(Frame& F, const Args& a) {
    if (F.G == 256) {
        if (F.vcu % SCAN_STRIDE == 0) { const int sw = F.vcu / SCAN_STRIDE; mlstm_scan_seq<SCAN_ES>(F, a.ws, sw / SCAN_ES, sw % SCAN_ES); }
        else expert_conv_items(F, a, XI_C_END, XI_TOTAL, ((F.vcu / SCAN_STRIDE) * (SCAN_STRIDE - 1) + F.vcu % SCAN_STRIDE - 1) * NWAVES + F.wave, (256 - SCAN_WGS) * NWAVES);
    } else {
        for (int sw = F.vcu; sw < SCAN_WGS; sw += F.G) mlstm_scan_seq<SCAN_ES>(F, a.ws, sw / SCAN_ES, sw % SCAN_ES);
        if (F.vcu == 0) expert_conv_items(F, a, XI_C_END, XI_TOTAL, F.wave, NWAVES);
    }
}
constexpr int S3_Q = 0, S3_KF = 8192, S3_KB = 16384, S3_V = 24576, S3_CF = 40960, S3_CB = 57344, S3_HS = 73728, S3_HS_LD = 132, S3_SM = 108544;
DI float incl_prefix_max(float v, int lane) {
#pragma unroll
    for (int o = 1; o < 64; o <<= 1) { const float t = __shfl_up(v, o); if (lane >= o) v = fmaxf(v, t); }
    return v;
}
DI float incl_suffix_max(float v, int lane) {
#pragma unroll
    for (int o = 1; o < 64; o <<= 1) { const float t = __shfl_down(v, o); if (lane + o < 64) v = fmaxf(v, t); }
    return v;
}
DI void mlstm_s3_phase(Frame& F, const Args& a) {
    unsigned char* ws = a.ws; LAS unsigned char* lds = F.lds;
    const bf16_t* P = (const bf16_t*)(ws + WS_PROJ); const float* MG = (const float*)(ws + WS_MG);
    const bf16_t* STATE = (const bf16_t*)(ws + WS_STATE); const float* NST = (const float*)(ws + WS_NST); const float* MST = (const float*)(ws + WS_MST);
    bf16_t* Y2 = (bf16_t*)(ws + WS_Y2); const float* outg = a.in[IN_MOG];
    const int tid = F.tid, lane = F.lane, wave = F.wave, r = lane & 31, h = lane >> 5;
    const int q4 = (lane & 15) >> 2, p4 = lane & 3, blk = (lane >> 4) & 1;
    LAS float* ALPHA = (LAS float*)(lds + S3_SM); LAS float* EA = ALPHA + 128; LAS float* EMT = ALPHA + 256; LAS unsigned short* NB16 = (LAS unsigned short*)(ALPHA + 384);
    LAS float* HS = (LAS float*)(lds + S3_HS);
    u32x4 rq, rk, rv[2], rcf[2], rcb[2], rog[2]; float pg[4], pn[2], pm_f = 0.f, pm_b = 0.f;
#define S3_LOAD(u_) do { const int c_ = (u_) & 63, bh_ = (u_) >> 6, b_ = bh_ >> 3, hd_ = bh_ & 7; const size_t tk_ = (size_t)b_ * SEQ + 64 * c_; \
        { const int row = tid >> 3, kc = tid & 7; rq = *(const u32x4*)(P + (tk_ + row) * MIN_N + hd_ * 64 + kc * 8); rk = *(const u32x4*)(P + (tk_ + row) * MIN_N + 512 + hd_ * 64 + kc * 8); } \
        _Pragma("unroll") for (int i = 0; i < 2; ++i) { const int idx = tid + i * NTHR, row = idx >> 4, c16 = idx & 15; \
            rv[i] = *(const u32x4*)(P + (tk_ + row) * MIN_N + 1024 + hd_ * 128 + c16 * 8); \
            rcf[i] = __builtin_nontemporal_load((const u32x4*)(STATE + ((size_t)(0 * 32 + bh_) * 64 + c_) * 8192) + idx); rcb[i] = __builtin_nontemporal_load((const u32x4*)(STATE + ((size_t)(1 * 32 + bh_) * 64 + c_) * 8192) + idx); } \
        { const bf16_t* ogp_ = P + (tk_ + (tid >> 3)) * MIN_N + 2048 + hd_ * 128 + (tid & 7) * 16; rog[0] = *(const u32x4*)ogp_; rog[1] = *(const u32x4*)(ogp_ + 8); } \
        pm_f = MST[(size_t)(0 * 32 + bh_) * 64 + c_]; pm_b = MST[(size_t)(1 * 32 + bh_) * 64 + c_]; \
        { const float* mg = MG + (tk_ + lane) * 32; pg[0] = mg[hd_]; pg[1] = mg[8 + hd_]; pg[2] = mg[16 + hd_]; pg[3] = mg[24 + hd_]; \
          pn[0] = NST[((size_t)(0 * 32 + bh_) * 64 + c_) * 64 + lane]; pn[1] = NST[((size_t)(1 * 32 + bh_) * 64 + c_) * 64 + lane]; } } while (0)
    if (F.vcu < 2048) S3_LOAD(F.vcu);
    for (int u = F.vcu; u < 2048; u += F.G) {
        const int c = u & 63, bh = u >> 6, b = bh >> 3, hd = bh & 7; const size_t tok0 = (size_t)b * SEQ + 64 * c;
        const float m_f = pm_f, m_b = pm_b;
        const float bf = incl_prefix(pg[1], lane), uf = pg[0] - bf, umf = wave_max(uf), cmf = incl_prefix_max(uf, lane);
        const float sb = incl_suffix(pg[3], lane), ub = pg[2] - sb, umb = wave_max(ub), cmb = incl_suffix_max(ub, lane);
        const float beta_f = __expf(uf - umf), beta_b = __expf(ub - umb);
        const float af_ = bf + m_f, mtf = fmaxf(af_, bf + cmf), ab_ = sb + m_b, mtb = fmaxf(ab_, sb + cmb);
        __syncthreads();
        if (wave == 0) { ALPHA[lane] = __expf(bf + umf - mtf); EA[lane] = __expf(af_ - mtf); EMT[lane] = __expf(-mtf);
            ALPHA[64 + lane] = __expf(sb + umb - mtb); EA[64 + lane] = __expf(ab_ - mtb); EMT[64 + lane] = __expf(-mtb);
            NB16[lane] = (unsigned short)f2bf(pn[0]); NB16[64 + lane] = (unsigned short)f2bf(pn[1]); }
        { const int row = tid >> 3, kc = tid & 7; const float wf = __shfl(beta_f, row & 63), wb = __shfl(beta_b, row & 63);
          *(LAS u32x4*)(lds + S3_Q + off128r(row, kc)) = rq;
          *(LAS u32x4*)(lds + S3_KF + off128r(row, kc)) = scale_bf16x8(rk, wf); *(LAS u32x4*)(lds + S3_KB + off128r(row, kc)) = scale_bf16x8(rk, wb); }
#pragma unroll
        for (int i = 0; i < 2; ++i) { const int idx = tid + i * NTHR, row = idx >> 4, c16 = idx & 15, erow = idx >> 3, ec = idx & 7;
            *(LAS u32x4*)(lds + S3_V + off256t(row, c16 * 16)) = rv[i];
            *(LAS u32x4*)(lds + S3_CF + off128r(erow, ec)) = rcf[i]; *(LAS u32x4*)(lds + S3_CB + off128r(erow, ec)) = rcb[i]; }
        const u32x4 og0 = rog[0], og1 = rog[1];
        if (u + F.G < 2048) S3_LOAD(u + F.G);
        __syncthreads();
        const int et = wave >> 1, tt = wave & 1, t = 32 * tt + r;
        bf16x8 qf[4];
#pragma unroll
        for (int s4 = 0; s4 < 4; ++s4) qf[s4] = *(const LAS bf16x8*)(lds + S3_Q + off128r(t, 2 * s4 + h));
        f32x16 pF, pB, pO;
#pragma unroll
        for (int i = 0; i < 16; ++i) { pF[i] = 0.f; pB[i] = 0.f; pO[i] = 0.f; }
        const int so = 1 - tt; const int koff = tt == 0 ? S3_KB : S3_KF;
#pragma unroll
        for (int s4 = 0; s4 < 4; ++s4) {
            const bf16x8 kF = *(const LAS bf16x8*)(lds + S3_KF + off128r(32 * tt + r, 2 * s4 + h)), kB = *(const LAS bf16x8*)(lds + S3_KB + off128r(32 * tt + r, 2 * s4 + h));
            const bf16x8 kO = *(const LAS bf16x8*)(lds + koff + off128r(32 * so + r, 2 * s4 + h));
            pF = __builtin_amdgcn_mfma_f32_32x32x16_bf16(kF, qf[s4], pF, 0, 0, 0);
            pB = __builtin_amdgcn_mfma_f32_32x32x16_bf16(kB, qf[s4], pB, 0, 0, 0);
            pO = __builtin_amdgcn_mfma_f32_32x32x16_bf16(kO, qf[s4], pO, 0, 0, 0);
        }
        float rsF = 0.f, rsB = 0.f, rsO = 0.f;
#pragma unroll
        for (int i = 0; i < 16; ++i) { const int sl_ = (i & 3) + 8 * (i >> 2) + 4 * h;
            pF[i] = sl_ <= r ? pF[i] : 0.f; pB[i] = sl_ >= r ? pB[i] : 0.f; rsF += pF[i]; rsB += pB[i]; rsO += pO[i]; }
        rsF += __shfl_xor(rsF, 32); rsB += __shfl_xor(rsB, 32); rsO += __shfl_xor(rsO, 32);
        if (tt == 0) rsB += rsO; else rsF += rsO;
        asm volatile("" ::: "memory");
        float qnf, qnb;
        {   f32x16 qn;
#pragma unroll
            for (int i = 0; i < 16; ++i) qn[i] = 0.f;
#pragma unroll
            for (int s4 = 0; s4 < 4; ++s4) { const bf16x8 nF = *(const LAS bf16x8*)(NB16 + 16 * s4 + 8 * h); qn = __builtin_amdgcn_mfma_f32_32x32x16_bf16(nF, qf[s4], qn, 0, 0, 0); }
            qnf = qn[0];
#pragma unroll
            for (int i = 0; i < 16; ++i) qn[i] = 0.f;
#pragma unroll
            for (int s4 = 0; s4 < 4; ++s4) { const bf16x8 nB = *(const LAS bf16x8*)(NB16 + 64 + 16 * s4 + 8 * h); qn = __builtin_amdgcn_mfma_f32_32x32x16_bf16(nB, qf[s4], qn, 0, 0, 0); }
            qnb = qn[0]; }
        const float alF = ALPHA[t], eaF = EA[t], emF = EMT[t], alB = ALPHA[64 + t], eaB = EA[64 + t], emB = EMT[64 + t];
        const float invF = 1.f / fmaxf(fabsf(eaF * qnf + alF * rsF), emF), invB = 1.f / fmaxf(fabsf(eaB * qnb + alB * rsB), emB);
        asm volatile("" ::: "memory");
        f32x16 hs;
        const int cbv = 64 * et + 32 * blk + 8 * p4;
        {   f32x16 it, in;
#pragma unroll
            for (int i = 0; i < 16; ++i) { it[i] = 0.f; in[i] = 0.f; }
#pragma unroll
            for (int s4 = 0; s4 < 4; ++s4) { const bf16x8 cF = *(const LAS bf16x8*)(lds + S3_CF + off128r(32 * et + r, 2 * s4 + h)); it = __builtin_amdgcn_mfma_f32_32x32x16_bf16(cF, qf[s4], it, 0, 0, 0); }
#pragma unroll
            for (int s2 = 0; s2 < 2; ++s2) { const int rd0 = 32 * tt + 16 * s2 + 4 * h + q4;
                const bf16x8 vD = cat8(tr_read(lds + S3_V + off256t(rd0, cbv)), tr_read(lds + S3_V + off256t(rd0 + 8, cbv)));
                in = __builtin_amdgcn_mfma_f32_32x32x16_bf16(vD, pack_step(pF, s2), in, 0, 0, 0);
                if (tt == 1) { const int ro0 = 16 * s2 + 4 * h + q4; const bf16x8 vO = cat8(tr_read(lds + S3_V + off256t(ro0, cbv)), tr_read(lds + S3_V + off256t(ro0 + 8, cbv)));
                    in = __builtin_amdgcn_mfma_f32_32x32x16_bf16(vO, pack_step(pO, s2), in, 0, 0, 0); } }
#pragma unroll
            for (int i = 0; i < 16; ++i) hs[i] = (eaF * it[i] + alF * in[i]) * invF;
        }
        asm volatile("" ::: "memory");
        {   f32x16 it, in;
#pragma unroll
            for (int i = 0; i < 16; ++i) { it[i] = 0.f; in[i] = 0.f; }
#pragma unroll
            for (int s4 = 0; s4 < 4; ++s4) { const bf16x8 cB = *(const LAS bf16x8*)(lds + S3_CB + off128r(32 * et + r, 2 * s4 + h)); it = __builtin_amdgcn_mfma_f32_32x32x16_bf16(cB, qf[s4], it, 0, 0, 0); }
#pragma unroll
            for (int s2 = 0; s2 < 2; ++s2) { const int rd0 = 32 * tt + 16 * s2 + 4 * h + q4;
                const bf16x8 vD = cat8(tr_read(lds + S3_V + off256t(rd0, cbv)), tr_read(lds + S3_V + off256t(rd0 + 8, cbv)));
                in = __builtin_amdgcn_mfma_f32_32x32x16_bf16(vD, pack_step(pB, s2), in, 0, 0, 0);
                if (tt == 0) { const int ro0 = 32 + 16 * s2 + 4 * h + q4; const bf16x8 vO = cat8(tr_read(lds + S3_V + off256t(ro0, cbv)), tr_read(lds + S3_V + off256t(ro0 + 8, cbv)));
                    in = __builtin_amdgcn_mfma_f32_32x32x16_bf16(vO, pack_step(pO, s2), in, 0, 0, 0); } }
#pragma unroll
            for (int i = 0; i < 16; ++i) hs[i] += (eaB * it[i] + alB * in[i]) * invB;
        }
#pragma unroll
        for (int i = 0; i < 16; ++i) HS[t * S3_HS_LD + 32 * et + (i & 3) + 8 * (i >> 2) + 4 * h] = hs[i];
        __syncthreads();
        { const int tr = tid >> 3, e0 = (tid & 7) * 16; float vv[16]; float ss = 0.f;
#pragma unroll
          for (int i = 0; i < 4; ++i) { const f32x4 x = *(const LAS f32x4*)(HS + tr * S3_HS_LD + e0 + 4 * i); vv[4 * i] = x[0]; vv[4 * i + 1] = x[1]; vv[4 * i + 2] = x[2]; vv[4 * i + 3] = x[3]; ss += (x[0] * x[0] + x[1] * x[1]) + (x[2] * x[2] + x[3] * x[3]); }
          ss += __shfl_xor(ss, 1); ss += __shfl_xor(ss, 2); ss += __shfl_xor(ss, 4);
          const float rinv = __builtin_amdgcn_rsqf(ss * (1.f / 128.f) + RMS_EPS);
          unsigned ow[8];
#pragma unroll
          for (int i = 0; i < 8; ++i) { const unsigned w = i < 4 ? og0[i] : og1[i - 4];
              const float o0 = __builtin_bit_cast(float, w << 16), o1 = __builtin_bit_cast(float, w & 0xffff0000u);
              const float g0 = outg[hd * 128 + e0 + 2 * i], g1 = outg[hd * 128 + e0 + 2 * i + 1];
              const float y0 = vv[2 * i] * rinv * g0 / (1.f + __expf(-o0)), y1 = vv[2 * i + 1] * rinv * g1 / (1.f + __expf(-o1));
              ow[i] = cvt_pk_bf16(y0, y1); }
          bf16_t* yp = Y2 + (tok0 + tr) * D + hd * 128 + e0;
          *(u32x4*)yp = (u32x4){ow[0], ow[1], ow[2], ow[3]}; *(u32x4*)(yp + 8) = (u32x4){ow[4], ow[5], ow[6], ow[7]}; }
    }
#undef S3_LOAD
}

__global__ void __launch_bounds__(NTHR, 2) fwd_kernel(Args args) {
    extern __shared__ __attribute__((aligned(16))) unsigned char lds_raw[];
    Frame F;
    F.lds = (LAS unsigned char*)lds_raw;
    F.MISC = (volatile LAS unsigned*)(F.lds + MISC_OFF);
    F.tid = threadIdx.x; F.lane = F.tid & 63; F.wave = __builtin_amdgcn_readfirstlane(F.tid >> 6);
    F.G = gridDim.x; { const int bx = blockIdx.x; F.vcu = (F.G % 8 == 0) ? (bx % 8) * (F.G / 8) + bx / 8 : bx; }
    F.ctl = (unsigned*)(args.ws + WS_CTL);
    if (F.tid < 64) F.MISC[F.tid] = 0u;
    __syncthreads();
    XcdBarrier bar = xcd_barrier_post(F.ctl + CW_BAR, F.MISC + 8);
    const int lo = args.ph_lo, hi = args.ph_hi;
    unsigned char* ws = args.ws;
#define IN(k) (lo <= (k) && (k) < hi)
#define SEAM(k) do { if (IN(k) && IN((k) + 1)) xcd_barrier(bar); } while (0)

    if (IN(0)) { p0_prologue(F, args); } SEAM(0);
    if (IN(1)) {
        pg8::DenseOrder8 S; S.init(M, NQKV, F.G, (int)blockIdx.x, (const bf16_t*)(ws + WS_WQKV), D);
        pg8::EpiQKV E{(bf16_t*)(ws + WS_Q), (bf16_t*)(ws + WS_K), (bf16_t*)(ws + WS_V), args.in[IN_AQG], args.in[IN_AKG]};
        pg8::gemm_phase<pg8::EpiQKV, pg8::DenseOrder8, false, true, true>(F.lds, nullptr, (const void*)(ws + WS_XN8), D, S, E);
        if ((int)blockIdx.x >= 128 && F.G == 256) expert_conv_items(F, args, XI_PRO_END, XI_A_END, ((int)blockIdx.x - 128) * NWAVES + F.wave, 128 * NWAVES);
        else if (F.G != 256 && (int)blockIdx.x == 0) expert_conv_items(F, args, XI_PRO_END, XI_A_END, F.wave, NWAVES);
    } SEAM(1);
    if (IN(2)) { attn_phase(F, args); } SEAM(2);
    if (IN(3)) {
        pg8::DenseOrder8 S; S.init(M, D, F.G, (int)blockIdx.x, (const bf16_t*)(ws + WS_WAO), D);
        if (F.G == 256) { pg8::EpiResRoute<false> E{args.in[IN_X], (bf16_t*)(ws + WS_X1), ws + WS_XN8, (float*)(ws + WS_PART), args.in[IN_FNG], args.in[IN_RW], 1.f / 256.f};
            pg8::gemm_phase<pg8::EpiResRoute<false>, pg8::DenseOrder8, false, false, true>(F.lds, nullptr, (const void*)(ws + WS_O), D, S, E); }
        else { pg8::EpiRes<false, true> E{args.in[IN_X], (void*)(ws + WS_X1), D, 1.f / 256.f};
            pg8::gemm_phase<pg8::EpiRes<false, true>, pg8::DenseOrder8, false, false, true>(F.lds, nullptr, (const void*)(ws + WS_O), D, S, E); }
    } SEAM(3);
    if (IN(4) && F.G != 256) { nr_phase<16, false>(F, (const bf16_t*)(ws + WS_X1), nullptr, nullptr, nullptr, args.in[IN_FNG], nullptr, (unsigned char*)(ws + WS_XN8), args.in[IN_RW], NE, 0, (float*)(ws + WS_PART), nullptr, nullptr); }
    if (F.G != 256) SEAM(4);
    if (IN(5)) { topk_phase(F, (const float*)(ws + WS_PART), (int*)(ws + WS_IDX), (float*)(ws + WS_GATE), (float*)(ws + WS_RSC), (int*)(ws + WS_SLOT));
        if ((int)blockIdx.x >= 64) expert_conv_items(F, args, XI_A_END, XI_B_END, ((int)blockIdx.x - 64) * NWAVES + F.wave, (F.G - 64) * NWAVES); } SEAM(5);
    if (IN(6)) { moe_up_phase(F, ws, 0); } SEAM(6);
    if (IN(7)) { moe_down_phase(F, ws, 0); } SEAM(7);
    if (IN(8)) { nrm_phase(F, (const bf16_t*)(ws + WS_X1), (const bf16_t*)(ws + WS_Y), (const int*)(ws + WS_SLOT), (bf16_t*)(ws + WS_X2), args.in[IN_MNG], (bf16_t*)(ws + WS_XN), ws + WS_XN8,
                           args.in[IN_MWIN], MIN_LD, MIN_N, (float*)(ws + WS_MG), args.in[IN_MBI], args.in[IN_MBF]); } SEAM(8);
    if (IN(9)) {
        { pg8::DenseOrder S; S.init(M, 1024, F.G, (int)blockIdx.x, (const bf16_t*)(ws + WS_WMIN), D);
          pg8::EpiBf16 E{(bf16_t*)(ws + WS_PROJ), MIN_N, nullptr, 1.f, 0};
          pg8::gemm_phase<pg8::EpiBf16, pg8::DenseOrder, false, true, false>(F.lds, nullptr, (const bf16_t*)(ws + WS_XN), D, S, E); }
        { pg8::DenseOrder8 S; S.init(M, 2048, F.G, (int)blockIdx.x, (const bf16_t*)(ws + WS_WMIN8), D);
          pg8::EpiBf16 E{(bf16_t*)(ws + WS_PROJ), MIN_N, nullptr, 0.0625f, 1024};
          pg8::gemm_phase<pg8::EpiBf16, pg8::DenseOrder8, false, true, true>(F.lds, nullptr, (const void*)(ws + WS_XN8), D, S, E); }
    } SEAM(9);
    if (IN(10)) { mlstm_scan_phase(F, args); } SEAM(10);
    if (IN(12)) { mlstm_s3_phase(F, args); } SEAM(12);
    if (IN(13)) {
        pg8::DenseOrder S; S.init(M, D, F.G, (int)blockIdx.x, (const bf16_t*)(ws + WS_WMO), D);
        if (F.G == 256) { pg8::EpiResRoute<true> E{(const void*)(ws + WS_X2), (bf16_t*)(ws + WS_X3), ws + WS_XN8, (float*)(ws + WS_PART), args.in[IN_FNG] + D, args.in[IN_RW] + D * NE, 1.f};
            pg8::gemm_phase<pg8::EpiResRoute<true>, pg8::DenseOrder, false, false, false>(F.lds, nullptr, (const bf16_t*)(ws + WS_Y2), D, S, E); }
        else { pg8::EpiRes<true, true> E{(const void*)(ws + WS_X2), (void*)(ws + WS_X3), D, 1.f};
            pg8::gemm_phase<pg8::EpiRes<true, true>, pg8::DenseOrder, false, false, false>(F.lds, nullptr, (const bf16_t*)(ws + WS_Y2), D, S, E); }
    } SEAM(13);
    if (IN(14) && F.G != 256) { nr_phase<16, false>(F, (const bf16_t*)(ws + WS_X3), nullptr, nullptr, nullptr, args.in[IN_FNG] + D, nullptr, (unsigned char*)(ws + WS_XN8), args.in[IN_RW] + D * NE, NE, 0, (float*)(ws + WS_PART), nullptr, nullptr); }
    if (F.G != 256) SEAM(14);
    if (IN(15)) { topk_phase(F, (const float*)(ws + WS_PART), (int*)(ws + WS_IDX), (float*)(ws + WS_GATE), (float*)(ws + WS_RSC), (int*)(ws + WS_SLOT));
        if ((int)blockIdx.x >= 64) expert_conv_items(F, args, XI_C_END - XI_NC, XI_C_END, ((int)blockIdx.x - 64) * NWAVES + F.wave, (F.G - 64) * NWAVES); } SEAM(15);
    if (IN(16)) { moe_up_phase(F, ws, 1); } SEAM(16);
    if (IN(17)) { moe_down_phase(F, ws, 1); } SEAM(17);
    if (IN(18)) { combine_phase(F, (const bf16_t*)(ws + WS_X3), (const bf16_t*)(ws + WS_Y), (const int*)(ws + WS_SLOT), args.out); }
#undef IN
#undef SEAM
}

extern "C" void kernel_launch(void* const* d_in, const int* in_sizes, int n_in, void* d_out, int out_size, void* d_ws, size_t ws_size, hipStream_t stream) {
    static int grid = 0;
    if (grid == 0) {
        if (n_in != 19 || out_size != M * D || ws_size < WS_END) { fprintf(stderr, "kernel_launch: unexpected problem (n_in %d, out %d, ws %zu)\n", n_in, out_size, ws_size); grid = -1; return; }
        int dev = 0, cus = 0, per_cu = 0;
        if (hipGetDevice(&dev) != hipSuccess || hipDeviceGetAttribute(&cus, hipDeviceAttributeMultiprocessorCount, dev) != hipSuccess) { grid = -1; return; }
        if (hipFuncSetAttribute((const void*)fwd_kernel, hipFuncAttributeMaxDynamicSharedMemorySize, LDS_BYTES) != hipSuccess) { fprintf(stderr, "kernel_launch: hipFuncSetAttribute failed\n"); grid = -1; return; }
        if (hipOccupancyMaxActiveBlocksPerMultiprocessor(&per_cu, (const void*)fwd_kernel, NTHR, LDS_BYTES) != hipSuccess || per_cu < 1) fprintf(stderr, "kernel_launch: occupancy query reports %d\n", per_cu);
        (void)hipGetLastError();
        grid = cus;
    }
    if (grid < 0) return;
    if (hipMemsetAsync((char*)d_ws + WS_CTL, 0, CTL_ZERO_BYTES, stream) != hipSuccess) return;
    Args a{};
    for (int i = 0; i < 19; ++i) a.in[i] = (const float*)d_in[i];
    a.out = (float*)d_out; a.ws = (unsigned char*)d_ws; a.ph_lo = 0; a.ph_hi = 19;
#ifndef EXP_LO
    hipLaunchKernelGGL(fwd_kernel, dim3(grid), dim3(NTHR), LDS_BYTES, stream, a);
#else
    a.ph_lo = 0; a.ph_hi = EXP_HI; hipLaunchKernelGGL(fwd_kernel, dim3(grid), dim3(NTHR), LDS_BYTES, stream, a);
    hipMemsetAsync((char*)d_ws + WS_CTL, 0, CTL_ZERO_BYTES, stream);
    a.ph_lo = EXP_LO; a.ph_hi = 19; hipLaunchKernelGGL(fwd_kernel, dim3(grid), dim3(NTHR), LDS_BYTES, stream, a);
#endif
}
```

```cpp
#include <hip/hip_runtime.h>
#include <cstdio>
#include <cstdint>

#define GAS __attribute__((address_space(1)))
#define LAS __attribute__((address_space(3)))
typedef unsigned short bf16_t;
typedef short bf16x8 __attribute__((ext_vector_type(8)));
typedef short s16x4 __attribute__((ext_vector_type(4)));
typedef float f32x4 __attribute__((ext_vector_type(4)));
typedef float f32x2 __attribute__((ext_vector_type(2)));
typedef float f32x16 __attribute__((ext_vector_type(16)));
typedef unsigned u32x4 __attribute__((ext_vector_type(4)));
typedef unsigned u32x2 __attribute__((ext_vector_type(2)));
typedef int i32x4 __attribute__((ext_vector_type(4)));
typedef int i32x8 __attribute__((ext_vector_type(8)));
#define LDS_WAIT() asm volatile("s_waitcnt lgkmcnt(0)" ::: "memory")
#define VM_WAIT() asm volatile("s_waitcnt vmcnt(0)" ::: "memory")
#define DI __device__ __forceinline__

constexpr int NB = 4, SEQ = 4096, D = 1024, M = NB * SEQ;
constexpr int NQKV = 1536;
constexpr int MIN_N = 3072, MIN_LD = 3104;
constexpr int NE = 16, CAP = 512, DE = 2048, MROWS = NB * NE * CAP;
constexpr float RMS_EPS = 1e-6f, LOG2E = 1.4426950408889634f, YS8 = 64.f;
constexpr int NWAVES = 8, NTHR = 512;

constexpr size_t MiB = 1u << 20;
constexpr size_t WS_CTL = 0, CTL_ZERO_BYTES = 1 * MiB;
constexpr size_t WS_WQKV = 2 * MiB, WS_WAO = 6 * MiB, WS_WMIN = 8 * MiB, WS_WMIN8 = 11 * MiB, WS_WMO = 14 * MiB;
constexpr size_t WS_W13 = 16 * MiB, W13_LAYER = 64 * MiB;
constexpr size_t WS_W2 = 272 * MiB, W2_LAYER = 32 * MiB;
constexpr size_t WS_XN = 400 * MiB, WS_X1 = 432 * MiB, WS_X2 = 496 * MiB, WS_X3 = 464 * MiB;
constexpr size_t WS_XN8 = 904 * MiB;
constexpr size_t WS_AFF = 560 * MiB, WS_IDX = 561 * MiB, WS_GATE = 562 * MiB, WS_SLOT = 563 * MiB, WS_MG = 564 * MiB;
constexpr size_t WS_ACT = 568 * MiB;
constexpr size_t WS_Q = WS_ACT, WS_K = WS_ACT + 32 * MiB, WS_V = WS_ACT + 40 * MiB, WS_O = WS_ACT + 48 * MiB;
constexpr size_t WS_H = WS_ACT, WS_Y = WS_ACT + 128 * MiB;
constexpr size_t WS_PROJ = WS_ACT, WS_CLOC = WS_ACT + 96 * MiB, WS_STATE = WS_ACT + 232 * MiB, WS_Y2 = WS_ACT + 300 * MiB;
constexpr size_t WS_NLOC = WS_ACT + 332 * MiB, WS_MLB = WS_ACT + 333 * MiB, WS_NST = WS_ACT + 334 * MiB, WS_MST = WS_ACT + 335 * MiB;
constexpr size_t WS_PART = 920 * MiB;
constexpr size_t WS_RSC = WS_AFF;
constexpr size_t WS_END = 928 * MiB;
constexpr int CW_BAR = 4096;

constexpr int RING_BYTES = 131072;
constexpr int AUX_OFF = RING_BYTES, AUX_BYTES = 24576;
constexpr int MISC_OFF = AUX_OFF + AUX_BYTES;
constexpr int LDS_BYTES = MISC_OFF + 256;

DI unsigned f2bf(float f) { unsigned u = __builtin_bit_cast(unsigned, f); return (u + 0x7fffu + ((u >> 16) & 1u)) >> 16; }
DI unsigned pk2(float lo, float hi) { return f2bf(lo) | (f2bf(hi) << 16); }
DI unsigned cvt_pk_bf16(float lo, float hi) { unsigned r; asm volatile("v_cvt_pk_bf16_f32 %0, %1, %2" : "=v"(r) : "v"(lo), "v"(hi)); return r; }
DI unsigned pk4_fp8(float a, float b, float c, float d) { unsigned w = 0u; w = __builtin_amdgcn_cvt_pk_fp8_f32(a, b, w, false); w = __builtin_amdgcn_cvt_pk_fp8_f32(c, d, w, true); return w; }
DI float bf2f(unsigned short b) { return __builtin_bit_cast(float, ((unsigned)b) << 16); }
DI float wave_sum(float v) {
#pragma unroll
    for (int o = 1; o < 64; o <<= 1) v += __shfl_xor(v, o);
    return v;
}

#define XB_TMO      128
#define XB_XCNT(j)  (256  + 64 * (j))
#define XB_XSUB(j)  (1280 + 64 * (j))
#define XB_XGEN(j)  (2304 + 64 * (j))
#define XB_TOP      3328
#define XB_TOPGEN   3392
#define XCD_BAR_WORDS 3456
#define XB_SPIN_CAP (1u << 18)
DI unsigned xb_ld(unsigned* p)              { return __hip_atomic_load(p, __ATOMIC_RELAXED, __HIP_MEMORY_SCOPE_AGENT); }
DI unsigned xb_add(unsigned* p, unsigned v) { return __hip_atomic_fetch_add(p, v, __ATOMIC_RELAXED, __HIP_MEMORY_SCOPE_AGENT); }
DI unsigned xb_xcc_id() { return (unsigned)__builtin_amdgcn_s_getreg((3 << 11) | 20) & 0xFu; }
#define XB_SPIN(cond, bar) do { unsigned _sp = 0; while (cond) { __builtin_amdgcn_s_sleep(1); \
    if ((++_sp & 255u) == 0u) { if (xb_ld(&(bar)[XB_TMO])) break; if (_sp > XB_SPIN_CAP) { atomicAdd(&(bar)[XB_TMO], 1u); break; } } } } while (0)
struct XcdBarrier { unsigned* bar; unsigned x; volatile LAS unsigned* st; };
DI XcdBarrier xcd_barrier_post(unsigned* bar, volatile LAS unsigned* st) {
    XcdBarrier b; b.bar = bar; b.x = xb_xcc_id(); b.st = st;
    if (threadIdx.x == 0) (void)xb_add(&bar[XB_XCNT(b.x)], 1u);
    return b;
}
DI void xcd_barrier_complete(unsigned* bar, unsigned x, unsigned& nloc, unsigned& nx) {
    const unsigned G = gridDim.x * gridDim.y * gridDim.z;
    unsigned sum, cnt, mine, sp = 0u;
    for (;;) {
        sum = 0u; cnt = 0u; mine = 0u;
#pragma unroll
        for (unsigned j = 0; j < 16; ++j) { const unsigned c = xb_ld(&bar[XB_XCNT(j)]); sum += c; cnt += (c > 0u) ? 1u : 0u; mine = (j == x) ? c : mine; }
        if (sum == G) break;
        __builtin_amdgcn_s_sleep(1);
        if ((++sp & 255u) == 0u) { if (xb_ld(&bar[XB_TMO])) break; if (sp > XB_SPIN_CAP) { atomicAdd(&bar[XB_TMO], 1u); break; } }
    }
    nloc = mine > 0u ? mine : 1u; nx = cnt > 0u ? cnt : 1u;
}
DI void xcd_barrier(const XcdBarrier& b) {
    asm volatile("s_waitcnt vmcnt(0)" ::: "memory");
    __syncthreads();
    if (threadIdx.x == 0) {
        unsigned* bar = b.bar;
        __builtin_amdgcn_s_waitcnt(0);
        unsigned nloc = b.st[0], nx = b.st[1];
        if (nloc == 0u) { xcd_barrier_complete(bar, b.x, nloc, nx); b.st[0] = nloc; b.st[1] = nx; }
        const unsigned old = xb_add(&bar[XB_XSUB(b.x)], 1u);
        const unsigned gen = old / nloc;
        if (old + 1u == (gen + 1u) * nloc) {
            __builtin_amdgcn_fence(__ATOMIC_RELEASE, "agent");
            asm volatile("s_waitcnt vmcnt(0)" ::: "memory");
            const unsigned og = xb_add(&bar[XB_TOP], 1u);
            const unsigned tg = og / nx;
            if (og + 1u == (tg + 1u) * nx) xb_add(&bar[XB_TOPGEN], 1u);
            else XB_SPIN(xb_ld(&bar[XB_TOPGEN]) == tg, bar);
            __builtin_amdgcn_fence(__ATOMIC_ACQUIRE, "agent");
            xb_add(&bar[XB_XGEN(b.x)], 1u);
            asm volatile("s_waitcnt vmcnt(0)" ::: "memory");
        } else {
            XB_SPIN(xb_ld(&bar[XB_XGEN(b.x)]) == gen, bar);
            __builtin_amdgcn_fence(__ATOMIC_ACQUIRE, "agent");
            asm volatile("s_waitcnt vmcnt(0)" ::: "memory");
        }
    }
    __syncthreads();
}

namespace pg8 {
constexpr int BM = 256, BK = 64, HALF = 128, HTB = HALF * BK * 2, STAGE_BYTES = 8 * HTB;
DI int lds_byte(int r, int c) { const int st = (r >> 4) * 2 + (c >> 5), rr = r & 15, cc = c & 31, ob = rr * 64 + cc * 2; return st * 1024 + (ob ^ (((ob >> 9) & 1) << 5)); }
DI void stage_rc(int b, int& R, int& C) { const int st = b / 1024, sb = b % 1024, swz = sb ^ (((sb >> 9) & 1) << 5); R = (st >> 1) * 16 + swz / 64; C = (st & 1) * 32 + (swz % 64) / 2; }
DI int perm32(int rho) { const int n = rho >> 4, i = rho & 15; return 8 * (i >> 2) + 4 * n + (i & 3); }
DI int perm32inv(int c) { return 16 * ((c >> 2) & 1) + 4 * (c >> 3) + (c & 3); }
struct Unit { int pm, pn, ui; };

template <class Epi, class Sched, bool GATHER, bool ALIGN_EPI, bool F8>
DI void gemm_phase(LAS unsigned char* lds, const LAS int* idx_lds, const void* A, const int K, const Sched& S, const Epi& E) {
    const int tid = threadIdx.x, wid = __builtin_amdgcn_readfirstlane(tid >> 6), lane = tid & 63, wr = wid >> 2, wc = wid & 3, fr = lane & 15, fq = lane >> 4;
    const int PB = F8 ? K : 2 * K, nt = PB / 128;
    unsigned voffA[2][2], voffB[2];
    int RA[2], CA[2];
#pragma unroll
    for (int i = 0; i < 2; ++i) { int R, C; stage_rc(tid * 16 + i * 8192, R, C); RA[i] = R; CA[i] = C; voffB[i] = (unsigned)(R * PB + C * 2); }
    const size_t kstep = (size_t)(BK * 2);
    const size_t hstep = (size_t)HALF * PB;
    const unsigned ldsw = (unsigned)wid * 1024u;
    const int aoff = lds_byte(wr * 64 + fr, fq * 8), boff = lds_byte(wc * 32 + fr, fq * 8);
#define PG8_SA(b, h) (((b) * 2 + (h)) * HTB)
#define PG8_SB(b, h) ((4 + (b) * 2 + (h)) * HTB)
#define PG8_STAGE(bufoff, gbase, voff) do { _Pragma("unroll") for (int _i = 0; _i < 2; ++_i) \
        __builtin_amdgcn_global_load_lds((const unsigned*)((const char*)(gbase) + (voff)[_i]), (LAS unsigned*)(lds + (bufoff) + ldsw + _i * 8192), 16, 0, 0); } while (0)
#define PG8_LDA(dst, b, h) do { _Pragma("unroll") for (int m = 0; m < 4; ++m) _Pragma("unroll") for (int k = 0; k < 2; ++k) dst[m][k] = *(const LAS bf16x8*)(lds + PG8_SA(b, h) + aoff + m * 2048 + k * 1024); } while (0)
#define PG8_LDB(dst, b, h) do { _Pragma("unroll") for (int n = 0; n < 2; ++n) _Pragma("unroll") for (int k = 0; k < 2; ++k) dst[n][k] = *(const LAS bf16x8*)(lds + PG8_SB(b, h) + boff + n * 2048 + k * 1024); } while (0)
#define PG8_MMA(ai, bj, At, Bt) do { __builtin_amdgcn_s_setprio(1); _Pragma("unroll") for (int m = 0; m < 4; ++m) _Pragma("unroll") for (int n = 0; n < 2; ++n) { \
        if constexpr (F8) acc[ai][bj][m][n] = __builtin_amdgcn_mfma_scale_f32_16x16x128_f8f6f4( \
            __builtin_shufflevector(__builtin_bit_cast(i32x4, Bt[n][0]), __builtin_bit_cast(i32x4, Bt[n][1]), 0, 1, 2, 3, 4, 5, 6, 7), \
            __builtin_shufflevector(__builtin_bit_cast(i32x4, At[m][0]), __builtin_bit_cast(i32x4, At[m][1]), 0, 1, 2, 3, 4, 5, 6, 7), acc[ai][bj][m][n], 0, 0, 0, 0x7f7f7f7f, 0, 0x7f7f7f7f); \
        else { _Pragma("unroll") for (int k = 0; k < 2; ++k) acc[ai][bj][m][n] = __builtin_amdgcn_mfma_f32_16x16x32_bf16(Bt[n][k], At[m][k], acc[ai][bj][m][n], 0, 0, 0); } } \
        __builtin_amdgcn_s_setprio(0); } while (0)
#define PG8_WAIT_V(n) asm volatile("s_waitcnt vmcnt(" #n ")" ::: "memory")
#define PG8_WAIT_L(n) asm volatile("s_waitcnt lgkmcnt(" #n ")" ::: "memory")
#define PG8_BAR __builtin_amdgcn_s_barrier()
#define PG8_SCHED __builtin_amdgcn_sched_barrier(0)
#define PG8_SETA(ui_, u_) do { _Pragma("unroll") for (int _h = 0; _h < 2; ++_h) _Pragma("unroll") for (int _i = 0; _i < 2; ++_i) { \
        const int _row = GATHER ? idx_lds[(ui_) * 256 + _h * 128 + RA[_i]] : (u_).pm * 256 + _h * 128 + RA[_i]; voffA[_h][_i] = (unsigned)(_row * PB + CA[_i] * 2); } } while (0)
    Unit cur, nxt; int ui = 0;
    if (!S.next(0, cur)) return;
    f32x4 acc[2][2][4][2];
#pragma unroll
    for (int a = 0; a < 2; ++a)
#pragma unroll
        for (int b = 0; b < 2; ++b)
#pragma unroll
            for (int m = 0; m < 4; ++m)
#pragma unroll
                for (int n = 0; n < 2; ++n) acc[a][b][m][n] = (f32x4){0.f, 0.f, 0.f, 0.f};
    bf16x8 At[4][2], B0[2][2], B1[2][2];
    const char* const Ab = (const char*)A;
    const char* cB = S.bptr(cur);
    PG8_SETA(0, cur);
    PG8_STAGE(PG8_SB(0, 0), cB, voffB); PG8_STAGE(PG8_SB(0, 1), cB + hstep, voffB); PG8_STAGE(PG8_SA(0, 0), Ab, voffA[0]); PG8_STAGE(PG8_SA(0, 1), Ab, voffA[1]);
    if (wr == 1) PG8_BAR;
    PG8_WAIT_V(2); PG8_BAR;
    PG8_STAGE(PG8_SB(1, 0), cB + kstep, voffB); PG8_STAGE(PG8_SA(1, 0), Ab + kstep, voffA[0]); PG8_STAGE(PG8_SB(1, 1), cB + hstep + kstep, voffB);
    PG8_WAIT_V(6); PG8_BAR;
    for (;;) {
        const bool has_next = S.next(ui + 1, nxt);
        const char* nB = has_next ? S.bptr(nxt) : cB;
        for (int t = 0; t < nt; t += 2) {
            const bool last = (t == nt - 2);
            const char* a1 = Ab + (size_t)(t + 1) * kstep;
            const char* a2 = last ? Ab : Ab + (size_t)(t + 2) * kstep; const char* b2 = last ? nB : cB + (size_t)(t + 2) * kstep;
            const char* a3 = a2 + kstep; const char* b3 = b2 + kstep;
            PG8_LDB(B0, 0, 0); PG8_LDB(B1, 0, 1); PG8_SCHED; PG8_LDA(At, 0, 0); PG8_STAGE(PG8_SA(1, 1), a1, voffA[1]);
            if (last && has_next) PG8_SETA(ui + 1, nxt);
            PG8_WAIT_V(8); PG8_WAIT_L(0); PG8_BAR; PG8_MMA(0, 0, At, B0); PG8_MMA(0, 1, At, B1); PG8_BAR; PG8_SCHED;
            PG8_LDA(At, 0, 1); PG8_STAGE(PG8_SB(0, 0), b2, voffB); PG8_STAGE(PG8_SB(0, 1), b2 + hstep, voffB); PG8_STAGE(PG8_SA(0, 0), a2, voffA[0]);
            PG8_WAIT_V(8); PG8_WAIT_L(0); PG8_BAR; PG8_MMA(1, 0, At, B0); PG8_MMA(1, 1, At, B1); PG8_BAR; PG8_SCHED;
            PG8_LDB(B0, 1, 0); PG8_LDB(B1, 1, 1); PG8_SCHED; PG8_LDA(At, 1, 0); PG8_STAGE(PG8_SA(0, 1), a2, voffA[1]);
            PG8_WAIT_V(8); PG8_WAIT_L(0); PG8_BAR; PG8_MMA(0, 0, At, B0); PG8_MMA(0, 1, At, B1); PG8_BAR; PG8_SCHED;
            PG8_LDA(At, 1, 1); PG8_STAGE(PG8_SB(1, 0), b3, voffB); PG8_STAGE(PG8_SB(1, 1), b3 + hstep, voffB); PG8_STAGE(PG8_SA(1, 0), a3, voffA[0]);
            PG8_WAIT_V(8); PG8_WAIT_L(0); PG8_BAR; PG8_MMA(1, 0, At, B0); PG8_MMA(1, 1, At, B1); PG8_BAR; PG8_SCHED;
        }
        if constexpr (ALIGN_EPI) { if (wr == 0) PG8_BAR; }
        cur.ui = ui;
        if constexpr (!Epi::AFTER_DRAIN) E(acc, cur, wr, wc, fr, fq);
        if (!has_next) break;
#pragma unroll
        for (int a = 0; a < 2; ++a)
#pragma unroll
            for (int b = 0; b < 2; ++b)
#pragma unroll
                for (int m = 0; m < 4; ++m)
#pragma unroll
                    for (int n = 0; n < 2; ++n) acc[a][b][m][n] = (f32x4){0.f, 0.f, 0.f, 0.f};
        cur = nxt; cB = nB; ++ui;
        if constexpr (ALIGN_EPI) { if (wr == 1) PG8_BAR; }
    }
    PG8_WAIT_V(0);
    if constexpr (!ALIGN_EPI) { if (wr == 0) PG8_BAR; }
    PG8_BAR;
    if constexpr (Epi::AFTER_DRAIN) E.fused(acc, cur, wr, wc, fr, fq, lds);
#undef PG8_SA
#undef PG8_SB
#undef PG8_STAGE
#undef PG8_LDA
#undef PG8_LDB
#undef PG8_MMA
#undef PG8_WAIT_V
#undef PG8_WAIT_L
#undef PG8_BAR
#undef PG8_SCHED
#undef PG8_SETA
}

struct DenseOrder {
    int nM, nN, nwg, G, c; const bf16_t* Bt; int K;
    DI void init(int M_, int N_, int G_, int c_, const bf16_t* Bt_, int K_) { nM = M_ / BM; nN = N_ / BM; nwg = nM * nN; G = G_; c = c_; Bt = Bt_; K = K_; }
    DI bool next(int i, Unit& u) const {
        const long L = (long)i * G + c; if (L >= nwg) return false;
        int wgid = (int)L; { const int q = nwg / 8, r = nwg % 8, xcd = wgid % 8, off = wgid / 8; wgid = (xcd < r ? xcd * (q + 1) : r * (q + 1) + (xcd - r) * q) + off; }
        const int nig = 8 * nN, gid = wgid / nig, fm = gid * 8, gsz = (nM - fm) < 8 ? (nM - fm) : 8;
        u.pm = fm + ((wgid % nig) % gsz); u.pn = (wgid % nig) / gsz; return true;
    }
    DI const char* bptr(const Unit& u) const { return (const char*)(Bt + (size_t)u.pn * BM * K); }
};

struct DenseOrder8 : DenseOrder { DI const char* bptr(const Unit& u) const { return (const char*)Bt + (size_t)u.pn * BM * K; } };

struct EpiQKV {
    static constexpr bool AFTER_DRAIN = false;
    bf16_t *Q, *Kb, *Vb; const float *qg, *kg;
    DI void operator()(const f32x4 (&acc)[2][2][4][2], const Unit& u, int wr, int wc, int fr, int fq) const {
        const int pn = u.pn; bf16_t* base; int ld; const float* g; float sc;
        if (pn < 4) { base = Q + (pn * 4 + wc) * 64; ld = 1024; g = qg; sc = 0.125f * LOG2E; }
        else if (pn == 4) { base = Kb + wc * 64; ld = 256; g = kg; sc = 1.f; }
        else { base = Vb + wc * 64; ld = 256; g = kg; sc = 0.f; }
        f32x4 gv[2][2];
#pragma unroll
        for (int bj = 0; bj < 2; ++bj)
#pragma unroll
            for (int n = 0; n < 2; ++n) { gv[bj][n] = *(const f32x4*)(g + 32 * bj + 8 * fq + 4 * n) * sc; if (pn == 5) gv[bj][n] = (f32x4){1.f, 1.f, 1.f, 1.f}; }
#pragma unroll
        for (int ai = 0; ai < 2; ++ai)
#pragma unroll
            for (int m = 0; m < 4; ++m) {
                const int row = u.pm * BM + ai * HALF + wr * 64 + m * 16 + fr;
                float ss = 0.f;
#pragma unroll
                for (int bj = 0; bj < 2; ++bj)
#pragma unroll
                    for (int n = 0; n < 2; ++n) { const f32x4 x = acc[ai][bj][m][n]; ss += (x[0] * x[0] + x[1] * x[1]) + (x[2] * x[2] + x[3] * x[3]); }
                ss += __shfl_xor(ss, 16); ss += __shfl_xor(ss, 32);
                const float rinv = (pn == 5) ? 0.0625f : __builtin_amdgcn_rsqf(ss * (1.f / 64.f) + RMS_EPS);
#pragma unroll
                for (int bj = 0; bj < 2; ++bj) {
                    const f32x4 v0 = acc[ai][bj][m][0] * rinv * gv[bj][0], v1 = acc[ai][bj][m][1] * rinv * gv[bj][1];
                    u32x4 w; w.x = cvt_pk_bf16(v0[0], v0[1]); w.y = cvt_pk_bf16(v0[2], v0[3]); w.z = cvt_pk_bf16(v1[0], v1[1]); w.w = cvt_pk_bf16(v1[2], v1[3]);
                    *(u32x4*)(base + (size_t)row * ld + 32 * bj + 8 * fq) = w; }
            }
    }
};
template <bool RB, bool OB> struct EpiRes {
    static constexpr bool AFTER_DRAIN = false;
    const void* resid; void* out; int ldc; float cscale;
    DI void operator()(const f32x4 (&acc)[2][2][4][2], const Unit& u, int wr, int wc, int fr, int fq) const {
        const int row0 = u.pm * BM + wr * 64 + fr, col0 = u.pn * BM + wc * 32 + 4 * fq;
#pragma unroll
        for (int ai = 0; ai < 2; ++ai)
#pragma unroll
          for (int mp = 0; mp < 4; mp += 2) {
            f32x4 rr[2][2][2];
#pragma unroll
            for (int m = 0; m < 2; ++m) { const size_t off = (size_t)(row0 + ai * HALF + (mp + m) * 16) * ldc + col0;
#pragma unroll
                for (int bj = 0; bj < 2; ++bj)
#pragma unroll
                    for (int n = 0; n < 2; ++n) {
                        if constexpr (RB) { const u32x2 w = *(const u32x2*)((const bf16_t*)resid + off + bj * HALF + n * 16);
                            rr[m][bj][n] = (f32x4){__builtin_bit_cast(float, w.x << 16), __builtin_bit_cast(float, w.x & 0xffff0000u), __builtin_bit_cast(float, w.y << 16), __builtin_bit_cast(float, w.y & 0xffff0000u)}; }
                        else rr[m][bj][n] = *(const f32x4*)((const float*)resid + off + bj * HALF + n * 16); } }
#pragma unroll
            for (int m = 0; m < 2; ++m) { const size_t off = (size_t)(row0 + ai * HALF + (mp + m) * 16) * ldc + col0;
#pragma unroll
                for (int bj = 0; bj < 2; ++bj)
#pragma unroll
                    for (int n = 0; n < 2; ++n) { const f32x4 o = rr[m][bj][n] + acc[ai][bj][mp + m][n] * cscale;
                        if constexpr (OB) { u32x2 w; w.x = cvt_pk_bf16(o[0], o[1]); w.y = cvt_pk_bf16(o[2], o[3]); *(u32x2*)((bf16_t*)out + off + bj * HALF + n * 16) = w; }
                        else *(f32x4*)((float*)out + off + bj * HALF + n * 16) = o; } }
            asm volatile("" ::: "memory"); }
    }
};
template <bool RB> struct EpiResRoute {
    static constexpr bool AFTER_DRAIN = true;
    const void* resid; bf16_t* X1; unsigned char* XG8; float* part; const float* g; const float* Wr; float cscale;
    DI void operator()(const f32x4 (&)[2][2][4][2], const Unit&, int, int, int, int) const {}
    DI void fused(f32x4 (&acc)[2][2][4][2], const Unit& u, int wr, int wc, int fr, int fq, LAS unsigned char* lds) const {
        const int tid = threadIdx.x;
        LAS unsigned short* WH = (LAS unsigned short*)lds;
        LAS unsigned short* WL = WH + 16 * 256;
        LAS float* RED = (LAS float*)(lds + 16384);
#pragma unroll
        for (int i = 0; i < 2; ++i) { const int idx = tid + i * 512, c = idx >> 2, e4 = idx & 3; const int col = u.pn * BM + c;
            const f32x4 w = *(const f32x4*)(Wr + (size_t)col * NE + 4 * e4) * g[col];
#pragma unroll
            for (int q = 0; q < 4; ++q) { const unsigned hb = f2bf(w[q]); const float lo = w[q] - __builtin_bit_cast(float, hb << 16);
                WH[(4 * e4 + q) * 256 + c] = (unsigned short)hb; WL[(4 * e4 + q) * 256 + c] = (unsigned short)f2bf(lo); } }
        const int row0 = u.pm * BM + wr * 64 + fr, col0 = u.pn * BM + wc * 32 + 4 * fq;
        f32x4 gc[2][2];
#pragma unroll
        for (int bj = 0; bj < 2; ++bj)
#pragma unroll
            for (int n = 0; n < 2; ++n) gc[bj][n] = *(const f32x4*)(g + col0 + bj * HALF + n * 16);
#pragma unroll
        for (int ai = 0; ai < 2; ++ai)
#pragma unroll
          for (int mp = 0; mp < 4; mp += 2) {
            f32x4 rr[2][2][2];
#pragma unroll
            for (int m = 0; m < 2; ++m) { const size_t off = (size_t)(row0 + ai * HALF + (mp + m) * 16) * D + col0;
#pragma unroll
                for (int bj = 0; bj < 2; ++bj)
#pragma unroll
                    for (int n = 0; n < 2; ++n) {
                        if constexpr (RB) { const u32x2 w = *(const u32x2*)((const bf16_t*)resid + off + bj * HALF + n * 16);
                            rr[m][bj][n] = (f32x4){__builtin_bit_cast(float, w.x << 16), __builtin_bit_cast(float, w.x & 0xffff0000u), __builtin_bit_cast(float, w.y << 16), __builtin_bit_cast(float, w.y & 0xffff0000u)}; }
                        else rr[m][bj][n] = *(const f32x4*)((const float*)resid + off + bj * HALF + n * 16); } }
#pragma unroll
            for (int m = 0; m < 2; ++m) { const size_t off = (size_t)(row0 + ai * HALF + (mp + m) * 16) * D + col0;
#pragma unroll
                for (int bj = 0; bj < 2; ++bj)
#pragma unroll
                    for (int n = 0; n < 2; ++n) { const f32x4 o = rr[m][bj][n] + acc[ai][bj][mp + m][n] * cscale; acc[ai][bj][mp + m][n] = o;
                        u32x2 w; w.x = cvt_pk_bf16(o[0], o[1]); w.y = cvt_pk_bf16(o[2], o[3]); *(u32x2*)(X1 + off + bj * HALF + n * 16) = w;
                        const f32x4 og = o * gc[bj][n]; *(unsigned*)(XG8 + off + bj * HALF + n * 16) = pk4_fp8(og[0], og[1], og[2], og[3]); } }
            asm volatile("" ::: "memory"); }
        __syncthreads();
#pragma unroll
        for (int ai = 0; ai < 2; ++ai)
#pragma unroll
            for (int m = 0; m < 4; ++m) { float ssl = 0.f;
#pragma unroll
                for (int bj = 0; bj < 2; ++bj)
#pragma unroll
                    for (int n = 0; n < 2; ++n) { const f32x4 x = acc[ai][bj][m][n]; ssl += (x[0] * x[0] + x[1] * x[1]) + (x[2] * x[2] + x[3] * x[3]); }
                ssl += __shfl_xor(ssl, 16); ssl += __shfl_xor(ssl, 32);
                if (fq == 0) RED[((ai * HALF + wr * 64 + m * 16 + fr) * 4 + wc) * 17 + 16] = ssl; }
        bf16x8 bh[2], bl[2];
#pragma unroll
        for (int bj = 0; bj < 2; ++bj) { const int cb = bj * HALF + wc * 32 + 4 * fq;
            const u32x2 h0 = *(const LAS u32x2*)(WH + fr * 256 + cb), h1 = *(const LAS u32x2*)(WH + fr * 256 + cb + 16), l0 = *(const LAS u32x2*)(WL + fr * 256 + cb), l1 = *(const LAS u32x2*)(WL + fr * 256 + cb + 16);
            bh[bj] = __builtin_bit_cast(bf16x8, (u32x4){h0.x, h0.y, h1.x, h1.y}); bl[bj] = __builtin_bit_cast(bf16x8, (u32x4){l0.x, l0.y, l1.x, l1.y}); }
#pragma unroll
        for (int ai = 0; ai < 2; ++ai)
#pragma unroll
            for (int m = 0; m < 4; ++m) { f32x4 lg = (f32x4){0.f, 0.f, 0.f, 0.f};
#pragma unroll
                for (int bj = 0; bj < 2; ++bj) { const f32x4 x0 = acc[ai][bj][m][0], x1v = acc[ai][bj][m][1];
                    u32x4 hi, lo; float r[8] = {x0[0], x0[1], x0[2], x0[3], x1v[0], x1v[1], x1v[2], x1v[3]};
#pragma unroll
                    for (int q = 0; q < 4; ++q) { const unsigned h2 = cvt_pk_bf16(r[2 * q], r[2 * q + 1]); hi[q] = h2;
                        lo[q] = cvt_pk_bf16(r[2 * q] - __builtin_bit_cast(float, h2 << 16), r[2 * q + 1] - __builtin_bit_cast(float, h2 & 0xffff0000u)); }
                    const bf16x8 ah = __builtin_bit_cast(bf16x8, hi), al = __builtin_bit_cast(bf16x8, lo);
                    lg = __builtin_amdgcn_mfma_f32_16x16x32_bf16(ah, bh[bj], lg, 0, 0, 0);
                    lg = __builtin_amdgcn_mfma_f32_16x16x32_bf16(al, bh[bj], lg, 0, 0, 0);
                    lg = __builtin_amdgcn_mfma_f32_16x16x32_bf16(ah, bl[bj], lg, 0, 0, 0); }
#pragma unroll
                for (int j = 0; j < 4; ++j) RED[((ai * HALF + wr * 64 + m * 16 + 4 * fq + j) * 4 + wc) * 17 + fr] = lg[j]; }
        __syncthreads();
        for (int idx = tid; idx < 256 * 17; idx += 512) { const int e17 = idx >> 8, row = idx & 255;
            const float v = (RED[(row * 4 + 0) * 17 + e17] + RED[(row * 4 + 1) * 17 + e17]) + (RED[(row * 4 + 2) * 17 + e17] + RED[(row * 4 + 3) * 17 + e17]);
            part[(size_t)(u.pn * 17 + e17) * M + u.pm * BM + row] = v; }
    }
};
struct EpiSwiGLU {
    static constexpr bool AFTER_DRAIN = false;
    unsigned char* H; const LAS float* rsl;
    DI void operator()(const f32x4 (&acc)[2][2][4][2], const Unit& u, int wr, int wc, int fr, int fq) const {
        const int row0 = u.pm * BM + wr * 64 + fr, col = u.pn * 128 + wc * 32 + 8 * fq;
        float rsv[2][4];
#pragma unroll
        for (int ai = 0; ai < 2; ++ai)
#pragma unroll
            for (int m = 0; m < 4; ++m) rsv[ai][m] = rsl[u.ui * 256 + ai * HALF + wr * 64 + m * 16 + fr] * 0.0625f;
#pragma unroll
        for (int ai = 0; ai < 2; ++ai)
#pragma unroll
            for (int m = 0; m < 4; ++m) {
                float hv[8]; const float rs = rsv[ai][m];
#pragma unroll
                for (int n = 0; n < 2; ++n)
#pragma unroll
                    for (int j = 0; j < 4; ++j) { const float a = acc[ai][0][m][n][j] * rs, uu = acc[ai][1][m][n][j] * rs;
                        const float hh = a * __builtin_amdgcn_rcpf(1.f + __builtin_amdgcn_exp2f(-a * LOG2E)) * uu; hv[4 * n + j] = fminf(fmaxf(hh, -448.f), 448.f); }
                u32x2 w; w.x = pk4_fp8(hv[0], hv[1], hv[2], hv[3]); w.y = pk4_fp8(hv[4], hv[5], hv[6], hv[7]);
                *(u32x2*)(H + (size_t)(row0 + ai * HALF + m * 16) * DE + col) = w;
            }
    }
};
struct EpiBf16 {
    static constexpr bool AFTER_DRAIN = false;
    bf16_t* O; int ldc; const float* rowscale; float cscale; int coloff;
    DI void operator()(const f32x4 (&acc)[2][2][4][2], const Unit& u, int wr, int wc, int fr, int fq) const {
        const int row0 = u.pm * BM + wr * 64 + fr, col0 = coloff + u.pn * BM + wc * 32 + 8 * fq;
#pragma unroll
        for (int ai = 0; ai < 2; ++ai)
#pragma unroll
            for (int m = 0; m < 4; ++m) { const int row = row0 + ai * HALF + m * 16; const float sc = rowscale ? rowscale[row] * cscale : cscale;
#pragma unroll
                for (int bj = 0; bj < 2; ++bj) { const f32x4 v0 = acc[ai][bj][m][0] * sc, v1 = acc[ai][bj][m][1] * sc;
                    u32x4 w; w.x = cvt_pk_bf16(v0[0], v0[1]); w.y = cvt_pk_bf16(v0[2], v0[3]); w.z = cvt_pk_bf16(v1[0], v1[1]); w.w = cvt_pk_bf16(v1[2], v1[3]);
                    *(u32x4*)(O + (size_t)row * ldc + col0 + bj * HALF) = w; } }
    }
};
struct EpiFp8 {
    static constexpr bool AFTER_DRAIN = false;
    unsigned char* O; int ldc; const float* rowscale; float cscale;
    DI void operator()(const f32x4 (&acc)[2][2][4][2], const Unit& u, int wr, int wc, int fr, int fq) const {
        const int row0 = u.pm * BM + wr * 64 + fr, col0 = u.pn * BM + wc * 32 + 8 * fq;
#pragma unroll
        for (int ai = 0; ai < 2; ++ai)
#pragma unroll
            for (int m = 0; m < 4; ++m) { const int row = row0 + ai * HALF + m * 16; const float sc = rowscale[row] * cscale;
#pragma unroll
                for (int bj = 0; bj < 2; ++bj) { const f32x4 v0 = acc[ai][bj][m][0] * sc, v1 = acc[ai][bj][m][1] * sc;
                    u32x2 w; w.x = pk4_fp8(v0[0], v0[1], v0[2], v0[3]); w.y = pk4_fp8(v1[0], v1[1], v1[2], v1[3]);
                    *(u32x2*)(O + (size_t)row * ldc + col0 + bj * HALF) = w; } }
    }
};
struct MoeUpOrder {
    int vcu, G; const char* W;
    DI bool next(int i, Unit& u) const { const int L = i * G + vcu; if (L >= 2048) return false; const int ii = L >> 8, v = L & 255, x = v >> 5, j = v & 31, e = 2 * ii + (x >> 2);
        u.pm = 8 * e + (j & 7); u.pn = 4 * (x & 3) + (j >> 3); return true; }
    DI const char* bptr(const Unit& u) const { return W + (size_t)(u.pm >> 3) * 4096 * 1024 + (size_t)u.pn * BM * 1024; }
};
struct MoeDownOrder {
    int vcu, G; const char* W;
    DI bool next(int i, Unit& u) const { const int L = i * G + vcu; if (L >= 512) return false; const int ii = L >> 8, v = L & 255, x = v >> 5, j = v & 31, e = 8 * ii + x;
        u.pm = 8 * e + (j & 7); u.pn = j >> 3; return true; }
    DI const char* bptr(const Unit& u) const { return W + (size_t)(u.pm >> 3) * 1024 * 2048 + (size_t)u.pn * BM * 2048; }
};
}

struct Args { const float* in[19]; float* out; unsigned char* ws; int ph_lo, ph_hi; };
struct Frame {
    LAS unsigned char* lds; volatile LAS unsigned* MISC; unsigned* ctl;
    int tid, lane, wave, vcu, G;
};
enum { IN_X = 0, IN_RELB, IN_ANG, IN_AWIN, IN_AQG, IN_AKG, IN_ASINK, IN_AWOUT, IN_MNG, IN_MWIN, IN_MBI, IN_MBF, IN_MOG, IN_MWOUT, IN_FNG, IN_RW, IN_W1, IN_W3, IN_W2 };

DI void conv_item(const float* W, int ldw, int cbase, bf16_t* dst, int K, int drow0, int k0, bool perm, float scale, LAS float* scr, int lane) {
#pragma unroll 8
    for (int i = 0; i < 32; ++i) { const int kk = 2 * i + (lane >> 5); scr[kk * 33 + (lane & 31)] = W[(size_t)(k0 + kk) * ldw + cbase + (lane & 31)]; }
    LDS_WAIT(); asm volatile("" ::: "memory");
    const int c = lane & 7;
#pragma unroll
    for (int j = 0; j < 4; ++j) { const int n = (lane >> 3) + 8 * j; const LAS float* s = scr + (8 * c) * 33 + n;
        u32x4 o; o.x = pk2(s[0 * 33] * scale, s[1 * 33] * scale); o.y = pk2(s[2 * 33] * scale, s[3 * 33] * scale); o.z = pk2(s[4 * 33] * scale, s[5 * 33] * scale); o.w = pk2(s[6 * 33] * scale, s[7 * 33] * scale);
        const int rho = perm ? pg8::perm32inv(n) : n;
        *(u32x4*)(dst + (size_t)(drow0 + rho) * K + k0 + 8 * c) = o; }
    LDS_WAIT(); asm volatile("" ::: "memory");
}
DI void conv_item8(const float* W, int ldw, int cbase, unsigned char* dst, int K, int drow0, int k0, float scale, LAS float* scr, int lane, bool perm = true) {
    const int a = lane >> 3, b = lane & 7;
    f32x4 v[16];
#pragma unroll
    for (int i = 0; i < 16; ++i) v[i] = __builtin_nontemporal_load((const f32x4*)(W + (size_t)(k0 + 8 * i + a) * ldw + cbase + 4 * b));
#pragma unroll
    for (int i = 0; i < 16; ++i) { const int k = 8 * i + a; LAS float* d = scr + k * 33 + 4 * (k >> 4) + 4 * b; d[0] = v[i].x; d[1] = v[i].y; d[2] = v[i].z; d[3] = v[i].w; }
    LDS_WAIT(); asm volatile("" ::: "memory");
    const int c = lane & 7;
#pragma unroll
    for (int j = 0; j < 4; ++j) { const int n = (lane >> 3) + 8 * j; const LAS float* s = scr + (16 * c) * 33 + 4 * c + n;
        u32x4 o;
#pragma unroll
        for (int q = 0; q < 4; ++q) o[q] = pk4_fp8(s[(4 * q) * 33] * scale, s[(4 * q + 1) * 33] * scale, s[(4 * q + 2) * 33] * scale, s[(4 * q + 3) * 33] * scale);
        __builtin_nontemporal_store(o, (u32x4*)(dst + (size_t)(drow0 + (perm ? pg8::perm32inv(n) : n)) * K + k0 + 16 * c)); }
    LDS_WAIT(); asm volatile("" ::: "memory");
}
DI void rms_row_to_bf16(const float* xrow, const float* g, bf16_t* orow, int lane) {
    const f32x4* xr = (const f32x4*)xrow + lane; const f32x4* gr = (const f32x4*)g + lane;
    f32x4 v[4]; float s = 0.f;
#pragma unroll
    for (int j = 0; j < 4; ++j) { v[j] = xr[64 * j]; s += (v[j].x * v[j].x + v[j].y * v[j].y) + (v[j].z * v[j].z + v[j].w * v[j].w); }
    const float rinv = __builtin_amdgcn_rsqf(wave_sum(s) * (1.f / D) + RMS_EPS);
    unsigned long long* o8 = (unsigned long long*)orow + lane;
#pragma unroll
    for (int j = 0; j < 4; ++j) { const f32x4 gg = gr[64 * j]; const f32x4 y = v[j] * rinv * gg;
        o8[64 * j] = (unsigned long long)pk2(y.x, y.y) | ((unsigned long long)pk2(y.z, y.w) << 32); }
}
constexpr int XI_PER_LE = 1536, XI_TOTAL = 32 * XI_PER_LE;
constexpr int XI_NA = 128 * NWAVES * 6, XI_NB = 192 * NWAVES * 6, XI_NC = 192 * NWAVES * 5, XI_ND = 128 * NWAVES * 16;
constexpr int XI_PRO_END = XI_TOTAL - XI_NA - XI_NB - XI_NC - XI_ND, XI_A_END = XI_PRO_END + XI_NA, XI_B_END = XI_A_END + XI_NB, XI_C_END = XI_TOTAL - XI_ND;
static_assert(XI_B_END >= XI_TOTAL / 2, "the slots after MoE layer 0 may only hold layer-1 items");
DI void expert_conv_items(Frame& F, const Args& a, int it0, int it1, int rank, int nrank) {
    LAS float* scr8 = (LAS float*)(F.lds + F.wave * 17152);
    unsigned char* ws = a.ws;
    for (int it = it0 + rank; it < it1; it += nrank) {
        const int le = it / XI_PER_LE, r = it % XI_PER_LE;
        if (r < 1024) { const int kb = r / 128, g = r % 128, pn = g >> 3, bj = (g >> 2) & 1, wc = g & 3;
            const float* W = (bj ? a.in[IN_W3] : a.in[IN_W1]) + (size_t)le * D * DE;
            conv_item8(W, DE, 128 * pn + 32 * wc, ws + WS_W13 + (size_t)le * 4096 * D, D, 32 * g, 128 * kb, 16.f, scr8, F.lane);
        } else { const int r2 = r - 1024, kb = r2 / 32, g = r2 % 32;
            conv_item8(a.in[IN_W2] + (size_t)le * DE * D, D, 32 * g, ws + WS_W2 + (size_t)le * D * DE, DE, 32 * g, 128 * kb, 32.f, scr8, F.lane); }
    }
}
DI void rms_row_to_fp8(const float* xrow, const float* g, unsigned char* orow, int lane) {
    const f32x4* xr = (const f32x4*)xrow + lane; const f32x4* gr = (const f32x4*)g + lane;
    f32x4 v[4]; float s = 0.f;
#pragma unroll
    for (int j = 0; j < 4; ++j) { v[j] = xr[64 * j]; s += (v[j].x * v[j].x + v[j].y * v[j].y) + (v[j].z * v[j].z + v[j].w * v[j].w); }
    const float rinv = __builtin_amdgcn_rsqf(wave_sum(s) * (1.f / D) + RMS_EPS);
#pragma unroll
    for (int j = 0; j < 4; ++j) { const f32x4 y = v[j] * rinv * gr[64 * j]; *((unsigned*)orow + lane + 64 * j) = pk4_fp8(y.x, y.y, y.z, y.w); }
}
DI void p0_prologue(Frame& F, const Args& a) {
    LAS float* scr = (LAS float*)(F.lds + F.wave * 17152);
    const int gw = F.vcu * NWAVES + F.wave, NGW = F.G * NWAVES;
    unsigned char* ws = a.ws;
    LAS float* scr8 = (LAS float*)(F.lds + F.wave * 17152);
    constexpr int I_QKV = 8 * 48, I_AO = 8 * 32, I_MINA = 16 * 32, I_MINB = 8 * 64, I_MO = 16 * 32, I_SMALL = I_QKV + I_AO + I_MINA + I_MINB + I_MO;
    for (int it = gw; it < I_SMALL; it += NGW) {
        int r = it;
        if (r < I_QKV) { const int kb = r / 48, g = r % 48, pn = g >> 3, bj = (g >> 2) & 1, wc = g & 3;
            conv_item8(a.in[IN_AWIN], NQKV, 256 * pn + 64 * wc + 32 * bj, ws + WS_WQKV, D, 32 * g, 128 * kb, 16.f, scr8, F.lane, true); continue; } r -= I_QKV;
        if (r < I_AO) { const int kb = r / 32, g = r % 32; conv_item8(a.in[IN_AWOUT], D, 32 * g, ws + WS_WAO, D, 32 * g, 128 * kb, 16.f, scr8, F.lane, false); continue; } r -= I_AO;
        if (r < I_MINA) { const int kb = r / 32, g = r % 32; const float sc = g >= 16 ? 0.125f : 1.f;
            conv_item(a.in[IN_MWIN], MIN_LD, 32 * g, (bf16_t*)(ws + WS_WMIN), D, 32 * g, 64 * kb, true, sc, scr, F.lane); continue; } r -= I_MINA;
        if (r < I_MINB) { const int kb = r / 64, g = r % 64;
            conv_item8(a.in[IN_MWIN], MIN_LD, 1024 + 32 * g, ws + WS_WMIN8, D, 32 * g, 128 * kb, 16.f, scr8, F.lane, true); continue; } r -= I_MINB;
        { const int kb = r / 32, g = r % 32; conv_item(a.in[IN_MWOUT], D, 32 * g, (bf16_t*)(ws + WS_WMO), D, 32 * g, 64 * kb, false, 1.f, scr, F.lane); }
    }
    for (int m = gw; m < M; m += NGW) rms_row_to_fp8(a.in[IN_X] + (size_t)m * D, a.in[IN_ANG], ws + WS_XN8 + (size_t)m * D, F.lane);
    expert_conv_items(F, a, 0, XI_PRO_END, gw, NGW);
}

constexpr int AT_K = 0, AT_V = 49152, AT_TB = 98304, AT_TB_COPY = 324, AT_TB_HEAD = 4 * AT_TB_COPY;
DI int t5_bucket_dev(int rel) {
    const int n = rel < 0 ? -rel : rel; int b;
    if (n < 8) b = n; else if (n < 12) b = 8; else if (n < 16) b = 9; else if (n < 23) b = 10; else if (n < 32) b = 11; else if (n < 46) b = 12; else if (n < 64) b = 13; else if (n < 91) b = 14; else b = 15;
    return b + (rel > 0 ? 16 : 0);
}
DI bf16x8 pack_step(const f32x16& x, int s) {
    u32x4 p;
    p.x = cvt_pk_bf16(x[8 * s + 0], x[8 * s + 1]); p.y = cvt_pk_bf16(x[8 * s + 2], x[8 * s + 3]); p.z = cvt_pk_bf16(x[8 * s + 4], x[8 * s + 5]); p.w = cvt_pk_bf16(x[8 * s + 6], x[8 * s + 7]);
    return __builtin_bit_cast(bf16x8, p);
}
typedef short v4i16_t __attribute__((ext_vector_type(4)));
DI s16x4 tr_read(const LAS unsigned char* p) { return __builtin_bit_cast(s16x4, __builtin_amdgcn_ds_read_tr16_b64_v4i16((LAS v4i16_t*)p)); }
DI bf16x8 cat8(s16x4 lo, s16x4 hi) { return __builtin_shufflevector(lo, hi, 0, 1, 2, 3, 4, 5, 6, 7); }

DI void attn_phase(Frame& F, const Args& a) {
    LAS unsigned char* lds = F.lds;
    const bf16_t* Qg = (const bf16_t*)(a.ws + WS_Q); const bf16_t* Kg = (const bf16_t*)(a.ws + WS_K); const bf16_t* Vg = (const bf16_t*)(a.ws + WS_V); unsigned char* Og = a.ws + WS_O;
    const float* relb = a.in[IN_RELB]; const float* sink = a.in[IN_ASINK];
    const int lane = F.lane, wave = F.wave, r = lane & 31, h = lane >> 5;
    const int g = wave >> 1, half = wave & 1;
    LAS float* TB = (LAS float*)(lds + AT_TB);
    constexpr int NPF = 6;
    u32x4 kvr[NPF];
#define AT_LOAD(u_) do { const int qb_ = (u_) & 31, kvh_ = ((u_) >> 5) & 3, b_ = (u_) >> 7, kb_ = qb_ * 128 - 128; \
        _Pragma("unroll") for (int i = 0; i < NPF; ++i) { const int idx = F.tid + i * NTHR, isv = idx >= 3072, rem = isv ? idx - 3072 : idx, row = rem >> 3, c = rem & 7; int kp = kb_ + row; kp = kp < 0 ? 0 : (kp >= SEQ ? SEQ - 1 : kp); \
            kvr[i] = *(const u32x4*)((isv ? Vg : Kg) + (size_t)(b_ * SEQ + kp) * 256 + kvh_ * 64 + c * 8); } } while (0)
    int tb_kvh = -1;
    if (F.vcu < 512) AT_LOAD(F.vcu);
    for (int u = F.vcu; u < 512; u += F.G) {
        const int qb = u & 31, kvh = (u >> 5) & 3, b = u >> 7;
        const int kbase = qb * 128 - 128;
        __syncthreads();
        if (kvh != tb_kvh) { tb_kvh = kvh;
#pragma unroll 4
            for (int idx = F.tid; idx < 4 * AT_TB_HEAD; idx += NTHR) {
                const int gg = idx / AT_TB_HEAD, rem = idx % AT_TB_HEAD, c = rem / AT_TB_COPY, i = rem % AT_TB_COPY, rel = i + c - 160;
                float v = -__builtin_inff();
                if (rel >= -128 && rel <= 128) v = relb[t5_bucket_dev(rel) * 16 + kvh * 4 + gg] * LOG2E;
                TB[idx] = v;
            } }
        u32x4 late[12 - NPF];
#pragma unroll
        for (int i = NPF; i < 12; ++i) { const int idx = F.tid + i * NTHR, isv = idx >= 3072, rem = isv ? idx - 3072 : idx, row = rem >> 3, c = rem & 7; int kp = kbase + row; kp = kp < 0 ? 0 : (kp >= SEQ ? SEQ - 1 : kp);
            late[i - NPF] = *(const u32x4*)((isv ? Vg : Kg) + (size_t)(b * SEQ + kp) * 256 + kvh * 64 + c * 8); }
#pragma unroll
        for (int i = 0; i < 12; ++i) { const int idx = F.tid + i * NTHR, isv = idx >= 3072, rem = isv ? idx - 3072 : idx, row = rem >> 3, c = rem & 7;
            const int pos = isv ? (c ^ (((row >> 1) & 1) << 2)) : (c ^ ((row >> 1) & 7));
            *(LAS u32x4*)(lds + (isv ? AT_V : AT_K) + row * 128 + pos * 16) = i < NPF ? kvr[i] : late[i < NPF ? 0 : i - NPF]; }
        if (u + F.G < 512) AT_LOAD(u + F.G);
        const int head = kvh * 4 + g, qw0 = qb * 128 + 64 * half;
        bf16x8 qf[2][4];
#pragma unroll
        for (int qt = 0; qt < 2; ++qt)
#pragma unroll
            for (int s = 0; s < 4; ++s) qf[qt][s] = *(const bf16x8*)(Qg + (size_t)(b * SEQ + qw0 + 32 * qt + r) * 1024 + head * 64 + 16 * s + 8 * h);
        __syncthreads();
        const float sk = sink[head] * LOG2E;
        float mrun[2] = {sk, sk}, lrun[2] = {h == 0 ? 1.f : 0.f, h == 0 ? 1.f : 0.f};
        f32x16 o[2][2];
#pragma unroll
        for (int qt = 0; qt < 2; ++qt)
#pragma unroll
            for (int dt = 0; dt < 2; ++dt)
#pragma unroll
                for (int i = 0; i < 16; ++i) o[qt][dt][i] = 0.f;
        const int cpy = (4 - (r & 3)) & 3;
        const LAS float* tbl = TB + g * AT_TB_HEAD + cpy * AT_TB_COPY + (32 + 4 * h - r - cpy);
        const int q4 = (lane & 15) >> 2, p4 = lane & 3, blk = (lane >> 4) & 1;
        for (int T = 2 * half; T < 2 * half + 10; ++T) {
            const int kp0 = kbase + 32 * T;
            if (kp0 < 0 || kp0 >= SEQ) continue;
            bf16x8 kf[4];
            { const int row = 32 * T + r;
#pragma unroll
              for (int s = 0; s < 4; ++s) kf[s] = *(const LAS bf16x8*)(lds + AT_K + row * 128 + (((2 * s + h) ^ ((row >> 1) & 7)) << 4)); }
            bf16x8 vf[2][2];
#pragma unroll
            for (int dt = 0; dt < 2; ++dt)
#pragma unroll
                for (int s = 0; s < 2; ++s) {
                    const int row0 = 32 * T + 16 * s + 4 * h + q4, row1 = row0 + 8, cb = 64 * dt + 32 * blk + 8 * p4;
                    const s16x4 lo = tr_read(lds + AT_V + row0 * 128 + (cb ^ (((row0 >> 1) & 1) << 6)));
                    const s16x4 hi = tr_read(lds + AT_V + row1 * 128 + (cb ^ (((row1 >> 1) & 1) << 6)));
                    vf[dt][s] = cat8(lo, hi);
                }
#pragma unroll
            for (int qt = 0; qt < 2; ++qt) {
                const int kt = T - 2 * half - qt;
                if (kt < 0 || kt > 8) continue;
                f32x16 sacc;
#pragma unroll
                for (int G4 = 0; G4 < 4; ++G4) { const f32x4 t = *(const LAS f32x4*)(tbl + 32 * kt + 8 * G4);
                    sacc[4 * G4 + 0] = t[0]; sacc[4 * G4 + 1] = t[1]; sacc[4 * G4 + 2] = t[2]; sacc[4 * G4 + 3] = t[3]; }
#pragma unroll
                for (int s = 0; s < 4; ++s) sacc = __builtin_amdgcn_mfma_f32_32x32x16_bf16(kf[s], qf[qt][s], sacc, 0, 0, 0);
                float mx = sacc[0];
#pragma unroll
                for (int i = 1; i < 16; ++i) mx = fmaxf(mx, sacc[i]);
                mx = fmaxf(mx, __shfl_xor(mx, 32));
                const float mnew = fmaxf(mrun[qt], mx), alpha = __builtin_amdgcn_exp2f(mrun[qt] - mnew);
                mrun[qt] = mnew;
                float ls = 0.f;
#pragma unroll
                for (int i = 0; i < 16; ++i) { sacc[i] = __builtin_amdgcn_exp2f(sacc[i] - mnew); ls += sacc[i]; }
                lrun[qt] = lrun[qt] * alpha + ls;
#pragma unroll
                for (int dt = 0; dt < 2; ++dt)
#pragma unroll
                    for (int i = 0; i < 16; ++i) o[qt][dt][i] *= alpha;
                const bf16x8 p0 = pack_step(sacc, 0), p1 = pack_step(sacc, 1);
#pragma unroll
                for (int dt = 0; dt < 2; ++dt) {
                    o[qt][dt] = __builtin_amdgcn_mfma_f32_32x32x16_bf16(vf[dt][0], p0, o[qt][dt], 0, 0, 0);
                    o[qt][dt] = __builtin_amdgcn_mfma_f32_32x32x16_bf16(vf[dt][1], p1, o[qt][dt], 0, 0, 0);
                }
            }
        }
#pragma unroll
        for (int qt = 0; qt < 2; ++qt) {
            const float lt = lrun[qt] + __shfl_xor(lrun[qt], 32), inv = 16.f / lt;
            unsigned char* orow = Og + (size_t)(b * SEQ + qw0 + 32 * qt + r) * 1024 + head * 64;
#pragma unroll
            for (int dt = 0; dt < 2; ++dt)
#pragma unroll
                for (int G4 = 0; G4 < 4; ++G4)
                    *(unsigned*)(orow + 32 * dt + 8 * G4 + 4 * h) = pk4_fp8(o[qt][dt][4 * G4] * inv, o[qt][dt][4 * G4 + 1] * inv, o[qt][dt][4 * G4 + 2] * inv, o[qt][dt][4 * G4 + 3] * inv);
        }
    }
#undef AT_LOAD
}

template <int N> DI int multi_reduce(float (&v)[N], int lane) {
    int idx = 0;
#pragma unroll
    for (int bit = 32, cnt = N / 2; cnt >= 1; bit >>= 1, cnt >>= 1) {
        const bool upper = (lane & bit) != 0;
#pragma unroll
        for (int i = 0; i < cnt; ++i) { const float lo = v[i], hi = v[i + cnt]; const float send = upper ? lo : hi, keep = upper ? hi : lo; v[i] = keep + __shfl_xor(send, bit); }
        idx |= upper ? cnt : 0;
    }
#pragma unroll
    for (int bit = 32 / N; bit >= 1; bit >>= 1) v[0] += __shfl_xor(v[0], bit);
    return idx;
}
DI float log_sigmoid(float x) { return x < 0.f ? x - log1pf(expf(x)) : -log1pf(expf(-x)); }
DI void add_routed_rows(f32x4 (&x)[4], const unsigned char* Y, int sl, int b, int lane) {
    unsigned long long mask = __ballot(sl >= 0);
    while (mask) {
        const unsigned char* yr[4]; float wq[4];
#pragma unroll
        for (int q = 0; q < 4; ++q) { const bool v = mask != 0ull; const int e = v ? __builtin_ctzll(mask) : 0; if (v) mask &= mask - 1;
            const int sv = __builtin_amdgcn_readlane(sl, e); wq[q] = v ? 1.f / YS8 : 0.f;
            yr[q] = (v || q == 0) ? Y + (size_t)((e * NB + b) * CAP + sv) * D : yr[0]; }
        unsigned w[4][4];
#pragma unroll
        for (int q = 0; q < 4; ++q)
#pragma unroll
            for (int j = 0; j < 4; ++j) w[q][j] = __builtin_nontemporal_load((const unsigned*)yr[q] + lane + 64 * j);
#pragma unroll
        for (int q = 0; q < 4; ++q)
#pragma unroll
            for (int j = 0; j < 4; ++j) { const f32x2 lo = __builtin_amdgcn_cvt_pk_f32_fp8(w[q][j], false), hi = __builtin_amdgcn_cvt_pk_f32_fp8(w[q][j], true);
                x[j].x += wq[q] * lo.x; x[j].y += wq[q] * lo.y; x[j].z += wq[q] * hi.x; x[j].w += wq[q] * hi.y; }
    }
}
template <int NEV, bool COMBINE>
DI void nr_phase(Frame& F, const bf16_t* base, const unsigned char* Y, const int* slot, bf16_t* xout, const float* g, bf16_t* XN, unsigned char* XN8,
                 const float* Wsrc, int ldw, int col0, float* outv, const float* b_i, const float* b_f) {
    LAS float* Wt = (LAS float*)F.lds;
    { f32x4 wv[NEV / 2];
#pragma unroll
      for (int i = 0; i < NEV / 2; ++i) { const int idx = F.tid + i * NTHR, d = idx / (NEV / 4), e4 = idx % (NEV / 4); wv[i] = *(const f32x4*)(Wsrc + (size_t)d * ldw + col0 + 4 * e4); }
#pragma unroll
      for (int i = 0; i < NEV / 2; ++i) { const int idx = F.tid + i * NTHR, d = idx / (NEV / 4), e4 = idx % (NEV / 4);
#pragma unroll
          for (int q = 0; q < 4; ++q) Wt[(4 * e4 + q) * 1024 + d] = wv[i][q]; } }
    const int gw = F.vcu * NWAVES + F.wave, NGW = F.G * NWAVES, lane = F.lane;
    LAS float* res = (LAS float*)(F.lds + AUX_OFF) + F.wave * 64;
    f32x4 gg[4];
#pragma unroll
    for (int j = 0; j < 4; ++j) gg[j] = *((const f32x4*)g + lane + 64 * j);
    __syncthreads();
#pragma unroll 1
    for (int m0 = gw; m0 < M; m0 += 4 * NGW) {
        f32x4 x[4][4]; int sl[4];
#pragma unroll
        for (int t4 = 0; t4 < 4; ++t4) { const int m = m0 + t4 * NGW < M ? m0 + t4 * NGW : m0;
#pragma unroll
            for (int j = 0; j < 4; ++j) { const u32x2 w = __builtin_nontemporal_load((const u32x2*)(base + (size_t)m * D) + lane + 64 * j);
                x[t4][j] = (f32x4){__builtin_bit_cast(float, w.x << 16), __builtin_bit_cast(float, w.x & 0xffff0000u), __builtin_bit_cast(float, w.y << 16), __builtin_bit_cast(float, w.y & 0xffff0000u)}; }
            sl[t4] = (COMBINE && lane < NE) ? slot[(size_t)m * NE + lane] : -1; }
#pragma unroll
        for (int pp = 0; pp < 4; pp += 2) {
            int mm[2]; float ssv[2];
#pragma unroll
            for (int u = 0; u < 2; ++u) {
                const int t4 = pp + u; const int m = m0 + t4 * NGW < M ? m0 + t4 * NGW : m0; mm[u] = m;
                if (COMBINE) add_routed_rows(x[t4], Y, sl[t4], m / SEQ, lane);
                if (xout) {
#pragma unroll
                    for (int j = 0; j < 4; ++j) { u32x2 w; w.x = cvt_pk_bf16(x[t4][j].x, x[t4][j].y); w.y = cvt_pk_bf16(x[t4][j].z, x[t4][j].w); *((u32x2*)(xout + (size_t)m * D) + lane + 64 * j) = w;
                        x[t4][j] = (f32x4){__builtin_bit_cast(float, w.x << 16), __builtin_bit_cast(float, w.x & 0xffff0000u), __builtin_bit_cast(float, w.y << 16), __builtin_bit_cast(float, w.y & 0xffff0000u)}; }
                }
                float ss = 0.f;
#pragma unroll
                for (int j = 0; j < 4; ++j) ss += (x[t4][j].x * x[t4][j].x + x[t4][j].y * x[t4][j].y) + (x[t4][j].z * x[t4][j].z + x[t4][j].w * x[t4][j].w);
                const float sst = wave_sum(ss); ssv[u] = sst;
                const float rinv = NEV == 16 ? 1.f : __builtin_amdgcn_rsqf(sst * (1.f / D) + RMS_EPS);
#pragma unroll
                for (int j = 0; j < 4; ++j) { x[t4][j] = x[t4][j] * rinv * gg[j];
                    if (NEV == 32) *((unsigned long long*)(XN + (size_t)m * D) + lane + 64 * j) = (unsigned long long)pk2(x[t4][j].x, x[t4][j].y) | ((unsigned long long)pk2(x[t4][j].z, x[t4][j].w) << 32);
                    else *((unsigned*)(XN8 + (size_t)m * D) + lane + 64 * j) = pk4_fp8(x[t4][j].x, x[t4][j].y, x[t4][j].z, x[t4][j].w); }
            }
#pragma unroll 1
            for (int eg = 0; eg < NEV / 4; ++eg) {
                float v8[8];
#pragma unroll
                for (int e4 = 0; e4 < 4; ++e4) { float s0 = 0.f, s1 = 0.f;
#pragma unroll
                    for (int j = 0; j < 4; ++j) { const f32x4 w = *((const LAS f32x4*)(Wt + (4 * eg + e4) * 1024) + lane + 64 * j);
                        s0 += (x[pp][j].x * w.x + x[pp][j].y * w.y) + (x[pp][j].z * w.z + x[pp][j].w * w.w); s1 += (x[pp + 1][j].x * w.x + x[pp + 1][j].y * w.y) + (x[pp + 1][j].z * w.z + x[pp + 1][j].w * w.w); }
                    v8[e4] = s0; v8[4 + e4] = s1; }
                const int i8 = multi_reduce<8>(v8, lane);
                if ((lane & 7) == 0) res[(i8 >> 2) * 32 + 4 * eg + (i8 & 3)] = v8[0];
            }
            asm volatile("s_waitcnt lgkmcnt(0)" ::: "memory");
            if (NEV == 16) {
                const int u = (lane >> 4) & 1, e = lane & 15, m = mm[u];
                if (lane < 32) { outv[(size_t)e * M + m] = res[u * 32 + e]; if (e == 0) outv[(size_t)16 * M + m] = ssv[u]; }
#pragma unroll
                for (int q = 0; q < 2; ++q) { const int idx = lane + 64 * q; if (idx < 102) { const int uu = idx / 51, r51 = idx % 51; outv[(size_t)(17 + r51) * M + mm[uu]] = 0.f; } }
            } else {
                const int u = lane >> 5, k = lane & 31, m = mm[u];
                const float v = res[u * 32 + k];
                const int kind = k >> 3, hd = k & 7, dir = kind >> 1;
                outv[(size_t)m * 32 + k] = (kind & 1) ? log_sigmoid(v + b_f[dir * 8 + hd]) : v + b_i[dir * 8 + hd];
            }
            asm volatile("" ::: "memory");
        }
    }
}
constexpr int NRM_WB = 0, NRM_WB_LD = 2128, NRM_XR = 32 * NRM_WB_LD, NRM_XR_LD = 2112;
static_assert(NRM_XR + NWAVES * 4 * NRM_XR_LD <= AUX_OFF + AUX_BYTES, "nrm_phase LDS");
DI void nrm_phase(Frame& F, const bf16_t* base, const unsigned char* Y, const int* slot, bf16_t* xout, const float* g, bf16_t* XN, unsigned char* XN8,
                  const float* Wsrc, int ldw, int col0, float* outv, const float* b_i, const float* b_f) {
    LAS unsigned char* lds = F.lds;
    { f32x4 wv[16];
#pragma unroll
      for (int i = 0; i < 16; ++i) { const int idx = F.tid + i * NTHR, d = idx >> 3, e4 = idx & 7; wv[i] = *(const f32x4*)(Wsrc + (size_t)d * ldw + col0 + 4 * e4); }
#pragma unroll
      for (int i = 0; i < 16; ++i) { const int idx = F.tid + i * NTHR, d = idx >> 3, e4 = idx & 7;
#pragma unroll
          for (int q = 0; q < 4; ++q) *(LAS unsigned short*)(lds + NRM_WB + (4 * e4 + q) * NRM_WB_LD + d * 2) = (unsigned short)f2bf(wv[i][q]); } }
    const int gw = F.vcu * NWAVES + F.wave, NGW = F.G * NWAVES, lane = F.lane, fr = lane & 15, fq = lane >> 4;
    LAS unsigned char* xr = lds + NRM_XR + F.wave * 4 * NRM_XR_LD;
    f32x4 gg[4];
#pragma unroll
    for (int j = 0; j < 4; ++j) gg[j] = *((const f32x4*)g + lane + 64 * j);
    float bias[2]; bool isf[2];
#pragma unroll
    for (int n = 0; n < 2; ++n) { const int k = fr + 16 * n, kind = k >> 3, hd = k & 7, dir = kind >> 1; isf[n] = (kind & 1) != 0; bias[n] = isf[n] ? b_f[dir * 8 + hd] : b_i[dir * 8 + hd]; }
    __syncthreads();
#pragma unroll 1
    for (int m0 = gw; m0 < M; m0 += 4 * NGW) {
        f32x4 x[4][4]; int sl[4]; int mm[4];
#pragma unroll
        for (int t4 = 0; t4 < 4; ++t4) { const int m = m0 + t4 * NGW < M ? m0 + t4 * NGW : m0; mm[t4] = m;
#pragma unroll
            for (int j = 0; j < 4; ++j) { const u32x2 w = __builtin_nontemporal_load((const u32x2*)(base + (size_t)m * D) + lane + 64 * j);
                x[t4][j] = (f32x4){__builtin_bit_cast(float, w.x << 16), __builtin_bit_cast(float, w.x & 0xffff0000u), __builtin_bit_cast(float, w.y << 16), __builtin_bit_cast(float, w.y & 0xffff0000u)}; }
            sl[t4] = lane < NE ? slot[(size_t)m * NE + lane] : -1; }
#pragma unroll
        for (int t4 = 0; t4 < 4; ++t4) { const int m = mm[t4];
            add_routed_rows(x[t4], Y, sl[t4], m / SEQ, lane);
#pragma unroll
            for (int j = 0; j < 4; ++j) { u32x2 w; w.x = cvt_pk_bf16(x[t4][j].x, x[t4][j].y); w.y = cvt_pk_bf16(x[t4][j].z, x[t4][j].w); *((u32x2*)(xout + (size_t)m * D) + lane + 64 * j) = w;
                x[t4][j] = (f32x4){__builtin_bit_cast(float, w.x << 16), __builtin_bit_cast(float, w.x & 0xffff0000u), __builtin_bit_cast(float, w.y << 16), __builtin_bit_cast(float, w.y & 0xffff0000u)}; }
            float ss = 0.f;
#pragma unroll
            for (int j = 0; j < 4; ++j) ss += (x[t4][j].x * x[t4][j].x + x[t4][j].y * x[t4][j].y) + (x[t4][j].z * x[t4][j].z + x[t4][j].w * x[t4][j].w);
            const float rinv = __builtin_amdgcn_rsqf(wave_sum(ss) * (1.f / D) + RMS_EPS);
#pragma unroll
            for (int j = 0; j < 4; ++j) { const f32x4 hn = x[t4][j] * rinv * gg[j]; u32x2 w; w.x = cvt_pk_bf16(hn.x, hn.y); w.y = cvt_pk_bf16(hn.z, hn.w);
                *((u32x2*)(XN + (size_t)m * D) + lane + 64 * j) = w; *(LAS u32x2*)(xr + t4 * NRM_XR_LD + (4 * lane + 256 * j) * 2) = w;
                *((unsigned*)(XN8 + (size_t)m * D) + lane + 64 * j) = pk4_fp8(hn.x, hn.y, hn.z, hn.w); }
        }
        asm volatile("s_waitcnt lgkmcnt(0)" ::: "memory");
        f32x4 ga[2] = {(f32x4){0.f, 0.f, 0.f, 0.f}, (f32x4){0.f, 0.f, 0.f, 0.f}};
#pragma unroll 4
        for (int ks = 0; ks < 32; ++ks) {
            bf16x8 a = (bf16x8){0, 0, 0, 0, 0, 0, 0, 0};
            if (fr < 4) a = *(const LAS bf16x8*)(xr + fr * NRM_XR_LD + (32 * ks + 8 * fq) * 2);
            const bf16x8 b0 = *(const LAS bf16x8*)(lds + NRM_WB + fr * NRM_WB_LD + (32 * ks + 8 * fq) * 2), b1 = *(const LAS bf16x8*)(lds + NRM_WB + (16 + fr) * NRM_WB_LD + (32 * ks + 8 * fq) * 2);
            ga[0] = __builtin_amdgcn_mfma_f32_16x16x32_bf16(a, b0, ga[0], 0, 0, 0); ga[1] = __builtin_amdgcn_mfma_f32_16x16x32_bf16(a, b1, ga[1], 0, 0, 0);
        }
        if (fq == 0) {
#pragma unroll
            for (int n = 0; n < 2; ++n)
#pragma unroll
                for (int j = 0; j < 4; ++j) { const float v = ga[n][j] + bias[n]; outv[(size_t)mm[j] * 32 + fr + 16 * n] = isf[n] ? log_sigmoid(v) : v; } }
        asm volatile("" ::: "memory");
    }
}
DI int block_excl_scan(int v, LAS int* wsum, int lane, int wave, int& total) {
    int inc = v;
#pragma unroll
    for (int o = 1; o < 64; o <<= 1) { const int t = __shfl_up(inc, o); if (lane >= o) inc += t; }
    if (lane == 63) wsum[wave] = inc;
    __syncthreads();
    int basev = 0, tot = 0;
#pragma unroll
    for (int w = 0; w < NWAVES; ++w) { const int x = wsum[w]; basev += (w < wave) ? x : 0; tot += x; }
    __syncthreads();
    total = tot;
    return basev + inc - v;
}
DI void topk_phase(Frame& F, const float* part, int* idxrow, float* gate, float* rsc, int* slot) {
    LAS unsigned* hist = (LAS unsigned*)F.lds; LAS unsigned* sh = hist + 4096; LAS int* wsum = (LAS int*)(hist + 4112);
    const int tid = F.tid;
    for (int p = blockIdx.x; p < NB * NE; p += F.G) {
        const int b = p / NE, e = p % NE;
        unsigned v[8]; float rinv8[8];
        { const float* pb = part + (size_t)b * SEQ + 8 * tid;
          float ssum[8], mx[8], sm[8], lm[8];
#pragma unroll
          for (int i = 0; i < 8; ++i) { ssum[i] = 0.f; mx[i] = -__builtin_inff(); sm[i] = 0.f; lm[i] = 0.f; }
#pragma unroll
          for (int pn = 0; pn < 4; ++pn) { const f32x4 a0 = *(const f32x4*)(pb + (size_t)(pn * 17 + 16) * M), a1 = *(const f32x4*)(pb + (size_t)(pn * 17 + 16) * M + 4);
#pragma unroll
              for (int i = 0; i < 4; ++i) { ssum[i] += a0[i]; ssum[4 + i] += a1[i]; } }
#pragma unroll
          for (int i = 0; i < 8; ++i) rinv8[i] = __builtin_amdgcn_rsqf(ssum[i] * (1.f / D) + RMS_EPS);
#pragma unroll 4
          for (int ee = 0; ee < NE; ++ee) { float l[8];
#pragma unroll
              for (int i = 0; i < 8; ++i) l[i] = 0.f;
#pragma unroll
              for (int pn = 0; pn < 4; ++pn) { const f32x4 a0 = *(const f32x4*)(pb + (size_t)(pn * 17 + ee) * M), a1 = *(const f32x4*)(pb + (size_t)(pn * 17 + ee) * M + 4);
#pragma unroll
                  for (int i = 0; i < 4; ++i) { l[i] += a0[i]; l[4 + i] += a1[i]; } }
#pragma unroll
              for (int i = 0; i < 8; ++i) { const float li = l[i] * rinv8[i], mn = fmaxf(mx[i], li); sm[i] = sm[i] * __expf(mx[i] - mn) + __expf(li - mn); mx[i] = mn; lm[i] = ee == e ? li : lm[i]; } }
#pragma unroll
          for (int i = 0; i < 8; ++i) v[i] = __builtin_bit_cast(unsigned, __expf(lm[i] - mx[i]) / sm[i]); }
        unsigned prefix = 0u; int need = CAP;
#pragma unroll 1
        for (int pass = 0; pass < 3; ++pass) {
            const int shift = pass == 0 ? 20 : (pass == 1 ? 8 : 0), hs = pass == 0 ? 31 : (pass == 1 ? 20 : 8);
            *((LAS u32x4*)hist + 2 * tid) = (u32x4){0u, 0u, 0u, 0u}; *((LAS u32x4*)hist + 2 * tid + 1) = (u32x4){0u, 0u, 0u, 0u};
            __syncthreads();
#pragma unroll
            for (int i = 0; i < 8; ++i) if (pass == 0 || (v[i] >> hs) == prefix) __hip_atomic_fetch_add(&hist[(v[i] >> shift) & (pass == 2 ? 0xffu : 0xfffu)], 1u, __ATOMIC_RELAXED, __HIP_MEMORY_SCOPE_WORKGROUP);
            __syncthreads();
            const u32x4 c0 = *((const LAS u32x4*)hist + 2 * tid), c1 = *((const LAS u32x4*)hist + 2 * tid + 1);
            const int cnt[8] = {(int)c0.x, (int)c0.y, (int)c0.z, (int)c0.w, (int)c1.x, (int)c1.y, (int)c1.z, (int)c1.w};
            const int ls = ((cnt[0] + cnt[1]) + (cnt[2] + cnt[3])) + ((cnt[4] + cnt[5]) + (cnt[6] + cnt[7]));
            int tot; const int pre = block_excl_scan(ls, wsum, F.lane, F.wave, tot);
            int run = tot - pre - ls;
#pragma unroll
            for (int j = 7; j >= 0; --j) { if (run < need && run + cnt[j] >= need) { sh[0] = (unsigned)(8 * tid + j); sh[1] = (unsigned)(need - run); } run += cnt[j]; }
            __syncthreads();
            prefix = pass == 0 ? sh[0] : ((prefix << (pass == 1 ? 12 : 8)) | sh[0]); need = (int)sh[1];
        }
        const unsigned T = prefix;
        int ce = 0;
#pragma unroll
        for (int i = 0; i < 8; ++i) ce += (v[i] == T) ? 1 : 0;
        int tot;
        int eqr = block_excl_scan(ce, wsum, F.lane, F.wave, tot);
        unsigned selm = 0u; int cs = 0;
#pragma unroll
        for (int i = 0; i < 8; ++i) { bool sel = v[i] > T; if (v[i] == T) { sel = eqr < need; ++eqr; } if (sel) { selm |= 1u << i; ++cs; } }
        int pos = block_excl_scan(cs, wsum, F.lane, F.wave, tot);
#pragma unroll
        for (int i = 0; i < 8; ++i) { const int t = 8 * tid + i; int sv = -1;
            if (selm & (1u << i)) { const int row = (e * NB + b) * CAP + pos; idxrow[row] = b * SEQ + t; gate[row] = __builtin_bit_cast(float, v[i]); rsc[row] = rinv8[i]; sv = pos; ++pos; }
            slot[(size_t)(b * SEQ + t) * NE + e] = sv; }
        __syncthreads();
    }
}
DI void combine_phase(Frame& F, const bf16_t* base, const unsigned char* Y, const int* slot, float* out) {
    const int gw = F.vcu * NWAVES + F.wave, NGW = F.G * NWAVES, lane = F.lane;
    for (int m0 = gw; m0 < M; m0 += 4 * NGW) {
        f32x4 x[4][4]; int sl[4];
#pragma unroll
        for (int t4 = 0; t4 < 4; ++t4) { const int m = m0 + t4 * NGW < M ? m0 + t4 * NGW : m0;
#pragma unroll
            for (int j = 0; j < 4; ++j) { const u32x2 w = __builtin_nontemporal_load((const u32x2*)(base + (size_t)m * D) + lane + 64 * j);
                x[t4][j] = (f32x4){__builtin_bit_cast(float, w.x << 16), __builtin_bit_cast(float, w.x & 0xffff0000u), __builtin_bit_cast(float, w.y << 16), __builtin_bit_cast(float, w.y & 0xffff0000u)}; }
            sl[t4] = lane < NE ? slot[(size_t)m * NE + lane] : -1; }
#pragma unroll
        for (int t4 = 0; t4 < 4; ++t4) { const int m = m0 + t4 * NGW < M ? m0 + t4 * NGW : m0;
            add_routed_rows(x[t4], Y, sl[t4], m / SEQ, lane);
#pragma unroll
            for (int j = 0; j < 4; ++j) __builtin_nontemporal_store(x[t4][j], (f32x4*)(out + (size_t)m * D) + lane + 64 * j); }
    }
}
DI void moe_up_phase(Frame& F, unsigned char* ws, int l) {
    pg8::MoeUpOrder S{F.vcu, F.G, (const char*)(ws + WS_W13 + (size_t)l * W13_LAYER)};
    LAS int* il = (LAS int*)(F.lds + AUX_OFF); const int* idxrow = (const int*)(ws + WS_IDX);
    pg8::Unit u;
    LAS float* rl = (LAS float*)(F.lds + AUX_OFF + 8192); const float* rsc = (const float*)(ws + WS_RSC);
    for (int i = 0; i < 8 && S.next(i, u); ++i) { if (F.tid < 256) il[i * 256 + F.tid] = idxrow[u.pm * 256 + F.tid]; else rl[i * 256 + F.tid - 256] = rsc[u.pm * 256 + F.tid - 256]; }
    __syncthreads();
    pg8::EpiSwiGLU E{(unsigned char*)(ws + WS_H), rl};
    pg8::gemm_phase<pg8::EpiSwiGLU, pg8::MoeUpOrder, true, true, true>(F.lds, il, (const void*)(ws + WS_XN8), D, S, E);
}
DI void moe_down_phase(Frame& F, unsigned char* ws, int l) {
    pg8::MoeDownOrder S{F.vcu, F.G, (const char*)(ws + WS_W2 + (size_t)l * W2_LAYER)};
    pg8::EpiFp8 E{ws + WS_Y, D, (const float*)(ws + WS_GATE), 0.03125f * YS8};
    pg8::gemm_phase<pg8::EpiFp8, pg8::MoeDownOrder, false, true, true>(F.lds, nullptr, (const void*)(ws + WS_H), DE, S, E);
}

DI int off128r(int row, int chunk) { return row * 128 + ((chunk ^ ((row >> 1) & 7)) << 4); }
DI int off128t(int row, int colbyte) { return row * 128 + (colbyte ^ (((row >> 1) & 1) << 6)); }
DI int off256t(int row, int colbyte) { return row * 256 + (colbyte ^ ((row & 3) << 6)); }
DI float wave_max(float v) {
#pragma unroll
    for (int o = 1; o < 64; o <<= 1) v = fmaxf(v, __shfl_xor(v, o));
    return v;
}
DI float incl_prefix(float v, int lane) {
#pragma unroll
    for (int o = 1; o < 64; o <<= 1) { const float t = __shfl_up(v, o); if (lane >= o) v += t; }
    return v;
}
DI float incl_suffix(float v, int lane) {
#pragma unroll
    for (int o = 1; o < 64; o <<= 1) { const float t = __shfl_down(v, o); if (lane + o < 64) v += t; }
    return v;
}
DI u32x4 scale_bf16x8(u32x4 v, float w) {
    u32x4 o;
#pragma unroll
    for (int i = 0; i < 4; ++i) { const float lo = __builtin_bit_cast(float, v[i] << 16) * w, hi = __builtin_bit_cast(float, v[i] & 0xffff0000u) * w; o[i] = cvt_pk_bf16(lo, hi); }
    return o;
}
constexpr int SS_KW = 0, SS_V = 32768, SS_WS = 98304, SS_SC = 114688;
DI int ss_kw_off(int row, int colbyte) { return row * 128 + (colbyte ^ ((((row >> 1) & 1) | (((row >> 3) & 1) << 1)) << 5)); }
DI int ss_v_off(int row, int colbyte) { return row * 256 + (colbyte ^ ((row & 3) << 6) ^ (((row >> 3) & 1) << 5)); }
template <int ES> DI void mlstm_scan_seq(Frame& F, unsigned char* ws, int seq, int half) {
    constexpr int NT = 4 / ES, VB = 16384 / ES; const int eoff = half * (128 / ES);
    LAS unsigned char* lds = F.lds;
    const bf16_t* P = (const bf16_t*)(ws + WS_PROJ); const float* MG = (const float*)(ws + WS_MG);
    bf16_t* STATE = (bf16_t*)(ws + WS_STATE); float* NST = (float*)(ws + WS_NST); float* MST = (float*)(ws + WS_MST);
    const int tid = F.tid, lane = F.lane, wave = F.wave, fr = lane & 15, fq = lane >> 4;
    LAS float* WS = (LAS float*)(lds + SS_WS); LAS float* ML = (LAS float*)(lds + SS_SC); LAS float* BL = ML + 64; LAS float* DEC = ML + 128; LAS float* LINJ = ML + 192; LAS float* MENT = ML + 256;
    {
        const int dir = seq >> 5, bh = seq & 31, b = bh >> 3, hd = bh & 7;
        __syncthreads();
        float igv[8], lfv[8];
#pragma unroll
        for (int i = 0; i < 8; ++i) { const float* mg = MG + ((size_t)b * SEQ + 64 * (8 * wave + i) + lane) * 32 + hd; igv[i] = mg[dir ? 16 : 0]; lfv[i] = mg[dir ? 24 : 8]; }
#pragma unroll
        for (int i = 0; i < 8; ++i) { const int c = 8 * wave + i; const float ig = igv[i], lf = lfv[i];
            float g, bl;
            if (dir == 0) { const float bf = incl_prefix(lf, lane); bl = __shfl(bf, 63); g = bl - bf + ig; }
            else { const float sb = incl_suffix(lf, lane); bl = __shfl(sb, 0); g = (bl - sb) + ig; }
            const float ml = wave_max(g);
            WS[c * 64 + lane] = g - ml; if (lane == 0) { ML[c] = ml; BL[c] = bl; } }
        __syncthreads();
        if (wave == 0) { const int cl = dir ? 63 - lane : lane; const float mlv = ML[cl], blv = BL[cl];
            float m = 0.f, dec = 0.f, linj = 0.f, ment = 0.f;
            for (int k = 0; k < 64; ++k) { const float ml = __shfl(mlv, k), bl = __shfl(blv, k); const float mn = fmaxf(bl + m, ml);
                if (lane == k) { dec = __expf(bl + m - mn); linj = ml - mn; ment = m; } m = mn; }
            DEC[lane] = dec; LINJ[cl] = linj; MENT[lane] = ment;
            if (half == 0) MST[(size_t)seq * 64 + cl] = ment; }
        __syncthreads();
#pragma unroll
        for (int i = 0; i < 8; ++i) { const int idx = tid + i * NTHR; WS[idx] = __expf(WS[idx] + LINJ[idx >> 6]); }
        const int krow = tid >> 3, kc = tid & 7;
        const int eh = wave >> 2, dt = wave & 3;
        f32x4 C[NT], Nacc = (f32x4){0.f, 0.f, 0.f, 0.f};
#pragma unroll
        for (int i = 0; i < NT; ++i) C[i] = (f32x4){0.f, 0.f, 0.f, 0.f};
        const bf16x8 ones = (bf16x8){0x3f80, 0x3f80, 0x3f80, 0x3f80, 0x3f80, 0x3f80, 0x3f80, 0x3f80};
        const size_t tokb = (size_t)b * SEQ;
        u32x4 kreg[2][2], vreg[2][2][2 / ES];
#define SS_LOAD(st_, kp_) do { _Pragma("unroll") for (int sb_ = 0; sb_ < 2; ++sb_) { const int kk_ = 2 * (kp_) + sb_; const int cn_ = dir ? 63 - kk_ : kk_; \
            kreg[st_][sb_] = *(const u32x4*)(P + (tokb + 64 * cn_ + krow) * MIN_N + 512 + hd * 64 + kc * 8); \
            _Pragma("unroll") for (int i_ = 0; i_ < 2 / ES; ++i_) { const int idx_ = tid + i_ * NTHR, vr_ = ES == 1 ? idx_ >> 4 : idx_ >> 3, vc_ = ES == 1 ? idx_ & 15 : idx_ & 7; \
                vreg[st_][sb_][i_] = *(const u32x4*)(P + (tokb + 64 * cn_ + vr_) * MIN_N + 1024 + hd * 128 + eoff + vc_ * 8); } } } while (0)
#define SS_PAIR(st, kp) do { const int buf = (kp) & 1; \
            _Pragma("unroll") for (int sb = 0; sb < 2; ++sb) { const int k = 2 * (kp) + sb, c = dir ? 63 - k : k; \
                *(LAS u32x4*)(lds + SS_KW + (buf * 2 + sb) * 8192 + ss_kw_off(krow, kc * 16)) = scale_bf16x8(kreg[st][sb], WS[c * 64 + krow]); \
                _Pragma("unroll") for (int i = 0; i < 2 / ES; ++i) { const int idx = tid + i * NTHR; \
                    *(LAS u32x4*)(lds + SS_V + (buf * 2 + sb) * VB + (ES == 1 ? ss_v_off(idx >> 4, (idx & 15) * 16) : ss_kw_off(idx >> 3, (idx & 7) * 16))) = vreg[st][sb][i]; } } \
            if ((kp) + 2 < 32) SS_LOAD(st, (kp) + 2); \
            asm volatile("s_waitcnt lgkmcnt(0)" ::: "memory"); __builtin_amdgcn_s_barrier(); asm volatile("" ::: "memory"); \
            _Pragma("unroll") for (int sb = 0; sb < 2; ++sb) { const int k = 2 * (kp) + sb, c = dir ? 63 - k : k; \
                _Pragma("unroll") for (int i = 0; i < NT; ++i) { u32x2 w; w.x = cvt_pk_bf16(C[i].x, C[i].y); w.y = cvt_pk_bf16(C[i].z, C[i].w); \
                    *(u32x2*)(STATE + ((size_t)seq * 64 + c) * 8192 + (size_t)(eoff + 16 * (eh + 2 * i) + fr) * 64 + 16 * dt + 4 * fq) = w; } \
                if (half == 0 && eh == 0 && fr == 0) *(f32x4*)(NST + ((size_t)seq * 64 + c) * 64 + 16 * dt + 4 * fq) = Nacc; \
                const float dec = DEC[k]; Nacc = Nacc * dec; \
                _Pragma("unroll") for (int i = 0; i < NT; ++i) C[i] = C[i] * dec; \
                _Pragma("unroll") for (int s2 = 0; s2 < 2; ++s2) { \
                    const int r0 = 32 * s2 + 8 * fq + ((lane & 15) >> 2), r1 = r0 + 4, cbk = 32 * dt + 8 * (lane & 3); \
                    const bf16x8 af = cat8(tr_read(lds + SS_KW + (buf * 2 + sb) * 8192 + ss_kw_off(r0, cbk)), tr_read(lds + SS_KW + (buf * 2 + sb) * 8192 + ss_kw_off(r1, cbk))); \
                    _Pragma("unroll") for (int i = 0; i < NT; ++i) { const int cbv = 32 * (eh + 2 * i) + 8 * (lane & 3); \
                        const bf16x8 bfv = cat8(tr_read(lds + SS_V + (buf * 2 + sb) * VB + (ES == 1 ? ss_v_off(r0, cbv) : ss_kw_off(r0, cbv))), tr_read(lds + SS_V + (buf * 2 + sb) * VB + (ES == 1 ? ss_v_off(r1, cbv) : ss_kw_off(r1, cbv)))); \
                        C[i] = __builtin_amdgcn_mfma_f32_16x16x32_bf16(af, bfv, C[i], 0, 0, 0); } \
                    if (eh == 0) Nacc = __builtin_amdgcn_mfma_f32_16x16x32_bf16(af, ones, Nacc, 0, 0, 0); } } } while (0)
        SS_LOAD(0, 0); SS_LOAD(1, 1);
        __syncthreads();
#pragma unroll 1
        for (int kp2 = 0; kp2 < 32; kp2 += 2) { SS_PAIR(0, kp2); SS_PAIR(1, kp2 + 1); }
#undef SS_PAIR
#undef SS_LOAD
    }
}
constexpr int SCAN_ES = 2, SCAN_WGS = 64 * SCAN_ES, SCAN_STRIDE = 256 / SCAN_WGS;
DI void mlstm_scan_phase(Frame& F, const Args& a) {
    if (F.G == 256) {
        if (F.vcu % SCAN_STRIDE == 0) { const int sw = F.vcu / SCAN_STRIDE; mlstm_scan_seq<SCAN_ES>(F, a.ws, sw / SCAN_ES, sw % SCAN_ES); }
        else expert_conv_items(F, a, XI_C_END, XI_TOTAL, ((F.vcu / SCAN_STRIDE) * (SCAN_STRIDE - 1) + F.vcu % SCAN_STRIDE - 1) * NWAVES + F.wave, (256 - SCAN_WGS) * NWAVES);
    } else {
        for (int sw = F.vcu; sw < SCAN_WGS; sw += F.G) mlstm_scan_seq<SCAN_ES>(F, a.ws, sw / SCAN_ES, sw % SCAN_ES);
        if (F.vcu == 0) expert_conv_items(F, a, XI_C_END, XI_TOTAL, F.wave, NWAVES);
    }
}
constexpr int S3_Q = 0, S3_KF = 8192, S3_KB = 16384, S3_V = 24576, S3_CF = 40960, S3_CB = 57344, S3_HS = 73728, S3_HS_LD = 132, S3_SM = 108544;
DI float incl_prefix_max(float v, int lane) {
#pragma unroll
    for (int o = 1; o < 64; o <<= 1) { const float t = __shfl_up(v, o); if (lane >= o) v = fmaxf(v, t); }
    return v;
}
DI float incl_suffix_max(float v, int lane) {
#pragma unroll
    for (int o = 1; o < 64; o <<= 1) { const float t = __shfl_down(v, o); if (lane + o < 64) v = fmaxf(v, t); }
    return v;
}
DI void mlstm_s3_phase(Frame& F, const Args& a) {
    unsigned char* ws = a.ws; LAS unsigned char* lds = F.lds;
    const bf16_t* P = (const bf16_t*)(ws + WS_PROJ); const float* MG = (const float*)(ws + WS_MG);
    const bf16_t* STATE = (const bf16_t*)(ws + WS_STATE); const float* NST = (const float*)(ws + WS_NST); const float* MST = (const float*)(ws + WS_MST);
    bf16_t* Y2 = (bf16_t*)(ws + WS_Y2); const float* outg = a.in[IN_MOG];
    const int tid = F.tid, lane = F.lane, wave = F.wave, r = lane & 31, h = lane >> 5;
    const int q4 = (lane & 15) >> 2, p4 = lane & 3, blk = (lane >> 4) & 1;
    LAS float* ALPHA = (LAS float*)(lds + S3_SM); LAS float* EA = ALPHA + 128; LAS float* EMT = ALPHA + 256; LAS unsigned short* NB16 = (LAS unsigned short*)(ALPHA + 384);
    LAS float* HS = (LAS float*)(lds + S3_HS);
    u32x4 rq, rk, rv[2], rcf[2], rcb[2], rog[2]; float pg[4], pn[2], pm_f = 0.f, pm_b = 0.f;
#define S3_LOAD(u_) do { const int c_ = (u_) & 63, bh_ = (u_) >> 6, b_ = bh_ >> 3, hd_ = bh_ & 7; const size_t tk_ = (size_t)b_ * SEQ + 64 * c_; \
        { const int row = tid >> 3, kc = tid & 7; rq = *(const u32x4*)(P + (tk_ + row) * MIN_N + hd_ * 64 + kc * 8); rk = *(const u32x4*)(P + (tk_ + row) * MIN_N + 512 + hd_ * 64 + kc * 8); } \
        _Pragma("unroll") for (int i = 0; i < 2; ++i) { const int idx = tid + i * NTHR, row = idx >> 4, c16 = idx & 15; \
            rv[i] = *(const u32x4*)(P + (tk_ + row) * MIN_N + 1024 + hd_ * 128 + c16 * 8); \
            rcf[i] = __builtin_nontemporal_load((const u32x4*)(STATE + ((size_t)(0 * 32 + bh_) * 64 + c_) * 8192) + idx); rcb[i] = __builtin_nontemporal_load((const u32x4*)(STATE + ((size_t)(1 * 32 + bh_) * 64 + c_) * 8192) + idx); } \
        { const bf16_t* ogp_ = P + (tk_ + (tid >> 3)) * MIN_N + 2048 + hd_ * 128 + (tid & 7) * 16; rog[0] = *(const u32x4*)ogp_; rog[1] = *(const u32x4*)(ogp_ + 8); } \
        pm_f = MST[(size_t)(0 * 32 + bh_) * 64 + c_]; pm_b = MST[(size_t)(1 * 32 + bh_) * 64 + c_]; \
        { const float* mg = MG + (tk_ + lane) * 32; pg[0] = mg[hd_]; pg[1] = mg[8 + hd_]; pg[2] = mg[16 + hd_]; pg[3] = mg[24 + hd_]; \
          pn[0] = NST[((size_t)(0 * 32 + bh_) * 64 + c_) * 64 + lane]; pn[1] = NST[((size_t)(1 * 32 + bh_) * 64 + c_) * 64 + lane]; } } while (0)
    if (F.vcu < 2048) S3_LOAD(F.vcu);
    for (int u = F.vcu; u < 2048; u += F.G) {
        const int c = u & 63, bh = u >> 6, b = bh >> 3, hd = bh & 7; const size_t tok0 = (size_t)b * SEQ + 64 * c;
        const float m_f = pm_f, m_b = pm_b;
        const float bf = incl_prefix(pg[1], lane), uf = pg[0] - bf, umf = wave_max(uf), cmf = incl_prefix_max(uf, lane);
        const float sb = incl_suffix(pg[3], lane), ub = pg[2] - sb, umb = wave_max(ub), cmb = incl_suffix_max(ub, lane);
        const float beta_f = __expf(uf - umf), beta_b = __expf(ub - umb);
        const float af_ = bf + m_f, mtf = fmaxf(af_, bf + cmf), ab_ = sb + m_b, mtb = fmaxf(ab_, sb + cmb);
        __syncthreads();
        if (wave == 0) { ALPHA[lane] = __expf(bf + umf - mtf); EA[lane] = __expf(af_ - mtf); EMT[lane] = __expf(-mtf);
            ALPHA[64 + lane] = __expf(sb + umb - mtb); EA[64 + lane] = __expf(ab_ - mtb); EMT[64 + lane] = __expf(-mtb);
            NB16[lane] = (unsigned short)f2bf(pn[0]); NB16[64 + lane] = (unsigned short)f2bf(pn[1]); }
        { const int row = tid >> 3, kc = tid & 7; const float wf = __shfl(beta_f, row & 63), wb = __shfl(beta_b, row & 63);
          *(LAS u32x4*)(lds + S3_Q + off128r(row, kc)) = rq;
          *(LAS u32x4*)(lds + S3_KF + off128r(row, kc)) = scale_bf16x8(rk, wf); *(LAS u32x4*)(lds + S3_KB + off128r(row, kc)) = scale_bf16x8(rk, wb); }
#pragma unroll
        for (int i = 0; i < 2; ++i) { const int idx = tid + i * NTHR, row = idx >> 4, c16 = idx & 15, erow = idx >> 3, ec = idx & 7;
            *(LAS u32x4*)(lds + S3_V + off256t(row, c16 * 16)) = rv[i];
            *(LAS u32x4*)(lds + S3_CF + off128r(erow, ec)) = rcf[i]; *(LAS u32x4*)(lds + S3_CB + off128r(erow, ec)) = rcb[i]; }
        const u32x4 og0 = rog[0], og1 = rog[1];
        if (u + F.G < 2048) S3_LOAD(u + F.G);
        __syncthreads();
        const int et = wave >> 1, tt = wave & 1, t = 32 * tt + r;
        bf16x8 qf[4];
#pragma unroll
        for (int s4 = 0; s4 < 4; ++s4) qf[s4] = *(const LAS bf16x8*)(lds + S3_Q + off128r(t, 2 * s4 + h));
        f32x16 pF, pB, pO;
#pragma unroll
        for (int i = 0; i < 16; ++i) { pF[i] = 0.f; pB[i] = 0.f; pO[i] = 0.f; }
        const int so = 1 - tt; const int koff = tt == 0 ? S3_KB : S3_KF;
#pragma unroll
        for (int s4 = 0; s4 < 4; ++s4) {
            const bf16x8 kF = *(const LAS bf16x8*)(lds + S3_KF + off128r(32 * tt + r, 2 * s4 + h)), kB = *(const LAS bf16x8*)(lds + S3_KB + off128r(32 * tt + r, 2 * s4 + h));
            const bf16x8 kO = *(const LAS bf16x8*)(lds + koff + off128r(32 * so + r, 2 * s4 + h));
            pF = __builtin_amdgcn_mfma_f32_32x32x16_bf16(kF, qf[s4], pF, 0, 0, 0);
            pB = __builtin_amdgcn_mfma_f32_32x32x16_bf16(kB, qf[s4], pB, 0, 0, 0);
            pO = __builtin_amdgcn_mfma_f32_32x32x16_bf16(kO, qf[s4], pO, 0, 0, 0);
        }
        float rsF = 0.f, rsB = 0.f, rsO = 0.f;
#pragma unroll
        for (int i = 0; i < 16; ++i) { const int sl_ = (i & 3) + 8 * (i >> 2) + 4 * h;
            pF[i] = sl_ <= r ? pF[i] : 0.f; pB[i] = sl_ >= r ? pB[i] : 0.f; rsF += pF[i]; rsB += pB[i]; rsO += pO[i]; }
        rsF += __shfl_xor(rsF, 32); rsB += __shfl_xor(rsB, 32); rsO += __shfl_xor(rsO, 32);
        if (tt == 0) rsB += rsO; else rsF += rsO;
        asm volatile("" ::: "memory");
        float qnf, qnb;
        {   f32x16 qn;
#pragma unroll
            for (int i = 0; i < 16; ++i) qn[i] = 0.f;
#pragma unroll
            for (int s4 = 0; s4 < 4; ++s4) { const bf16x8 nF = *(const LAS bf16x8*)(NB16 + 16 * s4 + 8 * h); qn = __builtin_amdgcn_mfma_f32_32x32x16_bf16(nF, qf[s4], qn, 0, 0, 0); }
            qnf = qn[0];
#pragma unroll
            for (int i = 0; i < 16; ++i) qn[i] = 0.f;
#pragma unroll
            for (int s4 = 0; s4 < 4; ++s4) { const bf16x8 nB = *(const LAS bf16x8*)(NB16 + 64 + 16 * s4 + 8 * h); qn = __builtin_amdgcn_mfma_f32_32x32x16_bf16(nB, qf[s4], qn, 0, 0, 0); }
            qnb = qn[0]; }
        const float alF = ALPHA[t], eaF = EA[t], emF = EMT[t], alB = ALPHA[64 + t], eaB = EA[64 + t], emB = EMT[64 + t];
        const float invF = 1.f / fmaxf(fabsf(eaF * qnf + alF * rsF), emF), invB = 1.f / fmaxf(fabsf(eaB * qnb + alB * rsB), emB);
        asm volatile("" ::: "memory");
        f32x16 hs;
        const int cbv = 64 * et + 32 * blk + 8 * p4;
        {   f32x16 it, in;
#pragma unroll
            for (int i = 0; i < 16; ++i) { it[i] = 0.f; in[i] = 0.f; }
#pragma unroll
            for (int s4 = 0; s4 < 4; ++s4) { const bf16x8 cF = *(const LAS bf16x8*)(lds + S3_CF + off128r(32 * et + r, 2 * s4 + h)); it = __builtin_amdgcn_mfma_f32_32x32x16_bf16(cF, qf[s4], it, 0, 0, 0); }
#pragma unroll
            for (int s2 = 0; s2 < 2; ++s2) { const int rd0 = 32 * tt + 16 * s2 + 4 * h + q4;
                const bf16x8 vD = cat8(tr_read(lds + S3_V + off256t(rd0, cbv)), tr_read(lds + S3_V + off256t(rd0 + 8, cbv)));
                in = __builtin_amdgcn_mfma_f32_32x32x16_bf16(vD, pack_step(pF, s2), in, 0, 0, 0);
                if (tt == 1) { const int ro0 = 16 * s2 + 4 * h + q4; const bf16x8 vO = cat8(tr_read(lds + S3_V + off256t(ro0, cbv)), tr_read(lds + S3_V + off256t(ro0 + 8, cbv)));
                    in = __builtin_amdgcn_mfma_f32_32x32x16_bf16(vO, pack_step(pO, s2), in, 0, 0, 0); } }
#pragma unroll
            for (int i = 0; i < 16; ++i) hs[i] = (eaF * it[i] + alF * in[i]) * invF;
        }
        asm volatile("" ::: "memory");
        {   f32x16 it, in;
#pragma unroll
            for (int i = 0; i < 16; ++i) { it[i] = 0.f; in[i] = 0.f; }
#pragma unroll
            for (int s4 = 0; s4 < 4; ++s4) { const bf16x8 cB = *(const LAS bf16x8*)(lds + S3_CB + off128r(32 * et + r, 2 * s4 + h)); it = __builtin_amdgcn_mfma_f32_32x32x16_bf16(cB, qf[s4], it, 0, 0, 0); }
#pragma unroll
            for (int s2 = 0; s2 < 2; ++s2) { const int rd0 = 32 * tt + 16 * s2 + 4 * h + q4;
                const bf16x8 vD = cat8(tr_read(lds + S3_V + off256t(rd0, cbv)), tr_read(lds + S3_V + off256t(rd0 + 8, cbv)));
                in = __builtin_amdgcn_mfma_f32_32x32x16_bf16(vD, pack_step(pB, s2), in, 0, 0, 0);
                if (tt == 0) { const int ro0 = 32 + 16 * s2 + 4 * h + q4; const bf16x8 vO = cat8(tr_read(lds + S3_V + off256t(ro0, cbv)), tr_read(lds + S3_V + off256t(ro0 + 8, cbv)));
                    in = __builtin_amdgcn_mfma_f32_32x32x16_bf16(vO, pack_step(pO, s2), in, 0, 0, 0); } }
#pragma unroll
            for (int i = 0; i < 16; ++i) hs[i] += (eaB * it[i] + alB * in[i]) * invB;
        }
#pragma unroll
        for (int i = 0; i < 16; ++i) HS[t * S3_HS_LD + 32 * et + (i & 3) + 8 * (i >> 2) + 4 * h] = hs[i];
        __syncthreads();
        { const int tr = tid >> 3, e0 = (tid & 7) * 16; float vv[16]; float ss = 0.f;
#pragma unroll
          for (int i = 0; i < 4; ++i) { const f32x4 x = *(const LAS f32x4*)(HS + tr * S3_HS_LD + e0 + 4 * i); vv[4 * i] = x[0]; vv[4 * i + 1] = x[1]; vv[4 * i + 2] = x[2]; vv[4 * i + 3] = x[3]; ss += (x[0] * x[0] + x[1] * x[1]) + (x[2] * x[2] + x[3] * x[3]); }
          ss += __shfl_xor(ss, 1); ss += __shfl_xor(ss, 2); ss += __shfl_xor(ss, 4);
          const float rinv = __builtin_amdgcn_rsqf(ss * (1.f / 128.f) + RMS_EPS);
          unsigned ow[8];
#pragma unroll
          for (int i = 0; i < 8; ++i) { const unsigned w = i < 4 ? og0[i] : og1[i - 4];
              const float o0 = __builtin_bit_cast(float, w << 16), o1 = __builtin_bit_cast(float, w & 0xffff0000u);
              const float g0 = outg[hd * 128 + e0 + 2 * i], g1 = outg[hd * 128 + e0 + 2 * i + 1];
              const float y0 = vv[2 * i] * rinv * g0 / (1.f + __expf(-o0)), y1 = vv[2 * i + 1] * rinv * g1 / (1.f + __expf(-o1));
              ow[i] = cvt_pk_bf16(y0, y1); }
          bf16_t* yp = Y2 + (tok0 + tr) * D + hd * 128 + e0;
          *(u32x4*)yp = (u32x4){ow[0], ow[1], ow[2], ow[3]}; *(u32x4*)(yp + 8) = (u32x4){ow[4], ow[5], ow[6], ow[7]}; }
    }
#undef S3_LOAD
}

__global__ void __launch_bounds__(NTHR, 2) fwd_kernel(Args args) {
    extern __shared__ __attribute__((aligned(16))) unsigned char lds_raw[];
    Frame F;
    F.lds = (LAS unsigned char*)lds_raw;
    F.MISC = (volatile LAS unsigned*)(F.lds + MISC_OFF);
    F.tid = threadIdx.x; F.lane = F.tid & 63; F.wave = __builtin_amdgcn_readfirstlane(F.tid >> 6);
    F.G = gridDim.x; { const int bx = blockIdx.x; F.vcu = (F.G % 8 == 0) ? (bx % 8) * (F.G / 8) + bx / 8 : bx; }
    F.ctl = (unsigned*)(args.ws + WS_CTL);
    if (F.tid < 64) F.MISC[F.tid] = 0u;
    __syncthreads();
    XcdBarrier bar = xcd_barrier_post(F.ctl + CW_BAR, F.MISC + 8);
    const int lo = args.ph_lo, hi = args.ph_hi;
    unsigned char* ws = args.ws;
#define IN(k) (lo <= (k) && (k) < hi)
#define SEAM(k) do { if (IN(k) && IN((k) + 1)) xcd_barrier(bar); } while (0)

    if (IN(0)) { p0_prologue(F, args); } SEAM(0);
    if (IN(1)) {
        pg8::DenseOrder8 S; S.init(M, NQKV, F.G, (int)blockIdx.x, (const bf16_t*)(ws + WS_WQKV), D);
        pg8::EpiQKV E{(bf16_t*)(ws + WS_Q), (bf16_t*)(ws + WS_K), (bf16_t*)(ws + WS_V), args.in[IN_AQG], args.in[IN_AKG]};
        pg8::gemm_phase<pg8::EpiQKV, pg8::DenseOrder8, false, true, true>(F.lds, nullptr, (const void*)(ws + WS_XN8), D, S, E);
        if ((int)blockIdx.x >= 128 && F.G == 256) expert_conv_items(F, args, XI_PRO_END, XI_A_END, ((int)blockIdx.x - 128) * NWAVES + F.wave, 128 * NWAVES);
        else if (F.G != 256 && (int)blockIdx.x == 0) expert_conv_items(F, args, XI_PRO_END, XI_A_END, F.wave, NWAVES);
    } SEAM(1);
    if (IN(2)) { attn_phase(F, args); } SEAM(2);
    if (IN(3)) {
        pg8::DenseOrder8 S; S.init(M, D, F.G, (int)blockIdx.x, (const bf16_t*)(ws + WS_WAO), D);
        if (F.G == 256) { pg8::EpiResRoute<false> E{args.in[IN_X], (bf16_t*)(ws + WS_X1), ws + WS_XN8, (float*)(ws + WS_PART), args.in[IN_FNG], args.in[IN_RW], 1.f / 256.f};
            pg8::gemm_phase<pg8::EpiResRoute<false>, pg8::DenseOrder8, false, false, true>(F.lds, nullptr, (const void*)(ws + WS_O), D, S, E); }
        else { pg8::EpiRes<false, true> E{args.in[IN_X], (void*)(ws + WS_X1), D, 1.f / 256.f};
            pg8::gemm_phase<pg8::EpiRes<false, true>, pg8::DenseOrder8, false, false, true>(F.lds, nullptr, (const void*)(ws + WS_O), D, S, E); }
    } SEAM(3);
    if (IN(4) && F.G != 256) { nr_phase<16, false>(F, (const bf16_t*)(ws + WS_X1), nullptr, nullptr, nullptr, args.in[IN_FNG], nullptr, (unsigned char*)(ws + WS_XN8), args.in[IN_RW], NE, 0, (float*)(ws + WS_PART), nullptr, nullptr); }
    if (F.G != 256) SEAM(4);
    if (IN(5)) { topk_phase(F, (const float*)(ws + WS_PART), (int*)(ws + WS_IDX), (float*)(ws + WS_GATE), (float*)(ws + WS_RSC), (int*)(ws + WS_SLOT));
        if ((int)blockIdx.x >= 64) expert_conv_items(F, args, XI_A_END, XI_B_END, ((int)blockIdx.x - 64) * NWAVES + F.wave, (F.G - 64) * NWAVES); } SEAM(5);
    if (IN(6)) { moe_up_phase(F, ws, 0); } SEAM(6);
    if (IN(7)) { moe_down_phase(F, ws, 0); } SEAM(7);
    if (IN(8)) { nrm_phase(F, (const bf16_t*)(ws + WS_X1), (const unsigned char*)(ws + WS_Y), (const int*)(ws + WS_SLOT), (bf16_t*)(ws + WS_X2), args.in[IN_MNG], (bf16_t*)(ws + WS_XN), ws + WS_XN8,
                           args.in[IN_MWIN], MIN_LD, MIN_N, (float*)(ws + WS_MG), args.in[IN_MBI], args.in[IN_MBF]); } SEAM(8);
    if (IN(9)) {
        { pg8::DenseOrder S; S.init(M, 1024, F.G, (int)blockIdx.x, (const bf16_t*)(ws + WS_WMIN), D);
          pg8::EpiBf16 E{(bf16_t*)(ws + WS_PROJ), MIN_N, nullptr, 1.f, 0};
          pg8::gemm_phase<pg8::EpiBf16, pg8::DenseOrder, false, true, false>(F.lds, nullptr, (const bf16_t*)(ws + WS_XN), D, S, E); }
        { pg8::DenseOrder8 S; S.init(M, 2048, F.G, (int)blockIdx.x, (const bf16_t*)(ws + WS_WMIN8), D);
          pg8::EpiBf16 E{(bf16_t*)(ws + WS_PROJ), MIN_N, nullptr, 0.0625f, 1024};
          pg8::gemm_phase<pg8::EpiBf16, pg8::DenseOrder8, false, true, true>(F.lds, nullptr, (const void*)(ws + WS_XN8), D, S, E); }
    } SEAM(9);
    if (IN(10)) { mlstm_scan_phase(F, args); } SEAM(10);
    if (IN(12)) { mlstm_s3_phase(F, args); } SEAM(12);
    if (IN(13)) {
        pg8::DenseOrder S; S.init(M, D, F.G, (int)blockIdx.x, (const bf16_t*)(ws + WS_WMO), D);
        if (F.G == 256) { pg8::EpiResRoute<true> E{(const void*)(ws + WS_X2), (bf16_t*)(ws + WS_X3), ws + WS_XN8, (float*)(ws + WS_PART), args.in[IN_FNG] + D, args.in[IN_RW] + D * NE, 1.f};
            pg8::gemm_phase<pg8::EpiResRoute<true>, pg8::DenseOrder, false, false, false>(F.lds, nullptr, (const bf16_t*)(ws + WS_Y2), D, S, E); }
        else { pg8::EpiRes<true, true> E{(const void*)(ws + WS_X2), (void*)(ws + WS_X3), D, 1.f};
            pg8::gemm_phase<pg8::EpiRes<true, true>, pg8::DenseOrder, false, false, false>(F.lds, nullptr, (const bf16_t*)(ws + WS_Y2), D, S, E); }
    } SEAM(13);
    if (IN(14) && F.G != 256) { nr_phase<16, false>(F, (const bf16_t*)(ws + WS_X3), nullptr, nullptr, nullptr, args.in[IN_FNG] + D, nullptr, (unsigned char*)(ws + WS_XN8), args.in[IN_RW] + D * NE, NE, 0, (float*)(ws + WS_PART), nullptr, nullptr); }
    if (F.G != 256) SEAM(14);
    if (IN(15)) { topk_phase(F, (const float*)(ws + WS_PART), (int*)(ws + WS_IDX), (float*)(ws + WS_GATE), (float*)(ws + WS_RSC), (int*)(ws + WS_SLOT));
        if ((int)blockIdx.x >= 64) expert_conv_items(F, args, XI_C_END - XI_NC, XI_C_END, ((int)blockIdx.x - 64) * NWAVES + F.wave, (F.G - 64) * NWAVES); } SEAM(15);
    if (IN(16)) { moe_up_phase(F, ws, 1); } SEAM(16);
    if (IN(17)) { moe_down_phase(F, ws, 1); } SEAM(17);
    if (IN(18)) { combine_phase(F, (const bf16_t*)(ws + WS_X3), (const unsigned char*)(ws + WS_Y), (const int*)(ws + WS_SLOT), args.out); }
#undef IN
#undef SEAM
}

extern "C" void kernel_launch(void* const* d_in, const int* in_sizes, int n_in, void* d_out, int out_size, void* d_ws, size_t ws_size, hipStream_t stream) {
    static int grid = 0;
    if (grid == 0) {
        if (n_in != 19 || out_size != M * D || ws_size < WS_END) { fprintf(stderr, "kernel_launch: unexpected problem (n_in %d, out %d, ws %zu)\n", n_in, out_size, ws_size); grid = -1; return; }
        int dev = 0, cus = 0, per_cu = 0;
        if (hipGetDevice(&dev) != hipSuccess || hipDeviceGetAttribute(&cus, hipDeviceAttributeMultiprocessorCount, dev) != hipSuccess) { grid = -1; return; }
        if (hipFuncSetAttribute((const void*)fwd_kernel, hipFuncAttributeMaxDynamicSharedMemorySize, LDS_BYTES) != hipSuccess) { fprintf(stderr, "kernel_launch: hipFuncSetAttribute failed\n"); grid = -1; return; }
        if (hipOccupancyMaxActiveBlocksPerMultiprocessor(&per_cu, (const void*)fwd_kernel, NTHR, LDS_BYTES) != hipSuccess || per_cu < 1) fprintf(stderr, "kernel_launch: occupancy query reports %d\n", per_cu);
        (void)hipGetLastError();
        grid = cus;
    }
    if (grid < 0) return;
    if (hipMemsetAsync((char*)d_ws + WS_CTL, 0, CTL_ZERO_BYTES, stream) != hipSuccess) return;
    Args a{};
    for (int i = 0; i < 19; ++i) a.in[i] = (const float*)d_in[i];
    a.out = (float*)d_out; a.ws = (unsigned char*)d_ws; a.ph_lo = 0; a.ph_hi = 19;
#ifndef EXP_LO
    hipLaunchKernelGGL(fwd_kernel, dim3(grid), dim3(NTHR), LDS_BYTES, stream, a);
#else
    a.ph_lo = 0; a.ph_hi = EXP_HI; hipLaunchKernelGGL(fwd_kernel, dim3(grid), dim3(NTHR), LDS_BYTES, stream, a);
    hipMemsetAsync((char*)d_ws + WS_CTL, 0, CTL_ZERO_BYTES, stream);
    a.ph_lo = EXP_LO; a.ph_hi = 19; hipLaunchKernelGGL(fwd_kernel, dim3(grid), dim3(NTHR), LDS_BYTES, stream, a);
#endif
}
```

```cpp
#include <hip/hip_runtime.h>
#include <cstdio>
#include <cstdint>

#define GAS __attribute__((address_space(1)))
#define LAS __attribute__((address_space(3)))
typedef unsigned short bf16_t;
typedef short bf16x8 __attribute__((ext_vector_type(8)));
typedef short s16x4 __attribute__((ext_vector_type(4)));
typedef float f32x4 __attribute__((ext_vector_type(4)));
typedef float f32x2 __attribute__((ext_vector_type(2)));
typedef float f32x16 __attribute__((ext_vector_type(16)));
typedef unsigned u32x4 __attribute__((ext_vector_type(4)));
typedef unsigned u32x2 __attribute__((ext_vector_type(2)));
typedef int i32x4 __attribute__((ext_vector_type(4)));
typedef int i32x8 __attribute__((ext_vector_type(8)));
#define LDS_WAIT() asm volatile("s_waitcnt lgkmcnt(0)" ::: "memory")
#define VM_WAIT() asm volatile("s_waitcnt vmcnt(0)" ::: "memory")
#define DI __device__ __forceinline__

constexpr int NB = 4, SEQ = 4096, D = 1024, M = NB * SEQ;
constexpr int NQKV = 1536;
constexpr int MIN_N = 3072, MIN_LD = 3104;
constexpr int NE = 16, CAP = 512, DE = 2048, MROWS = NB * NE * CAP;
constexpr float RMS_EPS = 1e-6f, LOG2E = 1.4426950408889634f, YS8 = 64.f;
constexpr int NWAVES = 8, NTHR = 512;

constexpr size_t MiB = 1u << 20;
constexpr size_t WS_CTL = 0, CTL_ZERO_BYTES = 1 * MiB;
constexpr size_t WS_WQKV = 2 * MiB, WS_WAO = 6 * MiB, WS_WMIN = 8 * MiB, WS_WMIN8 = 11 * MiB, WS_WMO = 14 * MiB;
constexpr size_t WS_W13 = 16 * MiB, W13_LAYER = 64 * MiB;
constexpr size_t WS_W2 = 272 * MiB, W2_LAYER = 32 * MiB;
constexpr size_t WS_XN = 400 * MiB, WS_X1 = 432 * MiB, WS_X2 = 496 * MiB, WS_X3 = 464 * MiB;
constexpr size_t WS_XN8 = 904 * MiB;
constexpr size_t WS_AFF = 560 * MiB, WS_IDX = 561 * MiB, WS_GATE = 562 * MiB, WS_SLOT = 563 * MiB, WS_MG = 564 * MiB;
constexpr size_t WS_ACT = 568 * MiB;
constexpr size_t WS_Q = WS_ACT, WS_K = WS_ACT + 32 * MiB, WS_V = WS_ACT + 40 * MiB, WS_O = WS_ACT + 48 * MiB;
constexpr size_t WS_H = WS_ACT, WS_Y = WS_ACT + 128 * MiB;
constexpr size_t WS_PVO = WS_ACT + 96 * MiB;
constexpr size_t WS_PROJ = WS_ACT, WS_CLOC = WS_ACT + 96 * MiB, WS_STATE = WS_ACT + 232 * MiB, WS_Y2 = WS_ACT + 300 * MiB;
constexpr size_t WS_NLOC = WS_ACT + 332 * MiB, WS_MLB = WS_ACT + 333 * MiB, WS_NST = WS_ACT + 334 * MiB, WS_MST = WS_ACT + 335 * MiB;
constexpr size_t WS_PART = 920 * MiB;
constexpr size_t WS_RSC = WS_AFF;
constexpr size_t WS_END = 928 * MiB;
constexpr int CW_BAR = 4096;

constexpr int RING_BYTES = 131072;
constexpr int AUX_OFF = RING_BYTES, AUX_BYTES = 24576;
constexpr int MISC_OFF = AUX_OFF + AUX_BYTES;
constexpr int LDS_BYTES = MISC_OFF + 256;

DI unsigned f2bf(float f) { unsigned u = __builtin_bit_cast(unsigned, f); return (u + 0x7fffu + ((u >> 16) & 1u)) >> 16; }
DI unsigned pk2(float lo, float hi) { return f2bf(lo) | (f2bf(hi) << 16); }
DI unsigned cvt_pk_bf16(float lo, float hi) { unsigned r; asm volatile("v_cvt_pk_bf16_f32 %0, %1, %2" : "=v"(r) : "v"(lo), "v"(hi)); return r; }
DI unsigned pk4_fp8(float a, float b, float c, float d) { unsigned w = 0u; w = __builtin_amdgcn_cvt_pk_fp8_f32(a, b, w, false); w = __builtin_amdgcn_cvt_pk_fp8_f32(c, d, w, true); return w; }
DI void fp8x16_to_bf16(u32x4 v, u32x4& lo8, u32x4& hi8) {
    unsigned o[8];
#pragma unroll
    for (int i = 0; i < 4; ++i) { const f32x2 a = __builtin_amdgcn_cvt_pk_f32_fp8(v[i], false), b = __builtin_amdgcn_cvt_pk_f32_fp8(v[i], true); o[2 * i] = cvt_pk_bf16(a.x, a.y); o[2 * i + 1] = cvt_pk_bf16(b.x, b.y); }
    lo8 = (u32x4){o[0], o[1], o[2], o[3]}; hi8 = (u32x4){o[4], o[5], o[6], o[7]};
}
DI float bf2f(unsigned short b) { return __builtin_bit_cast(float, ((unsigned)b) << 16); }
DI float wave_sum(float v) {
#pragma unroll
    for (int o = 1; o < 64; o <<= 1) v += __shfl_xor(v, o);
    return v;
}

#define XB_TMO      128
#define XB_XCNT(j)  (256  + 64 * (j))
#define XB_XSUB(j)  (1280 + 64 * (j))
#define XB_XGEN(j)  (2304 + 64 * (j))
#define XB_TOP      3328
#define XB_TOPGEN   3392
#define XCD_BAR_WORDS 3456
#define XB_SPIN_CAP (1u << 18)
DI unsigned xb_ld(unsigned* p)              { return __hip_atomic_load(p, __ATOMIC_RELAXED, __HIP_MEMORY_SCOPE_AGENT); }
DI unsigned xb_add(unsigned* p, unsigned v) { return __hip_atomic_fetch_add(p, v, __ATOMIC_RELAXED, __HIP_MEMORY_SCOPE_AGENT); }
DI unsigned xb_xcc_id() { return (unsigned)__builtin_amdgcn_s_getreg((3 << 11) | 20) & 0xFu; }
#define XB_SPIN(cond, bar) do { unsigned _sp = 0; while (cond) { __builtin_amdgcn_s_sleep(1); \
    if ((++_sp & 255u) == 0u) { if (xb_ld(&(bar)[XB_TMO])) break; if (_sp > XB_SPIN_CAP) { atomicAdd(&(bar)[XB_TMO], 1u); break; } } } } while (0)
struct XcdBarrier { unsigned* bar; unsigned x; volatile LAS unsigned* st; };
DI XcdBarrier xcd_barrier_post(unsigned* bar, volatile LAS unsigned* st) {
    XcdBarrier b; b.bar = bar; b.x = xb_xcc_id(); b.st = st;
    if (threadIdx.x == 0) (void)xb_add(&bar[XB_XCNT(b.x)], 1u);
    return b;
}
DI void xcd_barrier_complete(unsigned* bar, unsigned x, unsigned& nloc, unsigned& nx) {
    const unsigned G = gridDim.x * gridDim.y * gridDim.z;
    unsigned sum, cnt, mine, sp = 0u;
    for (;;) {
        sum = 0u; cnt = 0u; mine = 0u;
#pragma unroll
        for (unsigned j = 0; j < 16; ++j) { const unsigned c = xb_ld(&bar[XB_XCNT(j)]); sum += c; cnt += (c > 0u) ? 1u : 0u; mine = (j == x) ? c : mine; }
        if (sum == G) break;
        __builtin_amdgcn_s_sleep(1);
        if ((++sp & 255u) == 0u) { if (xb_ld(&bar[XB_TMO])) break; if (sp > XB_SPIN_CAP) { atomicAdd(&bar[XB_TMO], 1u); break; } }
    }
    nloc = mine > 0u ? mine : 1u; nx = cnt > 0u ? cnt : 1u;
}
DI void xcd_barrier(const XcdBarrier& b) {
    asm volatile("s_waitcnt vmcnt(0)" ::: "memory");
    __syncthreads();
    if (threadIdx.x == 0) {
        unsigned* bar = b.bar;
        __builtin_amdgcn_s_waitcnt(0);
        unsigned nloc = b.st[0], nx = b.st[1];
        if (nloc == 0u) { xcd_barrier_complete(bar, b.x, nloc, nx); b.st[0] = nloc; b.st[1] = nx; }
        const unsigned old = xb_add(&bar[XB_XSUB(b.x)], 1u);
        const unsigned gen = old / nloc;
        if (old + 1u == (gen + 1u) * nloc) {
            __builtin_amdgcn_fence(__ATOMIC_RELEASE, "agent");
            asm volatile("s_waitcnt vmcnt(0)" ::: "memory");
            const unsigned og = xb_add(&bar[XB_TOP], 1u);
            const unsigned tg = og / nx;
            if (og + 1u == (tg + 1u) * nx) xb_add(&bar[XB_TOPGEN], 1u);
            else XB_SPIN(xb_ld(&bar[XB_TOPGEN]) == tg, bar);
            __builtin_amdgcn_fence(__ATOMIC_ACQUIRE, "agent");
            xb_add(&bar[XB_XGEN(b.x)], 1u);
            asm volatile("s_waitcnt vmcnt(0)" ::: "memory");
        } else {
            XB_SPIN(xb_ld(&bar[XB_XGEN(b.x)]) == gen, bar);
            __builtin_amdgcn_fence(__ATOMIC_ACQUIRE, "agent");
            asm volatile("s_waitcnt vmcnt(0)" ::: "memory");
        }
    }
    __syncthreads();
}

namespace pg8 {
constexpr int BM = 256, BK = 64, HALF = 128, HTB = HALF * BK * 2, STAGE_BYTES = 8 * HTB;
DI int lds_byte(int r, int c) { const int st = (r >> 4) * 2 + (c >> 5), rr = r & 15, cc = c & 31, ob = rr * 64 + cc * 2; return st * 1024 + (ob ^ (((ob >> 9) & 1) << 5)); }
DI void stage_rc(int b, int& R, int& C) { const int st = b / 1024, sb = b % 1024, swz = sb ^ (((sb >> 9) & 1) << 5); R = (st >> 1) * 16 + swz / 64; C = (st & 1) * 32 + (swz % 64) / 2; }
DI int perm32(int rho) { const int n = rho >> 4, i = rho & 15; return 8 * (i >> 2) + 4 * n + (i & 3); }
DI int perm32inv(int c) { return 16 * ((c >> 2) & 1) + 4 * (c >> 3) + (c & 3); }
struct Unit { int pm, pn, ui; };

template <class Epi, class Sched, bool GATHER, bool ALIGN_EPI, bool F8>
DI void gemm_phase(LAS unsigned char* lds, const LAS int* idx_lds, const void* A, const int K, const Sched& S, const Epi& E) {
    const int tid = threadIdx.x, wid = __builtin_amdgcn_readfirstlane(tid >> 6), lane = tid & 63, wr = wid >> 2, wc = wid & 3, fr = lane & 15, fq = lane >> 4;
    const int PB = F8 ? K : 2 * K, nt = PB / 128;
    unsigned voffA[2][2], voffB[2];
    int RA[2], CA[2];
#pragma unroll
    for (int i = 0; i < 2; ++i) { int R, C; stage_rc(tid * 16 + i * 8192, R, C); RA[i] = R; CA[i] = C; voffB[i] = (unsigned)(R * PB + C * 2); }
    const size_t kstep = (size_t)(BK * 2);
    const size_t hstep = (size_t)HALF * PB;
    const unsigned ldsw = (unsigned)wid * 1024u;
    const int aoff = lds_byte(wr * 64 + fr, fq * 8), boff = lds_byte(wc * 32 + fr, fq * 8);
#define PG8_SA(b, h) (((b) * 2 + (h)) * HTB)
#define PG8_SB(b, h) ((4 + (b) * 2 + (h)) * HTB)
#define PG8_STAGE(bufoff, gbase, voff) do { _Pragma("unroll") for (int _i = 0; _i < 2; ++_i) \
        __builtin_amdgcn_global_load_lds((const unsigned*)((const char*)(gbase) + (voff)[_i]), (LAS unsigned*)(lds + (bufoff) + ldsw + _i * 8192), 16, 0, 0); } while (0)
#define PG8_LDA(dst, b, h) do { _Pragma("unroll") for (int m = 0; m < 4; ++m) _Pragma("unroll") for (int k = 0; k < 2; ++k) dst[m][k] = *(const LAS bf16x8*)(lds + PG8_SA(b, h) + aoff + m * 2048 + k * 1024); } while (0)
#define PG8_LDB(dst, b, h) do { _Pragma("unroll") for (int n = 0; n < 2; ++n) _Pragma("unroll") for (int k = 0; k < 2; ++k) dst[n][k] = *(const LAS bf16x8*)(lds + PG8_SB(b, h) + boff + n * 2048 + k * 1024); } while (0)
#define PG8_MMA(ai, bj, At, Bt) do { __builtin_amdgcn_s_setprio(1); _Pragma("unroll") for (int m = 0; m < 4; ++m) _Pragma("unroll") for (int n = 0; n < 2; ++n) { \
        if constexpr (F8) acc[ai][bj][m][n] = __builtin_amdgcn_mfma_scale_f32_16x16x128_f8f6f4( \
            __builtin_shufflevector(__builtin_bit_cast(i32x4, Bt[n][0]), __builtin_bit_cast(i32x4, Bt[n][1]), 0, 1, 2, 3, 4, 5, 6, 7), \
            __builtin_shufflevector(__builtin_bit_cast(i32x4, At[m][0]), __builtin_bit_cast(i32x4, At[m][1]), 0, 1, 2, 3, 4, 5, 6, 7), acc[ai][bj][m][n], 0, 0, 0, 0x7f7f7f7f, 0, 0x7f7f7f7f); \
        else { _Pragma("unroll") for (int k = 0; k < 2; ++k) acc[ai][bj][m][n] = __builtin_amdgcn_mfma_f32_16x16x32_bf16(Bt[n][k], At[m][k], acc[ai][bj][m][n], 0, 0, 0); } } \
        __builtin_amdgcn_s_setprio(0); } while (0)
#define PG8_WAIT_V(n) asm volatile("s_waitcnt vmcnt(" #n ")" ::: "memory")
#define PG8_WAIT_L(n) asm volatile("s_waitcnt lgkmcnt(" #n ")" ::: "memory")
#define PG8_BAR __builtin_amdgcn_s_barrier()
#define PG8_SCHED __builtin_amdgcn_sched_barrier(0)
#define PG8_SETA(ui_, u_) do { _Pragma("unroll") for (int _h = 0; _h < 2; ++_h) _Pragma("unroll") for (int _i = 0; _i < 2; ++_i) { \
        const int _row = GATHER ? idx_lds[(ui_) * 256 + _h * 128 + RA[_i]] : (u_).pm * 256 + _h * 128 + RA[_i]; voffA[_h][_i] = (unsigned)(_row * PB + CA[_i] * 2); } } while (0)
    Unit cur, nxt; int ui = 0;
    if (!S.next(0, cur)) return;
    f32x4 acc[2][2][4][2];
#pragma unroll
    for (int a = 0; a < 2; ++a)
#pragma unroll
        for (int b = 0; b < 2; ++b)
#pragma unroll
            for (int m = 0; m < 4; ++m)
#pragma unroll
                for (int n = 0; n < 2; ++n) acc[a][b][m][n] = (f32x4){0.f, 0.f, 0.f, 0.f};
    bf16x8 At[4][2], B0[2][2], B1[2][2];
    const char* const Ab = (const char*)A;
    const char* cB = S.bptr(cur);
    PG8_SETA(0, cur);
    PG8_STAGE(PG8_SB(0, 0), cB, voffB); PG8_STAGE(PG8_SB(0, 1), cB + hstep, voffB); PG8_STAGE(PG8_SA(0, 0), Ab, voffA[0]); PG8_STAGE(PG8_SA(0, 1), Ab, voffA[1]);
    if (wr == 1) PG8_BAR;
    PG8_WAIT_V(2); PG8_BAR;
    PG8_STAGE(PG8_SB(1, 0), cB + kstep, voffB); PG8_STAGE(PG8_SA(1, 0), Ab + kstep, voffA[0]); PG8_STAGE(PG8_SB(1, 1), cB + hstep + kstep, voffB);
    PG8_WAIT_V(6); PG8_BAR;
    for (;;) {
        const bool has_next = S.next(ui + 1, nxt);
        const char* nB = has_next ? S.bptr(nxt) : cB;
        for (int t = 0; t < nt; t += 2) {
            const bool last = (t == nt - 2);
            const char* a1 = Ab + (size_t)(t + 1) * kstep;
            const char* a2 = last ? Ab : Ab + (size_t)(t + 2) * kstep; const char* b2 = last ? nB : cB + (size_t)(t + 2) * kstep;
            const char* a3 = a2 + kstep; const char* b3 = b2 + kstep;
            PG8_LDB(B0, 0, 0); PG8_LDB(B1, 0, 1); PG8_SCHED; PG8_LDA(At, 0, 0); PG8_STAGE(PG8_SA(1, 1), a1, voffA[1]);
            if (last && has_next) PG8_SETA(ui + 1, nxt);
            PG8_WAIT_V(8); PG8_WAIT_L(0); PG8_BAR; PG8_MMA(0, 0, At, B0); PG8_MMA(0, 1, At, B1); PG8_BAR; PG8_SCHED;
            PG8_LDA(At, 0, 1); PG8_STAGE(PG8_SB(0, 0), b2, voffB); PG8_STAGE(PG8_SB(0, 1), b2 + hstep, voffB); PG8_STAGE(PG8_SA(0, 0), a2, voffA[0]);
            PG8_WAIT_V(8); PG8_WAIT_L(0); PG8_BAR; PG8_MMA(1, 0, At, B0); PG8_MMA(1, 1, At, B1); PG8_BAR; PG8_SCHED;
            PG8_LDB(B0, 1, 0); PG8_LDB(B1, 1, 1); PG8_SCHED; PG8_LDA(At, 1, 0); PG8_STAGE(PG8_SA(0, 1), a2, voffA[1]);
            PG8_WAIT_V(8); PG8_WAIT_L(0); PG8_BAR; PG8_MMA(0, 0, At, B0); PG8_MMA(0, 1, At, B1); PG8_BAR; PG8_SCHED;
            PG8_LDA(At, 1, 1); PG8_STAGE(PG8_SB(1, 0), b3, voffB); PG8_STAGE(PG8_SB(1, 1), b3 + hstep, voffB); PG8_STAGE(PG8_SA(1, 0), a3, voffA[0]);
            PG8_WAIT_V(8); PG8_WAIT_L(0); PG8_BAR; PG8_MMA(1, 0, At, B0); PG8_MMA(1, 1, At, B1); PG8_BAR; PG8_SCHED;
        }
        if constexpr (ALIGN_EPI) { if (wr == 0) PG8_BAR; }
        cur.ui = ui;
        if constexpr (!Epi::AFTER_DRAIN) E(acc, cur, wr, wc, fr, fq);
        if (!has_next) break;
#pragma unroll
        for (int a = 0; a < 2; ++a)
#pragma unroll
            for (int b = 0; b < 2; ++b)
#pragma unroll
                for (int m = 0; m < 4; ++m)
#pragma unroll
                    for (int n = 0; n < 2; ++n) acc[a][b][m][n] = (f32x4){0.f, 0.f, 0.f, 0.f};
        cur = nxt; cB = nB; ++ui;
        if constexpr (ALIGN_EPI) { if (wr == 1) PG8_BAR; }
    }
    PG8_WAIT_V(0);
    if constexpr (!ALIGN_EPI) { if (wr == 0) PG8_BAR; }
    PG8_BAR;
    if constexpr (Epi::AFTER_DRAIN) E.fused(acc, cur, wr, wc, fr, fq, lds);
#undef PG8_SA
#undef PG8_SB
#undef PG8_STAGE
#undef PG8_LDA
#undef PG8_LDB
#undef PG8_MMA
#undef PG8_WAIT_V
#undef PG8_WAIT_L
#undef PG8_BAR
#undef PG8_SCHED
#undef PG8_SETA
}

struct DenseOrder {
    int nM, nN, nwg, G, c; const bf16_t* Bt; int K;
    DI void init(int M_, int N_, int G_, int c_, const bf16_t* Bt_, int K_) { nM = M_ / BM; nN = N_ / BM; nwg = nM * nN; G = G_; c = c_; Bt = Bt_; K = K_; }
    DI bool next(int i, Unit& u) const {
        const long L = (long)i * G + c; if (L >= nwg) return false;
        int wgid = (int)L; { const int q = nwg / 8, r = nwg % 8, xcd = wgid % 8, off = wgid / 8; wgid = (xcd < r ? xcd * (q + 1) : r * (q + 1) + (xcd - r) * q) + off; }
        const int nig = 8 * nN, gid = wgid / nig, fm = gid * 8, gsz = (nM - fm) < 8 ? (nM - fm) : 8;
        u.pm = fm + ((wgid % nig) % gsz); u.pn = (wgid % nig) / gsz; return true;
    }
    DI const char* bptr(const Unit& u) const { return (const char*)(Bt + (size_t)u.pn * BM * K); }
};

struct DenseOrder8 : DenseOrder { DI const char* bptr(const Unit& u) const { return (const char*)Bt + (size_t)u.pn * BM * K; } };

struct EpiQKV {
    static constexpr bool AFTER_DRAIN = false;
    bf16_t *Q, *Kb, *Vb; const float *qg, *kg;
    DI void operator()(const f32x4 (&acc)[2][2][4][2], const Unit& u, int wr, int wc, int fr, int fq) const {
        const int pn = u.pn; bf16_t* base; int ld; const float* g; float sc;
        if (pn < 4) { base = Q + (pn * 4 + wc) * 64; ld = 1024; g = qg; sc = 0.125f * LOG2E; }
        else if (pn == 4) { base = Kb + wc * 64; ld = 256; g = kg; sc = 1.f; }
        else { base = Vb + wc * 64; ld = 256; g = kg; sc = 0.f; }
        f32x4 gv[2][2];
#pragma unroll
        for (int bj = 0; bj < 2; ++bj)
#pragma unroll
            for (int n = 0; n < 2; ++n) { gv[bj][n] = *(const f32x4*)(g + 32 * bj + 8 * fq + 4 * n) * sc; if (pn == 5) gv[bj][n] = (f32x4){1.f, 1.f, 1.f, 1.f}; }
#pragma unroll
        for (int ai = 0; ai < 2; ++ai)
#pragma unroll
            for (int m = 0; m < 4; ++m) {
                const int row = u.pm * BM + ai * HALF + wr * 64 + m * 16 + fr;
                float ss = 0.f;
#pragma unroll
                for (int bj = 0; bj < 2; ++bj)
#pragma unroll
                    for (int n = 0; n < 2; ++n) { const f32x4 x = acc[ai][bj][m][n]; ss += (x[0] * x[0] + x[1] * x[1]) + (x[2] * x[2] + x[3] * x[3]); }
                ss += __shfl_xor(ss, 16); ss += __shfl_xor(ss, 32);
                const float rinv = (pn == 5) ? 0.0625f : __builtin_amdgcn_rsqf(ss * (1.f / 64.f) + RMS_EPS);
#pragma unroll
                for (int bj = 0; bj < 2; ++bj) {
                    const f32x4 v0 = acc[ai][bj][m][0] * rinv * gv[bj][0], v1 = acc[ai][bj][m][1] * rinv * gv[bj][1];
                    u32x4 w; w.x = cvt_pk_bf16(v0[0], v0[1]); w.y = cvt_pk_bf16(v0[2], v0[3]); w.z = cvt_pk_bf16(v1[0], v1[1]); w.w = cvt_pk_bf16(v1[2], v1[3]);
                    *(u32x4*)(base + (size_t)row * ld + 32 * bj + 8 * fq) = w; }
            }
    }
};
template <bool RB, bool OB> struct EpiRes {
    static constexpr bool AFTER_DRAIN = false;
    const void* resid; void* out; int ldc; float cscale;
    DI void operator()(const f32x4 (&acc)[2][2][4][2], const Unit& u, int wr, int wc, int fr, int fq) const {
        const int row0 = u.pm * BM + wr * 64 + fr, col0 = u.pn * BM + wc * 32 + 4 * fq;
#pragma unroll
        for (int ai = 0; ai < 2; ++ai)
#pragma unroll
          for (int mp = 0; mp < 4; mp += 2) {
            f32x4 rr[2][2][2];
#pragma unroll
            for (int m = 0; m < 2; ++m) { const size_t off = (size_t)(row0 + ai * HALF + (mp + m) * 16) * ldc + col0;
#pragma unroll
                for (int bj = 0; bj < 2; ++bj)
#pragma unroll
                    for (int n = 0; n < 2; ++n) {
                        if constexpr (RB) { const u32x2 w = *(const u32x2*)((const bf16_t*)resid + off + bj * HALF + n * 16);
                            rr[m][bj][n] = (f32x4){__builtin_bit_cast(float, w.x << 16), __builtin_bit_cast(float, w.x & 0xffff0000u), __builtin_bit_cast(float, w.y << 16), __builtin_bit_cast(float, w.y & 0xffff0000u)}; }
                        else rr[m][bj][n] = *(const f32x4*)((const float*)resid + off + bj * HALF + n * 16); } }
#pragma unroll
            for (int m = 0; m < 2; ++m) { const size_t off = (size_t)(row0 + ai * HALF + (mp + m) * 16) * ldc + col0;
#pragma unroll
                for (int bj = 0; bj < 2; ++bj)
#pragma unroll
                    for (int n = 0; n < 2; ++n) { const f32x4 o = rr[m][bj][n] + acc[ai][bj][mp + m][n] * cscale;
                        if constexpr (OB) { u32x2 w; w.x = cvt_pk_bf16(o[0], o[1]); w.y = cvt_pk_bf16(o[2], o[3]); *(u32x2*)((bf16_t*)out + off + bj * HALF + n * 16) = w; }
                        else *(f32x4*)((float*)out + off + bj * HALF + n * 16) = o; } }
            asm volatile("" ::: "memory"); }
    }
};
template <bool RB> struct EpiResRoute {
    static constexpr bool AFTER_DRAIN = true;
    const void* resid; bf16_t* X1; unsigned char* XG8; float* part; const float* g; const float* Wr; float cscale;
    DI void operator()(const f32x4 (&)[2][2][4][2], const Unit&, int, int, int, int) const {}
    DI void fused(f32x4 (&acc)[2][2][4][2], const Unit& u, int wr, int wc, int fr, int fq, LAS unsigned char* lds) const {
        const int tid = threadIdx.x;
        LAS unsigned short* WH = (LAS unsigned short*)lds;
        LAS unsigned short* WL = WH + 16 * 256;
        LAS float* RED = (LAS float*)(lds + 16384);
#pragma unroll
        for (int i = 0; i < 2; ++i) { const int idx = tid + i * 512, c = idx >> 2, e4 = idx & 3; const int col = u.pn * BM + c;
            const f32x4 w = *(const f32x4*)(Wr + (size_t)col * NE + 4 * e4) * g[col];
#pragma unroll
            for (int q = 0; q < 4; ++q) { const unsigned hb = f2bf(w[q]); const float lo = w[q] - __builtin_bit_cast(float, hb << 16);
                WH[(4 * e4 + q) * 256 + c] = (unsigned short)hb; WL[(4 * e4 + q) * 256 + c] = (unsigned short)f2bf(lo); } }
        const int row0 = u.pm * BM + wr * 64 + fr, col0 = u.pn * BM + wc * 32 + 4 * fq;
        f32x4 gc[2][2];
#pragma unroll
        for (int bj = 0; bj < 2; ++bj)
#pragma unroll
            for (int n = 0; n < 2; ++n) gc[bj][n] = *(const f32x4*)(g + col0 + bj * HALF + n * 16);
#pragma unroll
        for (int ai = 0; ai < 2; ++ai)
#pragma unroll
          for (int mp = 0; mp < 4; mp += 2) {
            f32x4 rr[2][2][2];
#pragma unroll
            for (int m = 0; m < 2; ++m) { const size_t off = (size_t)(row0 + ai * HALF + (mp + m) * 16) * D + col0;
#pragma unroll
                for (int bj = 0; bj < 2; ++bj)
#pragma unroll
                    for (int n = 0; n < 2; ++n) {
                        if constexpr (RB) { const u32x2 w = *(const u32x2*)((const bf16_t*)resid + off + bj * HALF + n * 16);
                            rr[m][bj][n] = (f32x4){__builtin_bit_cast(float, w.x << 16), __builtin_bit_cast(float, w.x & 0xffff0000u), __builtin_bit_cast(float, w.y << 16), __builtin_bit_cast(float, w.y & 0xffff0000u)}; }
                        else rr[m][bj][n] = *(const f32x4*)((const float*)resid + off + bj * HALF + n * 16); } }
#pragma unroll
            for (int m = 0; m < 2; ++m) { const size_t off = (size_t)(row0 + ai * HALF + (mp + m) * 16) * D + col0;
#pragma unroll
                for (int bj = 0; bj < 2; ++bj)
#pragma unroll
                    for (int n = 0; n < 2; ++n) { const f32x4 o = rr[m][bj][n] + acc[ai][bj][mp + m][n] * cscale; acc[ai][bj][mp + m][n] = o;
                        u32x2 w; w.x = cvt_pk_bf16(o[0], o[1]); w.y = cvt_pk_bf16(o[2], o[3]); *(u32x2*)(X1 + off + bj * HALF + n * 16) = w;
                        const f32x4 og = o * gc[bj][n]; *(unsigned*)(XG8 + off + bj * HALF + n * 16) = pk4_fp8(og[0], og[1], og[2], og[3]); } }
            asm volatile("" ::: "memory"); }
        __syncthreads();
#pragma unroll
        for (int ai = 0; ai < 2; ++ai)
#pragma unroll
            for (int m = 0; m < 4; ++m) { float ssl = 0.f;
#pragma unroll
                for (int bj = 0; bj < 2; ++bj)
#pragma unroll
                    for (int n = 0; n < 2; ++n) { const f32x4 x = acc[ai][bj][m][n]; ssl += (x[0] * x[0] + x[1] * x[1]) + (x[2] * x[2] + x[3] * x[3]); }
                ssl += __shfl_xor(ssl, 16); ssl += __shfl_xor(ssl, 32);
                if (fq == 0) RED[((ai * HALF + wr * 64 + m * 16 + fr) * 4 + wc) * 17 + 16] = ssl; }
        bf16x8 bh[2], bl[2];
#pragma unroll
        for (int bj = 0; bj < 2; ++bj) { const int cb = bj * HALF + wc * 32 + 4 * fq;
            const u32x2 h0 = *(const LAS u32x2*)(WH + fr * 256 + cb), h1 = *(const LAS u32x2*)(WH + fr * 256 + cb + 16), l0 = *(const LAS u32x2*)(WL + fr * 256 + cb), l1 = *(const LAS u32x2*)(WL + fr * 256 + cb + 16);
            bh[bj] = __builtin_bit_cast(bf16x8, (u32x4){h0.x, h0.y, h1.x, h1.y}); bl[bj] = __builtin_bit_cast(bf16x8, (u32x4){l0.x, l0.y, l1.x, l1.y}); }
#pragma unroll
        for (int ai = 0; ai < 2; ++ai)
#pragma unroll
            for (int m = 0; m < 4; ++m) { f32x4 lg = (f32x4){0.f, 0.f, 0.f, 0.f};
#pragma unroll
                for (int bj = 0; bj < 2; ++bj) { const f32x4 x0 = acc[ai][bj][m][0], x1v = acc[ai][bj][m][1];
                    u32x4 hi, lo; float r[8] = {x0[0], x0[1], x0[2], x0[3], x1v[0], x1v[1], x1v[2], x1v[3]};
#pragma unroll
                    for (int q = 0; q < 4; ++q) { const unsigned h2 = cvt_pk_bf16(r[2 * q], r[2 * q + 1]); hi[q] = h2;
                        lo[q] = cvt_pk_bf16(r[2 * q] - __builtin_bit_cast(float, h2 << 16), r[2 * q + 1] - __builtin_bit_cast(float, h2 & 0xffff0000u)); }
                    const bf16x8 ah = __builtin_bit_cast(bf16x8, hi), al = __builtin_bit_cast(bf16x8, lo);
                    lg = __builtin_amdgcn_mfma_f32_16x16x32_bf16(ah, bh[bj], lg, 0, 0, 0);
                    lg = __builtin_amdgcn_mfma_f32_16x16x32_bf16(al, bh[bj], lg, 0, 0, 0);
                    lg = __builtin_amdgcn_mfma_f32_16x16x32_bf16(ah, bl[bj], lg, 0, 0, 0); }
#pragma unroll
                for (int j = 0; j < 4; ++j) RED[((ai * HALF + wr * 64 + m * 16 + 4 * fq + j) * 4 + wc) * 17 + fr] = lg[j]; }
        __syncthreads();
        for (int idx = tid; idx < 256 * 17; idx += 512) { const int e17 = idx >> 8, row = idx & 255;
            const float v = (RED[(row * 4 + 0) * 17 + e17] + RED[(row * 4 + 1) * 17 + e17]) + (RED[(row * 4 + 2) * 17 + e17] + RED[(row * 4 + 3) * 17 + e17]);
            part[(size_t)(u.pn * 17 + e17) * M + u.pm * BM + row] = v; }
    }
};
struct EpiSwiGLU {
    static constexpr bool AFTER_DRAIN = false;
    unsigned char* H; const LAS float* rsl;
    DI void operator()(const f32x4 (&acc)[2][2][4][2], const Unit& u, int wr, int wc, int fr, int fq) const {
        const int row0 = u.pm * BM + wr * 64 + fr, col = u.pn * 128 + wc * 32 + 8 * fq;
        float rsv[2][4];
#pragma unroll
        for (int ai = 0; ai < 2; ++ai)
#pragma unroll
            for (int m = 0; m < 4; ++m) rsv[ai][m] = rsl[u.ui * 256 + ai * HALF + wr * 64 + m * 16 + fr] * 0.0625f;
#pragma unroll
        for (int ai = 0; ai < 2; ++ai)
#pragma unroll
            for (int m = 0; m < 4; ++m) {
                float hv[8]; const float rs = rsv[ai][m];
#pragma unroll
                for (int n = 0; n < 2; ++n)
#pragma unroll
                    for (int j = 0; j < 4; ++j) { const float a = acc[ai][0][m][n][j] * rs, uu = acc[ai][1][m][n][j] * rs;
                        const float hh = a * __builtin_amdgcn_rcpf(1.f + __builtin_amdgcn_exp2f(-a * LOG2E)) * uu; hv[4 * n + j] = fminf(fmaxf(hh, -448.f), 448.f); }
                u32x2 w; w.x = pk4_fp8(hv[0], hv[1], hv[2], hv[3]); w.y = pk4_fp8(hv[4], hv[5], hv[6], hv[7]);
                *(u32x2*)(H + (size_t)(row0 + ai * HALF + m * 16) * DE + col) = w;
            }
    }
};
struct EpiBf16 {
    static constexpr bool AFTER_DRAIN = false;
    bf16_t* O; int ldc; const float* rowscale; float cscale; int coloff;
    DI void operator()(const f32x4 (&acc)[2][2][4][2], const Unit& u, int wr, int wc, int fr, int fq) const {
        const int row0 = u.pm * BM + wr * 64 + fr, col0 = coloff + u.pn * BM + wc * 32 + 8 * fq;
#pragma unroll
        for (int ai = 0; ai < 2; ++ai)
#pragma unroll
            for (int m = 0; m < 4; ++m) { const int row = row0 + ai * HALF + m * 16; const float sc = rowscale ? rowscale[row] * cscale : cscale;
#pragma unroll
                for (int bj = 0; bj < 2; ++bj) { const f32x4 v0 = acc[ai][bj][m][0] * sc, v1 = acc[ai][bj][m][1] * sc;
                    u32x4 w; w.x = cvt_pk_bf16(v0[0], v0[1]); w.y = cvt_pk_bf16(v0[2], v0[3]); w.z = cvt_pk_bf16(v1[0], v1[1]); w.w = cvt_pk_bf16(v1[2], v1[3]);
                    *(u32x4*)(O + (size_t)row * ldc + col0 + bj * HALF) = w; } }
    }
};
struct EpiFp8 {
    static constexpr bool AFTER_DRAIN = false;
    unsigned char* O; int ldc; const float* rowscale; float cscale;
    DI void operator()(const f32x4 (&acc)[2][2][4][2], const Unit& u, int wr, int wc, int fr, int fq) const {
        const int row0 = u.pm * BM + wr * 64 + fr, col0 = u.pn * BM + wc * 32 + 8 * fq;
#pragma unroll
        for (int ai = 0; ai < 2; ++ai)
#pragma unroll
            for (int m = 0; m < 4; ++m) { const int row = row0 + ai * HALF + m * 16; const float sc = rowscale ? rowscale[row] * cscale : cscale;
#pragma unroll
                for (int bj = 0; bj < 2; ++bj) { const f32x4 v0 = acc[ai][bj][m][0] * sc, v1 = acc[ai][bj][m][1] * sc;
                    u32x2 w; w.x = pk4_fp8(v0[0], v0[1], v0[2], v0[3]); w.y = pk4_fp8(v1[0], v1[1], v1[2], v1[3]);
                    *(u32x2*)(O + (size_t)row * ldc + col0 + bj * HALF) = w; } }
    }
};
struct MoeUpOrder {
    int vcu, G; const char* W;
    DI bool next(int i, Unit& u) const { const int L = i * G + vcu; if (L >= 2048) return false; const int ii = L >> 8, v = L & 255, x = v >> 5, j = v & 31, e = 2 * ii + (x >> 2);
        u.pm = 8 * e + (j & 7); u.pn = 4 * (x & 3) + (j >> 3); return true; }
    DI const char* bptr(const Unit& u) const { return W + (size_t)(u.pm >> 3) * 4096 * 1024 + (size_t)u.pn * BM * 1024; }
};
struct MoeDownOrder {
    int vcu, G; const char* W;
    DI bool next(int i, Unit& u) const { const int L = i * G + vcu; if (L >= 512) return false; const int ii = L >> 8, v = L & 255, x = v >> 5, j = v & 31, e = 8 * ii + x;
        u.pm = 8 * e + (j & 7); u.pn = j >> 3; return true; }
    DI const char* bptr(const Unit& u) const { return W + (size_t)(u.pm >> 3) * 1024 * 2048 + (size_t)u.pn * BM * 2048; }
};
}

struct Args { const float* in[19]; float* out; unsigned char* ws; int ph_lo, ph_hi; };
struct Frame {
    LAS unsigned char* lds; volatile LAS unsigned* MISC; unsigned* ctl;
    int tid, lane, wave, vcu, G;
};
enum { IN_X = 0, IN_RELB, IN_ANG, IN_AWIN, IN_AQG, IN_AKG, IN_ASINK, IN_AWOUT, IN_MNG, IN_MWIN, IN_MBI, IN_MBF, IN_MOG, IN_MWOUT, IN_FNG, IN_RW, IN_W1, IN_W3, IN_W2 };

DI void conv_item(const float* W, int ldw, int cbase, bf16_t* dst, int K, int drow0, int k0, bool perm, float scale, LAS float* scr, int lane) {
#pragma unroll 8
    for (int i = 0; i < 32; ++i) { const int kk = 2 * i + (lane >> 5); scr[kk * 33 + (lane & 31)] = W[(size_t)(k0 + kk) * ldw + cbase + (lane & 31)]; }
    LDS_WAIT(); asm volatile("" ::: "memory");
    const int c = lane & 7;
#pragma unroll
    for (int j = 0; j < 4; ++j) { const int n = (lane >> 3) + 8 * j; const LAS float* s = scr + (8 * c) * 33 + n;
        u32x4 o; o.x = pk2(s[0 * 33] * scale, s[1 * 33] * scale); o.y = pk2(s[2 * 33] * scale, s[3 * 33] * scale); o.z = pk2(s[4 * 33] * scale, s[5 * 33] * scale); o.w = pk2(s[6 * 33] * scale, s[7 * 33] * scale);
        const int rho = perm ? pg8::perm32inv(n) : n;
        *(u32x4*)(dst + (size_t)(drow0 + rho) * K + k0 + 8 * c) = o; }
    LDS_WAIT(); asm volatile("" ::: "memory");
}
DI void conv_item8(const float* W, int ldw, int cbase, unsigned char* dst, int K, int drow0, int k0, float scale, LAS float* scr, int lane, bool perm = true) {
    const int a = lane >> 3, b = lane & 7;
    f32x4 v[16];
#pragma unroll
    for (int i = 0; i < 16; ++i) v[i] = __builtin_nontemporal_load((const f32x4*)(W + (size_t)(k0 + 8 * i + a) * ldw + cbase + 4 * b));
#pragma unroll
    for (int i = 0; i < 16; ++i) { const int k = 8 * i + a; LAS float* d = scr + k * 33 + 4 * (k >> 4) + 4 * b; d[0] = v[i].x; d[1] = v[i].y; d[2] = v[i].z; d[3] = v[i].w; }
    LDS_WAIT(); asm volatile("" ::: "memory");
    const int c = lane & 7;
#pragma unroll
    for (int j = 0; j < 4; ++j) { const int n = (lane >> 3) + 8 * j; const LAS float* s = scr + (16 * c) * 33 + 4 * c + n;
        u32x4 o;
#pragma unroll
        for (int q = 0; q < 4; ++q) o[q] = pk4_fp8(s[(4 * q) * 33] * scale, s[(4 * q + 1) * 33] * scale, s[(4 * q + 2) * 33] * scale, s[(4 * q + 3) * 33] * scale);
        __builtin_nontemporal_store(o, (u32x4*)(dst + (size_t)(drow0 + (perm ? pg8::perm32inv(n) : n)) * K + k0 + 16 * c)); }
    LDS_WAIT(); asm volatile("" ::: "memory");
}
DI void rms_row_to_bf16(const float* xrow, const float* g, bf16_t* orow, int lane) {
    const f32x4* xr = (const f32x4*)xrow + lane; const f32x4* gr = (const f32x4*)g + lane;
    f32x4 v[4]; float s = 0.f;
#pragma unroll
    for (int j = 0; j < 4; ++j) { v[j] = xr[64 * j]; s += (v[j].x * v[j].x + v[j].y * v[j].y) + (v[j].z * v[j].z + v[j].w * v[j].w); }
    const float rinv = __builtin_amdgcn_rsqf(wave_sum(s) * (1.f / D) + RMS_EPS);
    unsigned long long* o8 = (unsigned long long*)orow + lane;
#pragma unroll
    for (int j = 0; j < 4; ++j) { const f32x4 gg = gr[64 * j]; const f32x4 y = v[j] * rinv * gg;
        o8[64 * j] = (unsigned long long)pk2(y.x, y.y) | ((unsigned long long)pk2(y.z, y.w) << 32); }
}
constexpr int XI_PER_LE = 1536, XI_TOTAL = 32 * XI_PER_LE;
constexpr int XI_NA = 128 * NWAVES * 6, XI_NB = 192 * NWAVES * 6, XI_NC = 192 * NWAVES * 5, XI_ND = 128 * NWAVES * 16;
constexpr int XI_PRO_END = XI_TOTAL - XI_NA - XI_NB - XI_NC - XI_ND, XI_A_END = XI_PRO_END + XI_NA, XI_B_END = XI_A_END + XI_NB, XI_C_END = XI_TOTAL - XI_ND;
static_assert(XI_B_END >= XI_TOTAL / 2, "the slots after MoE layer 0 may only hold layer-1 items");
DI void expert_conv_items(Frame& F, const Args& a, int it0, int it1, int rank, int nrank) {
    LAS float* scr8 = (LAS float*)(F.lds + F.wave * 17152);
    unsigned char* ws = a.ws;
    for (int it = it0 + rank; it < it1; it += nrank) {
        const int le = it / XI_PER_LE, r = it % XI_PER_LE;
        if (r < 1024) { const int kb = r / 128, g = r % 128, pn = g >> 3, bj = (g >> 2) & 1, wc = g & 3;
            const float* W = (bj ? a.in[IN_W3] : a.in[IN_W1]) + (size_t)le * D * DE;
            conv_item8(W, DE, 128 * pn + 32 * wc, ws + WS_W13 + (size_t)le * 4096 * D, D, 32 * g, 128 * kb, 16.f, scr8, F.lane);
        } else { const int r2 = r - 1024, kb = r2 / 32, g = r2 % 32;
            conv_item8(a.in[IN_W2] + (size_t)le * DE * D, D, 32 * g, ws + WS_W2 + (size_t)le * D * DE, DE, 32 * g, 128 * kb, 32.f, scr8, F.lane); }
    }
}
DI void rms_row_to_fp8(const float* xrow, const float* g, unsigned char* orow, int lane) {
    const f32x4* xr = (const f32x4*)xrow + lane; const f32x4* gr = (const f32x4*)g + lane;
    f32x4 v[4]; float s = 0.f;
#pragma unroll
    for (int j = 0; j < 4; ++j) { v[j] = xr[64 * j]; s += (v[j].x * v[j].x + v[j].y * v[j].y) + (v[j].z * v[j].z + v[j].w * v[j].w); }
    const float rinv = __builtin_amdgcn_rsqf(wave_sum(s) * (1.f / D) + RMS_EPS);
#pragma unroll
    for (int j = 0; j < 4; ++j) { const f32x4 y = v[j] * rinv * gr[64 * j]; *((unsigned*)orow + lane + 64 * j) = pk4_fp8(y.x, y.y, y.z, y.w); }
}
DI void p0_prologue(Frame& F, const Args& a) {
    LAS float* scr = (LAS float*)(F.lds + F.wave * 17152);
    const int gw = F.vcu * NWAVES + F.wave, NGW = F.G * NWAVES;
    unsigned char* ws = a.ws;
    LAS float* scr8 = (LAS float*)(F.lds + F.wave * 17152);
    constexpr int I_QKV = 8 * 48, I_AO = 8 * 32, I_MINA = 16 * 32, I_MINB = 8 * 64, I_MO = 16 * 32, I_SMALL = I_QKV + I_AO + I_MINA + I_MINB + I_MO;
    for (int it = gw; it < I_SMALL; it += NGW) {
        int r = it;
        if (r < I_QKV) { const int kb = r / 48, g = r % 48, pn = g >> 3, bj = (g >> 2) & 1, wc = g & 3;
            conv_item8(a.in[IN_AWIN], NQKV, 256 * pn + 64 * wc + 32 * bj, ws + WS_WQKV, D, 32 * g, 128 * kb, 16.f, scr8, F.lane, true); continue; } r -= I_QKV;
        if (r < I_AO) { const int kb = r / 32, g = r % 32; conv_item8(a.in[IN_AWOUT], D, 32 * g, ws + WS_WAO, D, 32 * g, 128 * kb, 16.f, scr8, F.lane, false); continue; } r -= I_AO;
        if (r < I_MINA) { const int kb = r / 32, g = r % 32; const float sc = g >= 16 ? 0.125f : 1.f;
            conv_item(a.in[IN_MWIN], MIN_LD, 32 * g, (bf16_t*)(ws + WS_WMIN), D, 32 * g, 64 * kb, true, sc, scr, F.lane); continue; } r -= I_MINA;
        if (r < I_MINB) { const int kb = r / 64, g = r % 64;
            conv_item8(a.in[IN_MWIN], MIN_LD, 1024 + 32 * g, ws + WS_WMIN8, D, 32 * g, 128 * kb, 16.f, scr8, F.lane, true); continue; } r -= I_MINB;
        { const int kb = r / 32, g = r % 32; conv_item(a.in[IN_MWOUT], D, 32 * g, (bf16_t*)(ws + WS_WMO), D, 32 * g, 64 * kb, false, 1.f, scr, F.lane); }
    }
    for (int m = gw; m < M; m += NGW) rms_row_to_fp8(a.in[IN_X] + (size_t)m * D, a.in[IN_ANG], ws + WS_XN8 + (size_t)m * D, F.lane);
    expert_conv_items(F, a, 0, XI_PRO_END, gw, NGW);
}

constexpr int AT_K = 0, AT_V = 49152, AT_TB = 98304, AT_TB_COPY = 324, AT_TB_HEAD = 4 * AT_TB_COPY;
DI int t5_bucket_dev(int rel) {
    const int n = rel < 0 ? -rel : rel; int b;
    if (n < 8) b = n; else if (n < 12) b = 8; else if (n < 16) b = 9; else if (n < 23) b = 10; else if (n < 32) b = 11; else if (n < 46) b = 12; else if (n < 64) b = 13; else if (n < 91) b = 14; else b = 15;
    return b + (rel > 0 ? 16 : 0);
}
DI bf16x8 pack_step(const f32x16& x, int s) {
    u32x4 p;
    p.x = cvt_pk_bf16(x[8 * s + 0], x[8 * s + 1]); p.y = cvt_pk_bf16(x[8 * s + 2], x[8 * s + 3]); p.z = cvt_pk_bf16(x[8 * s + 4], x[8 * s + 5]); p.w = cvt_pk_bf16(x[8 * s + 6], x[8 * s + 7]);
    return __builtin_bit_cast(bf16x8, p);
}
typedef short v4i16_t __attribute__((ext_vector_type(4)));
DI s16x4 tr_read(const LAS unsigned char* p) { return __builtin_bit_cast(s16x4, __builtin_amdgcn_ds_read_tr16_b64_v4i16((LAS v4i16_t*)p)); }
DI bf16x8 cat8(s16x4 lo, s16x4 hi) { return __builtin_shufflevector(lo, hi, 0, 1, 2, 3, 4, 5, 6, 7); }

DI void attn_phase(Frame& F, const Args& a) {
    LAS unsigned char* lds = F.lds;
    const bf16_t* Qg = (const bf16_t*)(a.ws + WS_Q); const bf16_t* Kg = (const bf16_t*)(a.ws + WS_K); const bf16_t* Vg = (const bf16_t*)(a.ws + WS_V); unsigned char* Og = a.ws + WS_O;
    const float* relb = a.in[IN_RELB]; const float* sink = a.in[IN_ASINK];
    const int lane = F.lane, wave = F.wave, r = lane & 31, h = lane >> 5;
    const int g = wave >> 1, half = wave & 1;
    LAS float* TB = (LAS float*)(lds + AT_TB);
    constexpr int NPF = 6;
    u32x4 kvr[NPF];
#define AT_LOAD(u_) do { const int qb_ = (u_) & 31, kvh_ = ((u_) >> 5) & 3, b_ = (u_) >> 7, kb_ = qb_ * 128 - 128; \
        _Pragma("unroll") for (int i = 0; i < NPF; ++i) { const int idx = F.tid + i * NTHR, isv = idx >= 3072, rem = isv ? idx - 3072 : idx, row = rem >> 3, c = rem & 7; int kp = kb_ + row; kp = kp < 0 ? 0 : (kp >= SEQ ? SEQ - 1 : kp); \
            kvr[i] = *(const u32x4*)((isv ? Vg : Kg) + (size_t)(b_ * SEQ + kp) * 256 + kvh_ * 64 + c * 8); } } while (0)
    int tb_kvh = -1;
    if (F.vcu < 512) AT_LOAD(F.vcu);
    for (int u = F.vcu; u < 512; u += F.G) {
        const int qb = u & 31, kvh = (u >> 5) & 3, b = u >> 7;
        const int kbase = qb * 128 - 128;
        __syncthreads();
        if (kvh != tb_kvh) { tb_kvh = kvh;
#pragma unroll 4
            for (int idx = F.tid; idx < 4 * AT_TB_HEAD; idx += NTHR) {
                const int gg = idx / AT_TB_HEAD, rem = idx % AT_TB_HEAD, c = rem / AT_TB_COPY, i = rem % AT_TB_COPY, rel = i + c - 160;
                float v = -__builtin_inff();
                if (rel >= -128 && rel <= 128) v = relb[t5_bucket_dev(rel) * 16 + kvh * 4 + gg] * LOG2E;
                TB[idx] = v;
            } }
        u32x4 late[12 - NPF];
#pragma unroll
        for (int i = NPF; i < 12; ++i) { const int idx = F.tid + i * NTHR, isv = idx >= 3072, rem = isv ? idx - 3072 : idx, row = rem >> 3, c = rem & 7; int kp = kbase + row; kp = kp < 0 ? 0 : (kp >= SEQ ? SEQ - 1 : kp);
            late[i - NPF] = *(const u32x4*)((isv ? Vg : Kg) + (size_t)(b * SEQ + kp) * 256 + kvh * 64 + c * 8); }
#pragma unroll
        for (int i = 0; i < 12; ++i) { const int idx = F.tid + i * NTHR, isv = idx >= 3072, rem = isv ? idx - 3072 : idx, row = rem >> 3, c = rem & 7;
            const int pos = isv ? (c ^ (((row >> 1) & 1) << 2)) : (c ^ ((row >> 1) & 7));
            *(LAS u32x4*)(lds + (isv ? AT_V : AT_K) + row * 128 + pos * 16) = i < NPF ? kvr[i] : late[i < NPF ? 0 : i - NPF]; }
        if (u + F.G < 512) AT_LOAD(u + F.G);
        const int head = kvh * 4 + g, qw0 = qb * 128 + 64 * half;
        bf16x8 qf[2][4];
#pragma unroll
        for (int qt = 0; qt < 2; ++qt)
#pragma unroll
            for (int s = 0; s < 4; ++s) qf[qt][s] = *(const bf16x8*)(Qg + (size_t)(b * SEQ + qw0 + 32 * qt + r) * 1024 + head * 64 + 16 * s + 8 * h);
        __syncthreads();
        const float sk = sink[head] * LOG2E;
        float mrun[2] = {sk, sk}, lrun[2] = {h == 0 ? 1.f : 0.f, h == 0 ? 1.f : 0.f};
        f32x16 o[2][2];
#pragma unroll
        for (int qt = 0; qt < 2; ++qt)
#pragma unroll
            for (int dt = 0; dt < 2; ++dt)
#pragma unroll
                for (int i = 0; i < 16; ++i) o[qt][dt][i] = 0.f;
        const int cpy = (4 - (r & 3)) & 3;
        const LAS float* tbl = TB + g * AT_TB_HEAD + cpy * AT_TB_COPY + (32 + 4 * h - r - cpy);
        const int q4 = (lane & 15) >> 2, p4 = lane & 3, blk = (lane >> 4) & 1;
        for (int T = 2 * half; T < 2 * half + 10; ++T) {
            const int kp0 = kbase + 32 * T;
            if (kp0 < 0 || kp0 >= SEQ) continue;
            bf16x8 kf[4];
            { const int row = 32 * T + r;
#pragma unroll
              for (int s = 0; s < 4; ++s) kf[s] = *(const LAS bf16x8*)(lds + AT_K + row * 128 + (((2 * s + h) ^ ((row >> 1) & 7)) << 4)); }
            bf16x8 vf[2][2];
#pragma unroll
            for (int dt = 0; dt < 2; ++dt)
#pragma unroll
                for (int s = 0; s < 2; ++s) {
                    const int row0 = 32 * T + 16 * s + 4 * h + q4, row1 = row0 + 8, cb = 64 * dt + 32 * blk + 8 * p4;
                    const s16x4 lo = tr_read(lds + AT_V + row0 * 128 + (cb ^ (((row0 >> 1) & 1) << 6)));
                    const s16x4 hi = tr_read(lds + AT_V + row1 * 128 + (cb ^ (((row1 >> 1) & 1) << 6)));
                    vf[dt][s] = cat8(lo, hi);
                }
#pragma unroll
            for (int qt = 0; qt < 2; ++qt) {
                const int kt = T - 2 * half - qt;
                if (kt < 0 || kt > 8) continue;
                f32x16 sacc;
#pragma unroll
                for (int G4 = 0; G4 < 4; ++G4) { const f32x4 t = *(const LAS f32x4*)(tbl + 32 * kt + 8 * G4);
                    sacc[4 * G4 + 0] = t[0]; sacc[4 * G4 + 1] = t[1]; sacc[4 * G4 + 2] = t[2]; sacc[4 * G4 + 3] = t[3]; }
#pragma unroll
                for (int s = 0; s < 4; ++s) sacc = __builtin_amdgcn_mfma_f32_32x32x16_bf16(kf[s], qf[qt][s], sacc, 0, 0, 0);
                float mx = sacc[0];
#pragma unroll
                for (int i = 1; i < 16; ++i) mx = fmaxf(mx, sacc[i]);
                mx = fmaxf(mx, __shfl_xor(mx, 32));
                const float mnew = fmaxf(mrun[qt], mx), alpha = __builtin_amdgcn_exp2f(mrun[qt] - mnew);
                mrun[qt] = mnew;
                float ls = 0.f;
#pragma unroll
                for (int i = 0; i < 16; ++i) { sacc[i] = __builtin_amdgcn_exp2f(sacc[i] - mnew); ls += sacc[i]; }
                lrun[qt] = lrun[qt] * alpha + ls;
#pragma unroll
                for (int dt = 0; dt < 2; ++dt)
#pragma unroll
                    for (int i = 0; i < 16; ++i) o[qt][dt][i] *= alpha;
                const bf16x8 p0 = pack_step(sacc, 0), p1 = pack_step(sacc, 1);
#pragma unroll
                for (int dt = 0; dt < 2; ++dt) {
                    o[qt][dt] = __builtin_amdgcn_mfma_f32_32x32x16_bf16(vf[dt][0], p0, o[qt][dt], 0, 0, 0);
                    o[qt][dt] = __builtin_amdgcn_mfma_f32_32x32x16_bf16(vf[dt][1], p1, o[qt][dt], 0, 0, 0);
                }
            }
        }
#pragma unroll
        for (int qt = 0; qt < 2; ++qt) {
            const float lt = lrun[qt] + __shfl_xor(lrun[qt], 32), inv = 16.f / lt;
            unsigned char* orow = Og + (size_t)(b * SEQ + qw0 + 32 * qt + r) * 1024 + head * 64;
#pragma unroll
            for (int dt = 0; dt < 2; ++dt)
#pragma unroll
                for (int G4 = 0; G4 < 4; ++G4)
                    *(unsigned*)(orow + 32 * dt + 8 * G4 + 4 * h) = pk4_fp8(o[qt][dt][4 * G4] * inv, o[qt][dt][4 * G4 + 1] * inv, o[qt][dt][4 * G4 + 2] * inv, o[qt][dt][4 * G4 + 3] * inv);
        }
    }
#undef AT_LOAD
}

template <int N> DI int multi_reduce(float (&v)[N], int lane) {
    int idx = 0;
#pragma unroll
    for (int bit = 32, cnt = N / 2; cnt >= 1; bit >>= 1, cnt >>= 1) {
        const bool upper = (lane & bit) != 0;
#pragma unroll
        for (int i = 0; i < cnt; ++i) { const float lo = v[i], hi = v[i + cnt]; const float send = upper ? lo : hi, keep = upper ? hi : lo; v[i] = keep + __shfl_xor(send, bit); }
        idx |= upper ? cnt : 0;
    }
#pragma unroll
    for (int bit = 32 / N; bit >= 1; bit >>= 1) v[0] += __shfl_xor(v[0], bit);
    return idx;
}
DI float log_sigmoid(float x) { return x < 0.f ? x - log1pf(expf(x)) : -log1pf(expf(-x)); }
DI void add_routed_rows(f32x4 (&x)[4], const unsigned char* Y, int sl, int b, int lane) {
    unsigned long long mask = __ballot(sl >= 0);
    while (mask) {
        const unsigned char* yr[4]; float wq[4];
#pragma unroll
        for (int q = 0; q < 4; ++q) { const bool v = mask != 0ull; const int e = v ? __builtin_ctzll(mask) : 0; if (v) mask &= mask - 1;
            const int sv = __builtin_amdgcn_readlane(sl, e); wq[q] = v ? 1.f / YS8 : 0.f;
            yr[q] = (v || q == 0) ? Y + (size_t)((e * NB + b) * CAP + sv) * D : yr[0]; }
        unsigned w[4][4];
#pragma unroll
        for (int q = 0; q < 4; ++q)
#pragma unroll
            for (int j = 0; j < 4; ++j) w[q][j] = __builtin_nontemporal_load((const unsigned*)yr[q] + lane + 64 * j);
#pragma unroll
        for (int q = 0; q < 4; ++q)
#pragma unroll
            for (int j = 0; j < 4; ++j) { const f32x2 lo = __builtin_amdgcn_cvt_pk_f32_fp8(w[q][j], false), hi = __builtin_amdgcn_cvt_pk_f32_fp8(w[q][j], true);
                x[j].x += wq[q] * lo.x; x[j].y += wq[q] * lo.y; x[j].z += wq[q] * hi.x; x[j].w += wq[q] * hi.y; }
    }
}
template <int NEV, bool COMBINE>
DI void nr_phase(Frame& F, const bf16_t* base, const unsigned char* Y, const int* slot, bf16_t* xout, const float* g, bf16_t* XN, unsigned char* XN8,
                 const float* Wsrc, int ldw, int col0, float* outv, const float* b_i, const float* b_f) {
    LAS float* Wt = (LAS float*)F.lds;
    { f32x4 wv[NEV / 2];
#pragma unroll
      for (int i = 0; i < NEV / 2; ++i) { const int idx = F.tid + i * NTHR, d = idx / (NEV / 4), e4 = idx % (NEV / 4); wv[i] = *(const f32x4*)(Wsrc + (size_t)d * ldw + col0 + 4 * e4); }
#pragma unroll
      for (int i = 0; i < NEV / 2; ++i) { const int idx = F.tid + i * NTHR, d = idx / (NEV / 4), e4 = idx % (NEV / 4);
#pragma unroll
          for (int q = 0; q < 4; ++q) Wt[(4 * e4 + q) * 1024 + d] = wv[i][q]; } }
    const int gw = F.vcu * NWAVES + F.wave, NGW = F.G * NWAVES, lane = F.lane;
    LAS float* res = (LAS float*)(F.lds + AUX_OFF) + F.wave * 64;
    f32x4 gg[4];
#pragma unroll
    for (int j = 0; j < 4; ++j) gg[j] = *((const f32x4*)g + lane + 64 * j);
    __syncthreads();
#pragma unroll 1
    for (int m0 = gw; m0 < M; m0 += 4 * NGW) {
        f32x4 x[4][4]; int sl[4];
#pragma unroll
        for (int t4 = 0; t4 < 4; ++t4) { const int m = m0 + t4 * NGW < M ? m0 + t4 * NGW : m0;
#pragma unroll
            for (int j = 0; j < 4; ++j) { const u32x2 w = __builtin_nontemporal_load((const u32x2*)(base + (size_t)m * D) + lane + 64 * j);
                x[t4][j] = (f32x4){__builtin_bit_cast(float, w.x << 16), __builtin_bit_cast(float, w.x & 0xffff0000u), __builtin_bit_cast(float, w.y << 16), __builtin_bit_cast(float, w.y & 0xffff0000u)}; }
            sl[t4] = (COMBINE && lane < NE) ? slot[(size_t)m * NE + lane] : -1; }
#pragma unroll
        for (int pp = 0; pp < 4; pp += 2) {
            int mm[2]; float ssv[2];
#pragma unroll
            for (int u = 0; u < 2; ++u) {
                const int t4 = pp + u; const int m = m0 + t4 * NGW < M ? m0 + t4 * NGW : m0; mm[u] = m;
                if (COMBINE) add_routed_rows(x[t4], Y, sl[t4], m / SEQ, lane);
                if (xout) {
#pragma unroll
                    for (int j = 0; j < 4; ++j) { u32x2 w; w.x = cvt_pk_bf16(x[t4][j].x, x[t4][j].y); w.y = cvt_pk_bf16(x[t4][j].z, x[t4][j].w); *((u32x2*)(xout + (size_t)m * D) + lane + 64 * j) = w;
                        x[t4][j] = (f32x4){__builtin_bit_cast(float, w.x << 16), __builtin_bit_cast(float, w.x & 0xffff0000u), __builtin_bit_cast(float, w.y << 16), __builtin_bit_cast(float, w.y & 0xffff0000u)}; }
                }
                float ss = 0.f;
#pragma unroll
                for (int j = 0; j < 4; ++j) ss += (x[t4][j].x * x[t4][j].x + x[t4][j].y * x[t4][j].y) + (x[t4][j].z * x[t4][j].z + x[t4][j].w * x[t4][j].w);
                const float sst = wave_sum(ss); ssv[u] = sst;
                const float rinv = NEV == 16 ? 1.f : __builtin_amdgcn_rsqf(sst * (1.f / D) + RMS_EPS);
#pragma unroll
                for (int j = 0; j < 4; ++j) { x[t4][j] = x[t4][j] * rinv * gg[j];
                    if (NEV == 32) *((unsigned long long*)(XN + (size_t)m * D) + lane + 64 * j) = (unsigned long long)pk2(x[t4][j].x, x[t4][j].y) | ((unsigned long long)pk2(x[t4][j].z, x[t4][j].w) << 32);
                    else *((unsigned*)(XN8 + (size_t)m * D) + lane + 64 * j) = pk4_fp8(x[t4][j].x, x[t4][j].y, x[t4][j].z, x[t4][j].w); }
            }
#pragma unroll 1
            for (int eg = 0; eg < NEV / 4; ++eg) {
                float v8[8];
#pragma unroll
                for (int e4 = 0; e4 < 4; ++e4) { float s0 = 0.f, s1 = 0.f;
#pragma unroll
                    for (int j = 0; j < 4; ++j) { const f32x4 w = *((const LAS f32x4*)(Wt + (4 * eg + e4) * 1024) + lane + 64 * j);
                        s0 += (x[pp][j].x * w.x + x[pp][j].y * w.y) + (x[pp][j].z * w.z + x[pp][j].w * w.w); s1 += (x[pp + 1][j].x * w.x + x[pp + 1][j].y * w.y) + (x[pp + 1][j].z * w.z + x[pp + 1][j].w * w.w); }
                    v8[e4] = s0; v8[4 + e4] = s1; }
                const int i8 = multi_reduce<8>(v8, lane);
                if ((lane & 7) == 0) res[(i8 >> 2) * 32 + 4 * eg + (i8 & 3)] = v8[0];
            }
            asm volatile("s_waitcnt lgkmcnt(0)" ::: "memory");
            if (NEV == 16) {
                const int u = (lane >> 4) & 1, e = lane & 15, m = mm[u];
                if (lane < 32) { outv[(size_t)e * M + m] = res[u * 32 + e]; if (e == 0) outv[(size_t)16 * M + m] = ssv[u]; }
#pragma unroll
                for (int q = 0; q < 2; ++q) { const int idx = lane + 64 * q; if (idx < 102) { const int uu = idx / 51, r51 = idx % 51; outv[(size_t)(17 + r51) * M + mm[uu]] = 0.f; } }
            } else {
                const int u = lane >> 5, k = lane & 31, m = mm[u];
                const float v = res[u * 32 + k];
                const int kind = k >> 3, hd = k & 7, dir = kind >> 1;
                outv[(size_t)m * 32 + k] = (kind & 1) ? log_sigmoid(v + b_f[dir * 8 + hd]) : v + b_i[dir * 8 + hd];
            }
            asm volatile("" ::: "memory");
        }
    }
}
constexpr int NRM_WB = 0, NRM_WB_LD = 2128, NRM_XR = 32 * NRM_WB_LD, NRM_XR_LD = 2112;
static_assert(NRM_XR + NWAVES * 4 * NRM_XR_LD <= AUX_OFF + AUX_BYTES, "nrm_phase LDS");
DI void nrm_phase(Frame& F, const bf16_t* base, const unsigned char* Y, const int* slot, bf16_t* xout, const float* g, bf16_t* XN, unsigned char* XN8,
                  const float* Wsrc, int ldw, int col0, float* outv, const float* b_i, const float* b_f) {
    LAS unsigned char* lds = F.lds;
    { f32x4 wv[16];
#pragma unroll
      for (int i = 0; i < 16; ++i) { const int idx = F.tid + i * NTHR, d = idx >> 3, e4 = idx & 7; wv[i] = *(const f32x4*)(Wsrc + (size_t)d * ldw + col0 + 4 * e4); }
#pragma unroll
      for (int i = 0; i < 16; ++i) { const int idx = F.tid + i * NTHR, d = idx >> 3, e4 = idx & 7;
#pragma unroll
          for (int q = 0; q < 4; ++q) *(LAS unsigned short*)(lds + NRM_WB + (4 * e4 + q) * NRM_WB_LD + d * 2) = (unsigned short)f2bf(wv[i][q]); } }
    const int gw = F.vcu * NWAVES + F.wave, NGW = F.G * NWAVES, lane = F.lane, fr = lane & 15, fq = lane >> 4;
    LAS unsigned char* xr = lds + NRM_XR + F.wave * 4 * NRM_XR_LD;
    f32x4 gg[4];
#pragma unroll
    for (int j = 0; j < 4; ++j) gg[j] = *((const f32x4*)g + lane + 64 * j);
    float bias[2]; bool isf[2];
#pragma unroll
    for (int n = 0; n < 2; ++n) { const int k = fr + 16 * n, kind = k >> 3, hd = k & 7, dir = kind >> 1; isf[n] = (kind & 1) != 0; bias[n] = isf[n] ? b_f[dir * 8 + hd] : b_i[dir * 8 + hd]; }
    __syncthreads();
#pragma unroll 1
    for (int m0 = gw; m0 < M; m0 += 4 * NGW) {
        f32x4 x[4][4]; int sl[4]; int mm[4];
#pragma unroll
        for (int t4 = 0; t4 < 4; ++t4) { const int m = m0 + t4 * NGW < M ? m0 + t4 * NGW : m0; mm[t4] = m;
#pragma unroll
            for (int j = 0; j < 4; ++j) { const u32x2 w = __builtin_nontemporal_load((const u32x2*)(base + (size_t)m * D) + lane + 64 * j);
                x[t4][j] = (f32x4){__builtin_bit_cast(float, w.x << 16), __builtin_bit_cast(float, w.x & 0xffff0000u), __builtin_bit_cast(float, w.y << 16), __builtin_bit_cast(float, w.y & 0xffff0000u)}; }
            sl[t4] = lane < NE ? slot[(size_t)m * NE + lane] : -1; }
#pragma unroll
        for (int t4 = 0; t4 < 4; ++t4) { const int m = mm[t4];
            add_routed_rows(x[t4], Y, sl[t4], m / SEQ, lane);
#pragma unroll
            for (int j = 0; j < 4; ++j) { u32x2 w; w.x = cvt_pk_bf16(x[t4][j].x, x[t4][j].y); w.y = cvt_pk_bf16(x[t4][j].z, x[t4][j].w); *((u32x2*)(xout + (size_t)m * D) + lane + 64 * j) = w;
                x[t4][j] = (f32x4){__builtin_bit_cast(float, w.x << 16), __builtin_bit_cast(float, w.x & 0xffff0000u), __builtin_bit_cast(float, w.y << 16), __builtin_bit_cast(float, w.y & 0xffff0000u)}; }
            float ss = 0.f;
#pragma unroll
            for (int j = 0; j < 4; ++j) ss += (x[t4][j].x * x[t4][j].x + x[t4][j].y * x[t4][j].y) + (x[t4][j].z * x[t4][j].z + x[t4][j].w * x[t4][j].w);
            const float rinv = __builtin_amdgcn_rsqf(wave_sum(ss) * (1.f / D) + RMS_EPS);
#pragma unroll
            for (int j = 0; j < 4; ++j) { const f32x4 hn = x[t4][j] * rinv * gg[j]; u32x2 w; w.x = cvt_pk_bf16(hn.x, hn.y); w.y = cvt_pk_bf16(hn.z, hn.w);
                *((u32x2*)(XN + (size_t)m * D) + lane + 64 * j) = w; *(LAS u32x2*)(xr + t4 * NRM_XR_LD + (4 * lane + 256 * j) * 2) = w;
                *((unsigned*)(XN8 + (size_t)m * D) + lane + 64 * j) = pk4_fp8(hn.x, hn.y, hn.z, hn.w); }
        }
        asm volatile("s_waitcnt lgkmcnt(0)" ::: "memory");
        f32x4 ga[2] = {(f32x4){0.f, 0.f, 0.f, 0.f}, (f32x4){0.f, 0.f, 0.f, 0.f}};
#pragma unroll 4
        for (int ks = 0; ks < 32; ++ks) {
            bf16x8 a = (bf16x8){0, 0, 0, 0, 0, 0, 0, 0};
            if (fr < 4) a = *(const LAS bf16x8*)(xr + fr * NRM_XR_LD + (32 * ks + 8 * fq) * 2);
            const bf16x8 b0 = *(const LAS bf16x8*)(lds + NRM_WB + fr * NRM_WB_LD + (32 * ks + 8 * fq) * 2), b1 = *(const LAS bf16x8*)(lds + NRM_WB + (16 + fr) * NRM_WB_LD + (32 * ks + 8 * fq) * 2);
            ga[0] = __builtin_amdgcn_mfma_f32_16x16x32_bf16(a, b0, ga[0], 0, 0, 0); ga[1] = __builtin_amdgcn_mfma_f32_16x16x32_bf16(a, b1, ga[1], 0, 0, 0);
        }
        if (fq == 0) {
#pragma unroll
            for (int n = 0; n < 2; ++n)
#pragma unroll
                for (int j = 0; j < 4; ++j) { const float v = ga[n][j] + bias[n]; outv[(size_t)mm[j] * 32 + fr + 16 * n] = isf[n] ? log_sigmoid(v) : v; } }
        asm volatile("" ::: "memory");
    }
}
DI int block_excl_scan(int v, LAS int* wsum, int lane, int wave, int& total) {
    int inc = v;
#pragma unroll
    for (int o = 1; o < 64; o <<= 1) { const int t = __shfl_up(inc, o); if (lane >= o) inc += t; }
    if (lane == 63) wsum[wave] = inc;
    __syncthreads();
    int basev = 0, tot = 0;
#pragma unroll
    for (int w = 0; w < NWAVES; ++w) { const int x = wsum[w]; basev += (w < wave) ? x : 0; tot += x; }
    __syncthreads();
    total = tot;
    return basev + inc - v;
}
DI void topk_phase(Frame& F, const float* part, int* idxrow, float* gate, float* rsc, int* slot) {
    LAS unsigned* hist = (LAS unsigned*)F.lds; LAS unsigned* sh = hist + 4096; LAS int* wsum = (LAS int*)(hist + 4112);
    const int tid = F.tid;
    for (int p = blockIdx.x; p < NB * NE; p += F.G) {
        const int b = p / NE, e = p % NE;
        unsigned v[8]; float rinv8[8];
        { const float* pb = part + (size_t)b * SEQ + 8 * tid;
          float ssum[8], mx[8], sm[8], lm[8];
#pragma unroll
          for (int i = 0; i < 8; ++i) { ssum[i] = 0.f; mx[i] = -__builtin_inff(); sm[i] = 0.f; lm[i] = 0.f; }
#pragma unroll
          for (int pn = 0; pn < 4; ++pn) { const f32x4 a0 = *(const f32x4*)(pb + (size_t)(pn * 17 + 16) * M), a1 = *(const f32x4*)(pb + (size_t)(pn * 17 + 16) * M + 4);
#pragma unroll
              for (int i = 0; i < 4; ++i) { ssum[i] += a0[i]; ssum[4 + i] += a1[i]; } }
#pragma unroll
          for (int i = 0; i < 8; ++i) rinv8[i] = __builtin_amdgcn_rsqf(ssum[i] * (1.f / D) + RMS_EPS);
#pragma unroll 4
          for (int ee = 0; ee < NE; ++ee) { float l[8];
#pragma unroll
              for (int i = 0; i < 8; ++i) l[i] = 0.f;
#pragma unroll
              for (int pn = 0; pn < 4; ++pn) { const f32x4 a0 = *(const f32x4*)(pb + (size_t)(pn * 17 + ee) * M), a1 = *(const f32x4*)(pb + (size_t)(pn * 17 + ee) * M + 4);
#pragma unroll
                  for (int i = 0; i < 4; ++i) { l[i] += a0[i]; l[4 + i] += a1[i]; } }
#pragma unroll
              for (int i = 0; i < 8; ++i) { const float li = l[i] * rinv8[i], mn = fmaxf(mx[i], li); sm[i] = sm[i] * __expf(mx[i] - mn) + __expf(li - mn); mx[i] = mn; lm[i] = ee == e ? li : lm[i]; } }
#pragma unroll
          for (int i = 0; i < 8; ++i) v[i] = __builtin_bit_cast(unsigned, __expf(lm[i] - mx[i]) / sm[i]); }
        unsigned prefix = 0u; int need = CAP;
#pragma unroll 1
        for (int pass = 0; pass < 3; ++pass) {
            const int shift = pass == 0 ? 20 : (pass == 1 ? 8 : 0), hs = pass == 0 ? 31 : (pass == 1 ? 20 : 8);
            *((LAS u32x4*)hist + 2 * tid) = (u32x4){0u, 0u, 0u, 0u}; *((LAS u32x4*)hist + 2 * tid + 1) = (u32x4){0u, 0u, 0u, 0u};
            __syncthreads();
#pragma unroll
            for (int i = 0; i < 8; ++i) if (pass == 0 || (v[i] >> hs) == prefix) __hip_atomic_fetch_add(&hist[(v[i] >> shift) & (pass == 2 ? 0xffu : 0xfffu)], 1u, __ATOMIC_RELAXED, __HIP_MEMORY_SCOPE_WORKGROUP);
            __syncthreads();
            const u32x4 c0 = *((const LAS u32x4*)hist + 2 * tid), c1 = *((const LAS u32x4*)hist + 2 * tid + 1);
            const int cnt[8] = {(int)c0.x, (int)c0.y, (int)c0.z, (int)c0.w, (int)c1.x, (int)c1.y, (int)c1.z, (int)c1.w};
            const int ls = ((cnt[0] + cnt[1]) + (cnt[2] + cnt[3])) + ((cnt[4] + cnt[5]) + (cnt[6] + cnt[7]));
            int tot; const int pre = block_excl_scan(ls, wsum, F.lane, F.wave, tot);
            int run = tot - pre - ls;
#pragma unroll
            for (int j = 7; j >= 0; --j) { if (run < need && run + cnt[j] >= need) { sh[0] = (unsigned)(8 * tid + j); sh[1] = (unsigned)(need - run); } run += cnt[j]; }
            __syncthreads();
            prefix = pass == 0 ? sh[0] : ((prefix << (pass == 1 ? 12 : 8)) | sh[0]); need = (int)sh[1];
        }
        const unsigned T = prefix;
        int ce = 0;
#pragma unroll
        for (int i = 0; i < 8; ++i) ce += (v[i] == T) ? 1 : 0;
        int tot;
        int eqr = block_excl_scan(ce, wsum, F.lane, F.wave, tot);
        unsigned selm = 0u; int cs = 0;
#pragma unroll
        for (int i = 0; i < 8; ++i) { bool sel = v[i] > T; if (v[i] == T) { sel = eqr < need; ++eqr; } if (sel) { selm |= 1u << i; ++cs; } }
        int pos = block_excl_scan(cs, wsum, F.lane, F.wave, tot);
#pragma unroll
        for (int i = 0; i < 8; ++i) { const int t = 8 * tid + i; int sv = -1;
            if (selm & (1u << i)) { const int row = (e * NB + b) * CAP + pos; idxrow[row] = b * SEQ + t; gate[row] = __builtin_bit_cast(float, v[i]); rsc[row] = rinv8[i]; sv = pos; ++pos; }
            slot[(size_t)(b * SEQ + t) * NE + e] = sv; }
        __syncthreads();
    }
}
DI void combine_phase(Frame& F, const bf16_t* base, const unsigned char* Y, const int* slot, float* out) {
    const int gw = F.vcu * NWAVES + F.wave, NGW = F.G * NWAVES, lane = F.lane;
    for (int m0 = gw; m0 < M; m0 += 4 * NGW) {
        f32x4 x[4][4]; int sl[4];
#pragma unroll
        for (int t4 = 0; t4 < 4; ++t4) { const int m = m0 + t4 * NGW < M ? m0 + t4 * NGW : m0;
#pragma unroll
            for (int j = 0; j < 4; ++j) { const u32x2 w = __builtin_nontemporal_load((const u32x2*)(base + (size_t)m * D) + lane + 64 * j);
                x[t4][j] = (f32x4){__builtin_bit_cast(float, w.x << 16), __builtin_bit_cast(float, w.x & 0xffff0000u), __builtin_bit_cast(float, w.y << 16), __builtin_bit_cast(float, w.y & 0xffff0000u)}; }
            sl[t4] = lane < NE ? slot[(size_t)m * NE + lane] : -1; }
#pragma unroll
        for (int t4 = 0; t4 < 4; ++t4) { const int m = m0 + t4 * NGW < M ? m0 + t4 * NGW : m0;
            add_routed_rows(x[t4], Y, sl[t4], m / SEQ, lane);
#pragma unroll
            for (int j = 0; j < 4; ++j) __builtin_nontemporal_store(x[t4][j], (f32x4*)(out + (size_t)m * D) + lane + 64 * j); }
    }
}
DI void moe_up_phase(Frame& F, unsigned char* ws, int l) {
    pg8::MoeUpOrder S{F.vcu, F.G, (const char*)(ws + WS_W13 + (size_t)l * W13_LAYER)};
    LAS int* il = (LAS int*)(F.lds + AUX_OFF); const int* idxrow = (const int*)(ws + WS_IDX);
    pg8::Unit u;
    LAS float* rl = (LAS float*)(F.lds + AUX_OFF + 8192); const float* rsc = (const float*)(ws + WS_RSC);
    for (int i = 0; i < 8 && S.next(i, u); ++i) { if (F.tid < 256) il[i * 256 + F.tid] = idxrow[u.pm * 256 + F.tid]; else rl[i * 256 + F.tid - 256] = rsc[u.pm * 256 + F.tid - 256]; }
    __syncthreads();
    pg8::EpiSwiGLU E{(unsigned char*)(ws + WS_H), rl};
    pg8::gemm_phase<pg8::EpiSwiGLU, pg8::MoeUpOrder, true, true, true>(F.lds, il, (const void*)(ws + WS_XN8), D, S, E);
}
DI void moe_down_phase(Frame& F, unsigned char* ws, int l) {
    pg8::MoeDownOrder S{F.vcu, F.G, (const char*)(ws + WS_W2 + (size_t)l * W2_LAYER)};
    pg8::EpiFp8 E{ws + WS_Y, D, (const float*)(ws + WS_GATE), 0.03125f * YS8};
    pg8::gemm_phase<pg8::EpiFp8, pg8::MoeDownOrder, false, true, true>(F.lds, nullptr, (const void*)(ws + WS_H), DE, S, E);
}

DI int off128r(int row, int chunk) { return row * 128 + ((chunk ^ ((row >> 1) & 7)) << 4); }
DI int off128t(int row, int colbyte) { return row * 128 + (colbyte ^ (((row >> 1) & 1) << 6)); }
DI int off256t(int row, int colbyte) { return row * 256 + (colbyte ^ ((row & 3) << 6)); }
DI float wave_max(float v) {
#pragma unroll
    for (int o = 1; o < 64; o <<= 1) v = fmaxf(v, __shfl_xor(v, o));
    return v;
}
DI float incl_prefix(float v, int lane) {
#pragma unroll
    for (int o = 1; o < 64; o <<= 1) { const float t = __shfl_up(v, o); if (lane >= o) v += t; }
    return v;
}
DI float incl_suffix(float v, int lane) {
#pragma unroll
    for (int o = 1; o < 64; o <<= 1) { const float t = __shfl_down(v, o); if (lane + o < 64) v += t; }
    return v;
}
DI u32x4 scale_bf16x8(u32x4 v, float w) {
    u32x4 o;
#pragma unroll
    for (int i = 0; i < 4; ++i) { const float lo = __builtin_bit_cast(float, v[i] << 16) * w, hi = __builtin_bit_cast(float, v[i] & 0xffff0000u) * w; o[i] = cvt_pk_bf16(lo, hi); }
    return o;
}
constexpr int SS_KW = 0, SS_V = 32768, SS_WS = 98304, SS_SC = 114688;
DI int ss_kw_off(int row, int colbyte) { return row * 128 + (colbyte ^ ((((row >> 1) & 1) | (((row >> 3) & 1) << 1)) << 5)); }
DI int ss_v_off(int row, int colbyte) { return row * 256 + (colbyte ^ ((row & 3) << 6) ^ (((row >> 3) & 1) << 5)); }
template <int ES> DI void mlstm_scan_seq(Frame& F, unsigned char* ws, int seq, int half) {
    static_assert(ES == 2, "the fp8 v tile staging is written for two workgroups per sequence");
    constexpr int NT = 4 / ES, VB = 16384 / ES; const int eoff = half * (128 / ES); const unsigned char* PV = ws + WS_PVO;
    LAS unsigned char* lds = F.lds;
    const bf16_t* P = (const bf16_t*)(ws + WS_PROJ); const float* MG = (const float*)(ws + WS_MG);
    bf16_t* STATE = (bf16_t*)(ws + WS_STATE); float* NST = (float*)(ws + WS_NST); float* MST = (float*)(ws + WS_MST);
    const int tid = F.tid, lane = F.lane, wave = F.wave, fr = lane & 15, fq = lane >> 4;
    LAS float* WS = (LAS float*)(lds + SS_WS); LAS float* ML = (LAS float*)(lds + SS_SC); LAS float* BL = ML + 64; LAS float* DEC = ML + 128; LAS float* LINJ = ML + 192; LAS float* MENT = ML + 256;
    {
        const int dir = seq >> 5, bh = seq & 31, b = bh >> 3, hd = bh & 7;
        __syncthreads();
        float igv[8], lfv[8];
#pragma unroll
        for (int i = 0; i < 8; ++i) { const float* mg = MG + ((size_t)b * SEQ + 64 * (8 * wave + i) + lane) * 32 + hd; igv[i] = mg[dir ? 16 : 0]; lfv[i] = mg[dir ? 24 : 8]; }
#pragma unroll
        for (int i = 0; i < 8; ++i) { const int c = 8 * wave + i; const float ig = igv[i], lf = lfv[i];
            float g, bl;
            if (dir == 0) { const float bf = incl_prefix(lf, lane); bl = __shfl(bf, 63); g = bl - bf + ig; }
            else { const float sb = incl_suffix(lf, lane); bl = __shfl(sb, 0); g = (bl - sb) + ig; }
            const float ml = wave_max(g);
            WS[c * 64 + lane] = g - ml; if (lane == 0) { ML[c] = ml; BL[c] = bl; } }
        __syncthreads();
        if (wave == 0) { const int cl = dir ? 63 - lane : lane; const float mlv = ML[cl], blv = BL[cl];
            float m = 0.f, dec = 0.f, linj = 0.f, ment = 0.f;
            for (int k = 0; k < 64; ++k) { const float ml = __shfl(mlv, k), bl = __shfl(blv, k); const float mn = fmaxf(bl + m, ml);
                if (lane == k) { dec = __expf(bl + m - mn); linj = ml - mn; ment = m; } m = mn; }
            DEC[lane] = dec; LINJ[cl] = linj; MENT[lane] = ment;
            if (half == 0) MST[(size_t)seq * 64 + cl] = ment; }
        __syncthreads();
#pragma unroll
        for (int i = 0; i < 8; ++i) { const int idx = tid + i * NTHR; WS[idx] = __expf(WS[idx] + LINJ[idx >> 6]); }
        const int krow = tid >> 3, kc = tid & 7;
        const int eh = wave >> 2, dt = wave & 3;
        f32x4 C[NT], Nacc = (f32x4){0.f, 0.f, 0.f, 0.f};
#pragma unroll
        for (int i = 0; i < NT; ++i) C[i] = (f32x4){0.f, 0.f, 0.f, 0.f};
        const bf16x8 ones = (bf16x8){0x3f80, 0x3f80, 0x3f80, 0x3f80, 0x3f80, 0x3f80, 0x3f80, 0x3f80};
        const size_t tokb = (size_t)b * SEQ;
        u32x4 kreg[2][2], vreg[2][2][2 / ES];
#define SS_LOAD(st_, kp_) do { _Pragma("unroll") for (int sb_ = 0; sb_ < 2; ++sb_) { const int kk_ = 2 * (kp_) + sb_; const int cn_ = dir ? 63 - kk_ : kk_; \
            kreg[st_][sb_] = *(const u32x4*)(P + (tokb + 64 * cn_ + krow) * MIN_N + 512 + hd * 64 + kc * 8); \
            vreg[st_][sb_][0] = *(const u32x4*)(PV + (tokb + 64 * cn_ + ((tid & 255) >> 2)) * 2048 + hd * 128 + eoff + (tid & 3) * 16); } } while (0)
#define SS_PAIR(st, kp) do { const int buf = (kp) & 1; \
            _Pragma("unroll") for (int sb = 0; sb < 2; ++sb) { const int k = 2 * (kp) + sb, c = dir ? 63 - k : k; \
                *(LAS u32x4*)(lds + SS_KW + (buf * 2 + sb) * 8192 + ss_kw_off(krow, kc * 16)) = scale_bf16x8(kreg[st][sb], WS[c * 64 + krow]); \
                if (tid < 256) { u32x4 v0_, v1_; fp8x16_to_bf16(vreg[st][sb][0], v0_, v1_); const int vr = tid >> 2, vc2 = 2 * (tid & 3); \
                    *(LAS u32x4*)(lds + SS_V + (buf * 2 + sb) * VB + ss_kw_off(vr, vc2 * 16)) = v0_; *(LAS u32x4*)(lds + SS_V + (buf * 2 + sb) * VB + ss_kw_off(vr, (vc2 + 1) * 16)) = v1_; } } \
            if ((kp) + 2 < 32) SS_LOAD(st, (kp) + 2); \
            asm volatile("s_waitcnt lgkmcnt(0)" ::: "memory"); __builtin_amdgcn_s_barrier(); asm volatile("" ::: "memory"); \
            _Pragma("unroll") for (int sb = 0; sb < 2; ++sb) { const int k = 2 * (kp) + sb, c = dir ? 63 - k : k; \
                _Pragma("unroll") for (int i = 0; i < NT; ++i) { u32x2 w; w.x = cvt_pk_bf16(C[i].x, C[i].y); w.y = cvt_pk_bf16(C[i].z, C[i].w); \
                    *(u32x2*)(STATE + ((size_t)seq * 64 + c) * 8192 + (size_t)(eoff + 16 * (eh + 2 * i) + fr) * 64 + 16 * dt + 4 * fq) = w; } \
                if (half == 0 && eh == 0 && fr == 0) *(f32x4*)(NST + ((size_t)seq * 64 + c) * 64 + 16 * dt + 4 * fq) = Nacc; \
                const float dec = DEC[k]; Nacc = Nacc * dec; \
                _Pragma("unroll") for (int i = 0; i < NT; ++i) C[i] = C[i] * dec; \
                _Pragma("unroll") for (int s2 = 0; s2 < 2; ++s2) { \
                    const int r0 = 32 * s2 + 8 * fq + ((lane & 15) >> 2), r1 = r0 + 4, cbk = 32 * dt + 8 * (lane & 3); \
                    const bf16x8 af = cat8(tr_read(lds + SS_KW + (buf * 2 + sb) * 8192 + ss_kw_off(r0, cbk)), tr_read(lds + SS_KW + (buf * 2 + sb) * 8192 + ss_kw_off(r1, cbk))); \
                    _Pragma("unroll") for (int i = 0; i < NT; ++i) { const int cbv = 32 * (eh + 2 * i) + 8 * (lane & 3); \
                        const bf16x8 bfv = cat8(tr_read(lds + SS_V + (buf * 2 + sb) * VB + (ES == 1 ? ss_v_off(r0, cbv) : ss_kw_off(r0, cbv))), tr_read(lds + SS_V + (buf * 2 + sb) * VB + (ES == 1 ? ss_v_off(r1, cbv) : ss_kw_off(r1, cbv)))); \
                        C[i] = __builtin_amdgcn_mfma_f32_16x16x32_bf16(af, bfv, C[i], 0, 0, 0); } \
                    if (eh == 0) Nacc = __builtin_amdgcn_mfma_f32_16x16x32_bf16(af, ones, Nacc, 0, 0, 0); } } } while (0)
        SS_LOAD(0, 0); SS_LOAD(1, 1);
        __syncthreads();
#pragma unroll 1
        for (int kp2 = 0; kp2 < 32; kp2 += 2) { SS_PAIR(0, kp2); SS_PAIR(1, kp2 + 1); }
#undef SS_PAIR
#undef SS_LOAD
    }
}
constexpr int SCAN_ES = 2, SCAN_WGS = 64 * SCAN_ES, SCAN_STRIDE = 256 / SCAN_WGS;
DI void mlstm_scan_phase(Frame& F, const Args& a) {
    if (F.G == 256) {
        if (F.vcu % SCAN_STRIDE == 0) { const int sw = F.vcu / SCAN_STRIDE; mlstm_scan_seq<SCAN_ES>(F, a.ws, sw / SCAN_ES, sw % SCAN_ES); }
        else expert_conv_items(F, a, XI_C_END, XI_TOTAL, ((F.vcu / SCAN_STRIDE) * (SCAN_STRIDE - 1) + F.vcu % SCAN_STRIDE - 1) * NWAVES + F.wave, (256 - SCAN_WGS) * NWAVES);
    } else {
        for (int sw = F.vcu; sw < SCAN_WGS; sw += F.G) mlstm_scan_seq<SCAN_ES>(F, a.ws, sw / SCAN_ES, sw % SCAN_ES);
        if (F.vcu == 0) expert_conv_items(F, a, XI_C_END, XI_TOTAL, F.wave, NWAVES);
    }
}
constexpr int S3_Q = 0, S3_KF = 8192, S3_KB = 16384, S3_V = 24576, S3_CF = 40960, S3_CB = 57344, S3_HS = 73728, S3_HS_LD = 132, S3_SM = 108544;
DI float incl_prefix_max(float v, int lane) {
#pragma unroll
    for (int o = 1; o < 64; o <<= 1) { const float t = __shfl_up(v, o); if (lane >= o) v = fmaxf(v, t); }
    return v;
}
DI float incl_suffix_max(float v, int lane) {
#pragma unroll
    for (int o = 1; o < 64; o <<= 1) { const float t = __shfl_down(v, o); if (lane + o < 64) v = fmaxf(v, t); }
    return v;
}
DI void mlstm_s3_phase(Frame& F, const Args& a) {
    unsigned char* ws = a.ws; LAS unsigned char* lds = F.lds;
    const bf16_t* P = (const bf16_t*)(ws + WS_PROJ); const float* MG = (const float*)(ws + WS_MG);
    const bf16_t* STATE = (const bf16_t*)(ws + WS_STATE); const float* NST = (const float*)(ws + WS_NST); const float* MST = (const float*)(ws + WS_MST);
    bf16_t* Y2 = (bf16_t*)(ws + WS_Y2); const float* outg = a.in[IN_MOG];
    const int tid = F.tid, lane = F.lane, wave = F.wave, r = lane & 31, h = lane >> 5;
    const int q4 = (lane & 15) >> 2, p4 = lane & 3, blk = (lane >> 4) & 1;
    LAS float* ALPHA = (LAS float*)(lds + S3_SM); LAS float* EA = ALPHA + 128; LAS float* EMT = ALPHA + 256; LAS unsigned short* NB16 = (LAS unsigned short*)(ALPHA + 384);
    LAS float* HS = (LAS float*)(lds + S3_HS);
    const unsigned char* PV = ws + WS_PVO;
    u32x4 rq, rk, rv, rcf[2], rcb[2], rog; float pg[4], pn[2], pm_f = 0.f, pm_b = 0.f;
#define S3_LOAD(u_) do { const int c_ = (u_) & 63, bh_ = (u_) >> 6, b_ = bh_ >> 3, hd_ = bh_ & 7; const size_t tk_ = (size_t)b_ * SEQ + 64 * c_; \
        { const int row = tid >> 3, kc = tid & 7; rq = *(const u32x4*)(P + (tk_ + row) * MIN_N + hd_ * 64 + kc * 8); rk = *(const u32x4*)(P + (tk_ + row) * MIN_N + 512 + hd_ * 64 + kc * 8); } \
        rv = *(const u32x4*)(PV + (tk_ + (tid >> 3)) * 2048 + hd_ * 128 + (tid & 7) * 16); \
        _Pragma("unroll") for (int i = 0; i < 2; ++i) { const int idx = tid + i * NTHR; \
            rcf[i] = __builtin_nontemporal_load((const u32x4*)(STATE + ((size_t)(0 * 32 + bh_) * 64 + c_) * 8192) + idx); rcb[i] = __builtin_nontemporal_load((const u32x4*)(STATE + ((size_t)(1 * 32 + bh_) * 64 + c_) * 8192) + idx); } \
        rog = *(const u32x4*)(PV + (tk_ + (tid >> 3)) * 2048 + 1024 + hd_ * 128 + (tid & 7) * 16); \
        pm_f = MST[(size_t)(0 * 32 + bh_) * 64 + c_]; pm_b = MST[(size_t)(1 * 32 + bh_) * 64 + c_]; \
        { const float* mg = MG + (tk_ + lane) * 32; pg[0] = mg[hd_]; pg[1] = mg[8 + hd_]; pg[2] = mg[16 + hd_]; pg[3] = mg[24 + hd_]; \
          pn[0] = NST[((size_t)(0 * 32 + bh_) * 64 + c_) * 64 + lane]; pn[1] = NST[((size_t)(1 * 32 + bh_) * 64 + c_) * 64 + lane]; } } while (0)
    if (F.vcu < 2048) S3_LOAD(F.vcu);
    for (int u = F.vcu; u < 2048; u += F.G) {
        const int c = u & 63, bh = u >> 6, b = bh >> 3, hd = bh & 7; const size_t tok0 = (size_t)b * SEQ + 64 * c;
        const float m_f = pm_f, m_b = pm_b;
        const float bf = incl_prefix(pg[1], lane), uf = pg[0] - bf, umf = wave_max(uf), cmf = incl_prefix_max(uf, lane);
        const float sb = incl_suffix(pg[3], lane), ub = pg[2] - sb, umb = wave_max(ub), cmb = incl_suffix_max(ub, lane);
        const float beta_f = __expf(uf - umf), beta_b = __expf(ub - umb);
        const float af_ = bf + m_f, mtf = fmaxf(af_, bf + cmf), ab_ = sb + m_b, mtb = fmaxf(ab_, sb + cmb);
        __syncthreads();
        if (wave == 0) { ALPHA[lane] = __expf(bf + umf - mtf); EA[lane] = __expf(af_ - mtf); EMT[lane] = __expf(-mtf);
            ALPHA[64 + lane] = __expf(sb + umb - mtb); EA[64 + lane] = __expf(ab_ - mtb); EMT[64 + lane] = __expf(-mtb);
            NB16[lane] = (unsigned short)f2bf(pn[0]); NB16[64 + lane] = (unsigned short)f2bf(pn[1]); }
        { const int row = tid >> 3, kc = tid & 7; const float wf = __shfl(beta_f, row & 63), wb = __shfl(beta_b, row & 63);
          *(LAS u32x4*)(lds + S3_Q + off128r(row, kc)) = rq;
          *(LAS u32x4*)(lds + S3_KF + off128r(row, kc)) = scale_bf16x8(rk, wf); *(LAS u32x4*)(lds + S3_KB + off128r(row, kc)) = scale_bf16x8(rk, wb); }
#pragma unroll
        for (int i = 0; i < 2; ++i) { const int idx = tid + i * NTHR, erow = idx >> 3, ec = idx & 7;
            *(LAS u32x4*)(lds + S3_CF + off128r(erow, ec)) = rcf[i]; *(LAS u32x4*)(lds + S3_CB + off128r(erow, ec)) = rcb[i]; }
        { u32x4 v0_, v1_; fp8x16_to_bf16(rv, v0_, v1_); const int vr = tid >> 3, vc2 = 2 * (tid & 7);
          *(LAS u32x4*)(lds + S3_V + off256t(vr, vc2 * 16)) = v0_; *(LAS u32x4*)(lds + S3_V + off256t(vr, (vc2 + 1) * 16)) = v1_; }
        u32x4 og0, og1; fp8x16_to_bf16(rog, og0, og1);
        if (u + F.G < 2048) S3_LOAD(u + F.G);
        __syncthreads();
        const int et = wave >> 1, tt = wave & 1, t = 32 * tt + r;
        bf16x8 qf[4];
#pragma unroll
        for (int s4 = 0; s4 < 4; ++s4) qf[s4] = *(const LAS bf16x8*)(lds + S3_Q + off128r(t, 2 * s4 + h));
        f32x16 pF, pB, pO;
#pragma unroll
        for (int i = 0; i < 16; ++i) { pF[i] = 0.f; pB[i] = 0.f; pO[i] = 0.f; }
        const int so = 1 - tt; const int koff = tt == 0 ? S3_KB : S3_KF;
#pragma unroll
        for (int s4 = 0; s4 < 4; ++s4) {
            const bf16x8 kF = *(const LAS bf16x8*)(lds + S3_KF + off128r(32 * tt + r, 2 * s4 + h)), kB = *(const LAS bf16x8*)(lds + S3_KB + off128r(32 * tt + r, 2 * s4 + h));
            const bf16x8 kO = *(const LAS bf16x8*)(lds + koff + off128r(32 * so + r, 2 * s4 + h));
            pF = __builtin_amdgcn_mfma_f32_32x32x16_bf16(kF, qf[s4], pF, 0, 0, 0);
            pB = __builtin_amdgcn_mfma_f32_32x32x16_bf16(kB, qf[s4], pB, 0, 0, 0);
            pO = __builtin_amdgcn_mfma_f32_32x32x16_bf16(kO, qf[s4], pO, 0, 0, 0);
        }
        float rsF = 0.f, rsB = 0.f, rsO = 0.f;
#pragma unroll
        for (int i = 0; i < 16; ++i) { const int sl_ = (i & 3) + 8 * (i >> 2) + 4 * h;
            pF[i] = sl_ <= r ? pF[i] : 0.f; pB[i] = sl_ >= r ? pB[i] : 0.f; rsF += pF[i]; rsB += pB[i]; rsO += pO[i]; }
        rsF += __shfl_xor(rsF, 32); rsB += __shfl_xor(rsB, 32); rsO += __shfl_xor(rsO, 32);
        if (tt == 0) rsB += rsO; else rsF += rsO;
        asm volatile("" ::: "memory");
        float qnf, qnb;
        {   f32x16 qn;
#pragma unroll
            for (int i = 0; i < 16; ++i) qn[i] = 0.f;
#pragma unroll
            for (int s4 = 0; s4 < 4; ++s4) { const bf16x8 nF = *(const LAS bf16x8*)(NB16 + 16 * s4 + 8 * h); qn = __builtin_amdgcn_mfma_f32_32x32x16_bf16(nF, qf[s4], qn, 0, 0, 0); }
            qnf = qn[0];
#pragma unroll
            for (int i = 0; i < 16; ++i) qn[i] = 0.f;
#pragma unroll
            for (int s4 = 0; s4 < 4; ++s4) { const bf16x8 nB = *(const LAS bf16x8*)(NB16 + 64 + 16 * s4 + 8 * h); qn = __builtin_amdgcn_mfma_f32_32x32x16_bf16(nB, qf[s4], qn, 0, 0, 0); }
            qnb = qn[0]; }
        const float alF = ALPHA[t], eaF = EA[t], emF = EMT[t], alB = ALPHA[64 + t], eaB = EA[64 + t], emB = EMT[64 + t];
        const float invF = 1.f / fmaxf(fabsf(eaF * qnf + alF * rsF), emF), invB = 1.f / fmaxf(fabsf(eaB * qnb + alB * rsB), emB);
        asm volatile("" ::: "memory");
        f32x16 hs;
        const int cbv = 64 * et + 32 * blk + 8 * p4;
        {   f32x16 it, in;
#pragma unroll
            for (int i = 0; i < 16; ++i) { it[i] = 0.f; in[i] = 0.f; }
#pragma unroll
            for (int s4 = 0; s4 < 4; ++s4) { const bf16x8 cF = *(const LAS bf16x8*)(lds + S3_CF + off128r(32 * et + r, 2 * s4 + h)); it = __builtin_amdgcn_mfma_f32_32x32x16_bf16(cF, qf[s4], it, 0, 0, 0); }
#pragma unroll
            for (int s2 = 0; s2 < 2; ++s2) { const int rd0 = 32 * tt + 16 * s2 + 4 * h + q4;
                const bf16x8 vD = cat8(tr_read(lds + S3_V + off256t(rd0, cbv)), tr_read(lds + S3_V + off256t(rd0 + 8, cbv)));
                in = __builtin_amdgcn_mfma_f32_32x32x16_bf16(vD, pack_step(pF, s2), in, 0, 0, 0);
                if (tt == 1) { const int ro0 = 16 * s2 + 4 * h + q4; const bf16x8 vO = cat8(tr_read(lds + S3_V + off256t(ro0, cbv)), tr_read(lds + S3_V + off256t(ro0 + 8, cbv)));
                    in = __builtin_amdgcn_mfma_f32_32x32x16_bf16(vO, pack_step(pO, s2), in, 0, 0, 0); } }
#pragma unroll
            for (int i = 0; i < 16; ++i) hs[i] = (eaF * it[i] + alF * in[i]) * invF;
        }
        asm volatile("" ::: "memory");
        {   f32x16 it, in;
#pragma unroll
            for (int i = 0; i < 16; ++i) { it[i] = 0.f; in[i] = 0.f; }
#pragma unroll
            for (int s4 = 0; s4 < 4; ++s4) { const bf16x8 cB = *(const LAS bf16x8*)(lds + S3_CB + off128r(32 * et + r, 2 * s4 + h)); it = __builtin_amdgcn_mfma_f32_32x32x16_bf16(cB, qf[s4], it, 0, 0, 0); }
#pragma unroll
            for (int s2 = 0; s2 < 2; ++s2) { const int rd0 = 32 * tt + 16 * s2 + 4 * h + q4;
                const bf16x8 vD = cat8(tr_read(lds + S3_V + off256t(rd0, cbv)), tr_read(lds + S3_V + off256t(rd0 + 8, cbv)));
                in = __builtin_amdgcn_mfma_f32_32x32x16_bf16(vD, pack_step(pB, s2), in, 0, 0, 0);
                if (tt == 0) { const int ro0 = 32 + 16 * s2 + 4 * h + q4; const bf16x8 vO = cat8(tr_read(lds + S3_V + off256t(ro0, cbv)), tr_read(lds + S3_V + off256t(ro0 + 8, cbv)));
                    in = __builtin_amdgcn_mfma_f32_32x32x16_bf16(vO, pack_step(pO, s2), in, 0, 0, 0); } }
#pragma unroll
            for (int i = 0; i < 16; ++i) hs[i] += (eaB * it[i] + alB * in[i]) * invB;
        }
#pragma unroll
        for (int i = 0; i < 16; ++i) HS[t * S3_HS_LD + 32 * et + (i & 3) + 8 * (i >> 2) + 4 * h] = hs[i];
        __syncthreads();
        { const int tr = tid >> 3, e0 = (tid & 7) * 16; float vv[16]; float ss = 0.f;
#pragma unroll
          for (int i = 0; i < 4; ++i) { const f32x4 x = *(const LAS f32x4*)(HS + tr * S3_HS_LD + e0 + 4 * i); vv[4 * i] = x[0]; vv[4 * i + 1] = x[1]; vv[4 * i + 2] = x[2]; vv[4 * i + 3] = x[3]; ss += (x[0] * x[0] + x[1] * x[1]) + (x[2] * x[2] + x[3] * x[3]); }
          ss += __shfl_xor(ss, 1); ss += __shfl_xor(ss, 2); ss += __shfl_xor(ss, 4);
          const float rinv = __builtin_amdgcn_rsqf(ss * (1.f / 128.f) + RMS_EPS);
          unsigned ow[8];
#pragma unroll
          for (int i = 0; i < 8; ++i) { const unsigned w = i < 4 ? og0[i] : og1[i - 4];
              const float o0 = __builtin_bit_cast(float, w << 16), o1 = __builtin_bit_cast(float, w & 0xffff0000u);
              const float g0 = outg[hd * 128 + e0 + 2 * i], g1 = outg[hd * 128 + e0 + 2 * i + 1];
              const float y0 = vv[2 * i] * rinv * g0 / (1.f + __expf(-o0)), y1 = vv[2 * i + 1] * rinv * g1 / (1.f + __expf(-o1));
              ow[i] = cvt_pk_bf16(y0, y1); }
          bf16_t* yp = Y2 + (tok0 + tr) * D + hd * 128 + e0;
          *(u32x4*)yp = (u32x4){ow[0], ow[1], ow[2], ow[3]}; *(u32x4*)(yp + 8) = (u32x4){ow[4], ow[5], ow[6], ow[7]}; }
    }
#undef S3_LOAD
}

__global__ void __launch_bounds__(NTHR, 2) fwd_kernel(Args args) {
    extern __shared__ __attribute__((aligned(16))) unsigned char lds_raw[];
    Frame F;
    F.lds = (LAS unsigned char*)lds_raw;
    F.MISC = (volatile LAS unsigned*)(F.lds + MISC_OFF);
    F.tid = threadIdx.x; F.lane = F.tid & 63; F.wave = __builtin_amdgcn_readfirstlane(F.tid >> 6);
    F.G = gridDim.x; { const int bx = blockIdx.x; F.vcu = (F.G % 8 == 0) ? (bx % 8) * (F.G / 8) + bx / 8 : bx; }
    F.ctl = (unsigned*)(args.ws + WS_CTL);
    if (F.tid < 64) F.MISC[F.tid] = 0u;
    __syncthreads();
    XcdBarrier bar = xcd_barrier_post(F.ctl + CW_BAR, F.MISC + 8);
    const int lo = args.ph_lo, hi = args.ph_hi;
    unsigned char* ws = args.ws;
#define IN(k) (lo <= (k) && (k) < hi)
#define SEAM(k) do { if (IN(k) && IN((k) + 1)) xcd_barrier(bar); } while (0)

    if (IN(0)) { p0_prologue(F, args); } SEAM(0);
    if (IN(1)) {
        pg8::DenseOrder8 S; S.init(M, NQKV, F.G, (int)blockIdx.x, (const bf16_t*)(ws + WS_WQKV), D);
        pg8::EpiQKV E{(bf16_t*)(ws + WS_Q), (bf16_t*)(ws + WS_K), (bf16_t*)(ws + WS_V), args.in[IN_AQG], args.in[IN_AKG]};
        pg8::gemm_phase<pg8::EpiQKV, pg8::DenseOrder8, false, true, true>(F.lds, nullptr, (const void*)(ws + WS_XN8), D, S, E);
        if ((int)blockIdx.x >= 128 && F.G == 256) expert_conv_items(F, args, XI_PRO_END, XI_A_END, ((int)blockIdx.x - 128) * NWAVES + F.wave, 128 * NWAVES);
        else if (F.G != 256 && (int)blockIdx.x == 0) expert_conv_items(F, args, XI_PRO_END, XI_A_END, F.wave, NWAVES);
    } SEAM(1);
    if (IN(2)) { attn_phase(F, args); } SEAM(2);
    if (IN(3)) {
        pg8::DenseOrder8 S; S.init(M, D, F.G, (int)blockIdx.x, (const bf16_t*)(ws + WS_WAO), D);
        if (F.G == 256) { pg8::EpiResRoute<false> E{args.in[IN_X], (bf16_t*)(ws + WS_X1), ws + WS_XN8, (float*)(ws + WS_PART), args.in[IN_FNG], args.in[IN_RW], 1.f / 256.f};
            pg8::gemm_phase<pg8::EpiResRoute<false>, pg8::DenseOrder8, false, false, true>(F.lds, nullptr, (const void*)(ws + WS_O), D, S, E); }
        else { pg8::EpiRes<false, true> E{args.in[IN_X], (void*)(ws + WS_X1), D, 1.f / 256.f};
            pg8::gemm_phase<pg8::EpiRes<false, true>, pg8::DenseOrder8, false, false, true>(F.lds, nullptr, (const void*)(ws + WS_O), D, S, E); }
    } SEAM(3);
    if (IN(4) && F.G != 256) { nr_phase<16, false>(F, (const bf16_t*)(ws + WS_X1), nullptr, nullptr, nullptr, args.in[IN_FNG], nullptr, (unsigned char*)(ws + WS_XN8), args.in[IN_RW], NE, 0, (float*)(ws + WS_PART), nullptr, nullptr); }
    if (F.G != 256) SEAM(4);
    if (IN(5)) { topk_phase(F, (const float*)(ws + WS_PART), (int*)(ws + WS_IDX), (float*)(ws + WS_GATE), (float*)(ws + WS_RSC), (int*)(ws + WS_SLOT));
        if ((int)blockIdx.x >= 64) expert_conv_items(F, args, XI_A_END, XI_B_END, ((int)blockIdx.x - 64) * NWAVES + F.wave, (F.G - 64) * NWAVES); } SEAM(5);
    if (IN(6)) { moe_up_phase(F, ws, 0); } SEAM(6);
    if (IN(7)) { moe_down_phase(F, ws, 0); } SEAM(7);
    if (IN(8)) { nrm_phase(F, (const bf16_t*)(ws + WS_X1), (const unsigned char*)(ws + WS_Y), (const int*)(ws + WS_SLOT), (bf16_t*)(ws + WS_X2), args.in[IN_MNG], (bf16_t*)(ws + WS_XN), ws + WS_XN8,
                           args.in[IN_MWIN], MIN_LD, MIN_N, (float*)(ws + WS_MG), args.in[IN_MBI], args.in[IN_MBF]); } SEAM(8);
    if (IN(9)) {
        { pg8::DenseOrder S; S.init(M, 1024, F.G, (int)blockIdx.x, (const bf16_t*)(ws + WS_WMIN), D);
          pg8::EpiBf16 E{(bf16_t*)(ws + WS_PROJ), MIN_N, nullptr, 1.f, 0};
          pg8::gemm_phase<pg8::EpiBf16, pg8::DenseOrder, false, true, false>(F.lds, nullptr, (const bf16_t*)(ws + WS_XN), D, S, E); }
        { pg8::DenseOrder8 S; S.init(M, 2048, F.G, (int)blockIdx.x, (const bf16_t*)(ws + WS_WMIN8), D);
          pg8::EpiFp8 E{ws + WS_PVO, 2048, nullptr, 0.0625f};
          pg8::gemm_phase<pg8::EpiFp8, pg8::DenseOrder8, false, true, true>(F.lds, nullptr, (const void*)(ws + WS_XN8), D, S, E); }
    } SEAM(9);
    if (IN(10)) { mlstm_scan_phase(F, args); } SEAM(10);
    if (IN(12)) { mlstm_s3_phase(F, args); } SEAM(12);
    if (IN(13)) {
        pg8::DenseOrder S; S.init(M, D, F.G, (int)blockIdx.x, (const bf16_t*)(ws + WS_WMO), D);
        if (F.G == 256) { pg8::EpiResRoute<true> E{(const void*)(ws + WS_X2), (bf16_t*)(ws + WS_X3), ws + WS_XN8, (float*)(ws + WS_PART), args.in[IN_FNG] + D, args.in[IN_RW] + D * NE, 1.f};
            pg8::gemm_phase<pg8::EpiResRoute<true>, pg8::DenseOrder, false, false, false>(F.lds, nullptr, (const bf16_t*)(ws + WS_Y2), D, S, E); }
        else { pg8::EpiRes<true, true> E{(const void*)(ws + WS_X2), (void*)(ws + WS_X3), D, 1.f};
            pg8::gemm_phase<pg8::EpiRes<true, true>, pg8::DenseOrder, false, false, false>(F.lds, nullptr, (const bf16_t*)(ws + WS_Y2), D, S, E); }
    } SEAM(13);
    if (IN(14) && F.G != 256) { nr_phase<16, false>(F, (const bf16_t*)(ws + WS_X3), nullptr, nullptr, nullptr, args.in[IN_FNG] + D, nullptr, (unsigned char*)(ws + WS_XN8), args.in[IN_RW] + D * NE, NE, 0, (float*)(ws + WS_PART), nullptr, nullptr); }
    if (F.G != 256) SEAM(14);
    if (IN(15)) { topk_phase(F, (const float*)(ws + WS_PART), (int*)(ws + WS_IDX), (float*)(ws + WS_GATE), (float*)(ws + WS_RSC), (int*)(ws + WS_SLOT));
        if ((int)blockIdx.x >= 64) expert_conv_items(F, args, XI_C_END - XI_NC, XI_C_END, ((int)blockIdx.x - 64) * NWAVES + F.wave, (F.G - 64) * NWAVES); } SEAM(15);
    if (IN(16)) { moe_up_phase(F, ws, 1); } SEAM(16);
    if (IN(17)) { moe_down_phase(F, ws, 1); } SEAM(17);
    if (IN(18)) { combine_phase(F, (const bf16_t*)(ws + WS_X3), (const unsigned char*)(ws + WS_Y), (const int*)(ws + WS_SLOT), args.out); }
#undef IN
#undef SEAM
}

extern "C" void kernel_launch(void* const* d_in, const int* in_sizes, int n_in, void* d_out, int out_size, void* d_ws, size_t ws_size, hipStream_t stream) {
    static int grid = 0;
    if (grid == 0) {
        if (n_in != 19 || out_size != M * D || ws_size < WS_END) { fprintf(stderr, "kernel_launch: unexpected problem (n_in %d, out %d, ws %zu)\n", n_in, out_size, ws_size); grid = -1; return; }
        int dev = 0, cus = 0, per_cu = 0;
        if (hipGetDevice(&dev) != hipSuccess || hipDeviceGetAttribute(&cus, hipDeviceAttributeMultiprocessorCount, dev) != hipSuccess) { grid = -1; return; }
        if (hipFuncSetAttribute((const void*)fwd_kernel, hipFuncAttributeMaxDynamicSharedMemorySize, LDS_BYTES) != hipSuccess) { fprintf(stderr, "kernel_launch: hipFuncSetAttribute failed\n"); grid = -1; return; }
        if (hipOccupancyMaxActiveBlocksPerMultiprocessor(&per_cu, (const void*)fwd_kernel, NTHR, LDS_BYTES) != hipSuccess || per_cu < 1) fprintf(stderr, "kernel_launch: occupancy query reports %d\n", per_cu);
        (void)hipGetLastError();
        grid = cus;
    }
    if (grid < 0) return;
    if (hipMemsetAsync((char*)d_ws + WS_CTL, 0, CTL_ZERO_BYTES, stream) != hipSuccess) return;
    Args a{};
    for (int i = 0; i < 19; ++i) a.in[i] = (const float*)d_in[i];
    a.out = (float*)d_out; a.ws = (unsigned char*)d_ws; a.ph_lo = 0; a.ph_hi = 19;
#ifndef EXP_LO
    hipLaunchKernelGGL(fwd_kernel, dim3(grid), dim3(NTHR), LDS_BYTES, stream, a);
#else
    a.ph_lo = 0; a.ph_hi = EXP_HI; hipLaunchKernelGGL(fwd_kernel, dim3(grid), dim3(NTHR), LDS_BYTES, stream, a);
    hipMemsetAsync((char*)d_ws + WS_CTL, 0, CTL_ZERO_BYTES, stream);
    a.ph_lo = EXP_LO; a.ph_hi = 19; hipLaunchKernelGGL(fwd_kernel, dim3(grid), dim3(NTHR), LDS_BYTES, stream, a);
#endif
}
```

```cpp
#include <hip/hip_runtime.h>
#include <cstdio>
#include <cstdint>

#define GAS __attribute__((address_space(1)))
#define LAS __attribute__((address_space(3)))
typedef unsigned short bf16_t;
typedef short bf16x8 __attribute__((ext_vector_type(8)));
typedef short s16x4 __attribute__((ext_vector_type(4)));
typedef float f32x4 __attribute__((ext_vector_type(4)));
typedef float f32x2 __attribute__((ext_vector_type(2)));
typedef float f32x16 __attribute__((ext_vector_type(16)));
typedef unsigned u32x4 __attribute__((ext_vector_type(4)));
typedef unsigned u32x2 __attribute__((ext_vector_type(2)));
typedef int i32x4 __attribute__((ext_vector_type(4)));
typedef int i32x8 __attribute__((ext_vector_type(8)));
#define LDS_WAIT() asm volatile("s_waitcnt lgkmcnt(0)" ::: "memory")
#define VM_WAIT() asm volatile("s_waitcnt vmcnt(0)" ::: "memory")
#define DI __device__ __forceinline__

constexpr int NB = 4, SEQ = 4096, D = 1024, M = NB * SEQ;
constexpr int NQKV = 1536;
constexpr int MIN_N = 3072, MIN_LD = 3104;
constexpr int NE = 16, CAP = 512, DE = 2048, MROWS = NB * NE * CAP;
constexpr float RMS_EPS = 1e-6f, LOG2E = 1.4426950408889634f, YS8 = 64.f;
constexpr int NWAVES = 8, NTHR = 512;

constexpr size_t MiB = 1u << 20;
constexpr size_t WS_CTL = 0, CTL_ZERO_BYTES = 1 * MiB;
constexpr size_t WS_WQKV = 2 * MiB, WS_WAO = 6 * MiB, WS_WMIN = 8 * MiB, WS_WMIN8 = 11 * MiB, WS_WMO = 14 * MiB;
constexpr size_t WS_W13 = 16 * MiB, W13_LAYER = 64 * MiB;
constexpr size_t WS_W2 = 272 * MiB, W2_LAYER = 32 * MiB;
constexpr size_t WS_XN = 400 * MiB, WS_X1 = 432 * MiB, WS_X2 = 496 * MiB, WS_X3 = 464 * MiB;
constexpr size_t WS_XN8 = 904 * MiB;
constexpr size_t WS_AFF = 560 * MiB, WS_IDX = 561 * MiB, WS_GATE = 562 * MiB, WS_SLOT = 563 * MiB, WS_MG = 564 * MiB;
constexpr size_t WS_ACT = 568 * MiB;
constexpr size_t WS_Q = WS_ACT, WS_K = WS_ACT + 32 * MiB, WS_V = WS_ACT + 40 * MiB, WS_O = WS_ACT + 48 * MiB;
constexpr size_t WS_H = WS_ACT, WS_Y = WS_ACT + 128 * MiB;
constexpr size_t WS_PVO = WS_ACT + 96 * MiB;
constexpr size_t WS_PROJ = WS_ACT, WS_CLOC = WS_ACT + 96 * MiB, WS_STATE = WS_ACT + 232 * MiB, WS_Y2 = WS_ACT + 300 * MiB;
constexpr size_t WS_NLOC = WS_ACT + 332 * MiB, WS_MLB = WS_ACT + 333 * MiB, WS_NST = WS_ACT + 334 * MiB, WS_MST = WS_ACT + 335 * MiB;
constexpr size_t WS_PART = 920 * MiB;
constexpr size_t WS_RSC = WS_AFF;
constexpr size_t WS_END = 928 * MiB;
constexpr int CW_BAR = 4096;

constexpr int RING_BYTES = 131072;
constexpr int AUX_OFF = RING_BYTES, AUX_BYTES = 24576;
constexpr int MISC_OFF = AUX_OFF + AUX_BYTES;
constexpr int LDS_BYTES = MISC_OFF + 256;

DI unsigned f2bf(float f) { unsigned u = __builtin_bit_cast(unsigned, f); return (u + 0x7fffu + ((u >> 16) & 1u)) >> 16; }
DI unsigned pk2(float lo, float hi) { return f2bf(lo) | (f2bf(hi) << 16); }
DI unsigned cvt_pk_bf16(float lo, float hi) { unsigned r; asm volatile("v_cvt_pk_bf16_f32 %0, %1, %2" : "=v"(r) : "v"(lo), "v"(hi)); return r; }
DI unsigned pk4_fp8(float a, float b, float c, float d) { unsigned w = 0u; w = __builtin_amdgcn_cvt_pk_fp8_f32(a, b, w, false); w = __builtin_amdgcn_cvt_pk_fp8_f32(c, d, w, true); return w; }
DI void fp8x16_to_bf16(u32x4 v, u32x4& lo8, u32x4& hi8) {
    unsigned o[8];
#pragma unroll
    for (int i = 0; i < 4; ++i) { const f32x2 a = __builtin_amdgcn_cvt_pk_f32_fp8(v[i], false), b = __builtin_amdgcn_cvt_pk_f32_fp8(v[i], true); o[2 * i] = cvt_pk_bf16(a.x, a.y); o[2 * i + 1] = cvt_pk_bf16(b.x, b.y); }
    lo8 = (u32x4){o[0], o[1], o[2], o[3]}; hi8 = (u32x4){o[4], o[5], o[6], o[7]};
}
DI float bf2f(unsigned short b) { return __builtin_bit_cast(float, ((unsigned)b) << 16); }
DI float wave_sum(float v) {
#pragma unroll
    for (int o = 1; o < 64; o <<= 1) v += __shfl_xor(v, o);
    return v;
}

#define XB_TMO      128
#define XB_XCNT(j)  (256  + 64 * (j))
#define XB_XSUB(j)  (1280 + 64 * (j))
#define XB_XGEN(j)  (2304 + 64 * (j))
#define XB_TOP      3328
#define XB_TOPGEN   3392
#define XCD_BAR_WORDS 3456
#define XB_SPIN_CAP (1u << 18)
DI unsigned xb_ld(unsigned* p)              { return __hip_atomic_load(p, __ATOMIC_RELAXED, __HIP_MEMORY_SCOPE_AGENT); }
DI unsigned xb_add(unsigned* p, unsigned v) { return __hip_atomic_fetch_add(p, v, __ATOMIC_RELAXED, __HIP_MEMORY_SCOPE_AGENT); }
DI unsigned xb_xcc_id() { return (unsigned)__builtin_amdgcn_s_getreg((3 << 11) | 20) & 0xFu; }
#define XB_SPIN(cond, bar) do { unsigned _sp = 0; while (cond) { __builtin_amdgcn_s_sleep(1); \
    if ((++_sp & 255u) == 0u) { if (xb_ld(&(bar)[XB_TMO])) break; if (_sp > XB_SPIN_CAP) { atomicAdd(&(bar)[XB_TMO], 1u); break; } } } } while (0)
struct XcdBarrier { unsigned* bar; unsigned x; volatile LAS unsigned* st; };
DI XcdBarrier xcd_barrier_post(unsigned* bar, volatile LAS unsigned* st) {
    XcdBarrier b; b.bar = bar; b.x = xb_xcc_id(); b.st = st;
    if (threadIdx.x == 0) (void)xb_add(&bar[XB_XCNT(b.x)], 1u);
    return b;
}
DI void xcd_barrier_complete(unsigned* bar, unsigned x, unsigned& nloc, unsigned& nx) {
    const unsigned G = gridDim.x * gridDim.y * gridDim.z;
    unsigned sum, cnt, mine, sp = 0u;
    for (;;) {
        sum = 0u; cnt = 0u; mine = 0u;
#pragma unroll
        for (unsigned j = 0; j < 16; ++j) { const unsigned c = xb_ld(&bar[XB_XCNT(j)]); sum += c; cnt += (c > 0u) ? 1u : 0u; mine = (j == x) ? c : mine; }
        if (sum == G) break;
        __builtin_amdgcn_s_sleep(1);
        if ((++sp & 255u) == 0u) { if (xb_ld(&bar[XB_TMO])) break; if (sp > XB_SPIN_CAP) { atomicAdd(&bar[XB_TMO], 1u); break; } }
    }
    nloc = mine > 0u ? mine : 1u; nx = cnt > 0u ? cnt : 1u;
}
DI void xcd_barrier(const XcdBarrier& b) {
    asm volatile("s_waitcnt vmcnt(0)" ::: "memory");
    __syncthreads();
    if (threadIdx.x == 0) {
        unsigned* bar = b.bar;
        __builtin_amdgcn_s_waitcnt(0);
        unsigned nloc = b.st[0], nx = b.st[1];
        if (nloc == 0u) { xcd_barrier_complete(bar, b.x, nloc, nx); b.st[0] = nloc; b.st[1] = nx; }
        const unsigned old = xb_add(&bar[XB_XSUB(b.x)], 1u);
        const unsigned gen = old / nloc;
        if (old + 1u == (gen + 1u) * nloc) {
            __builtin_amdgcn_fence(__ATOMIC_RELEASE, "agent");
            asm volatile("s_waitcnt vmcnt(0)" ::: "memory");
            const unsigned og = xb_add(&bar[XB_TOP], 1u);
            const unsigned tg = og / nx;
            if (og + 1u == (tg + 1u) * nx) xb_add(&bar[XB_TOPGEN], 1u);
            else XB_SPIN(xb_ld(&bar[XB_TOPGEN]) == tg, bar);
            __builtin_amdgcn_fence(__ATOMIC_ACQUIRE, "agent");
            xb_add(&bar[XB_XGEN(b.x)], 1u);
            asm volatile("s_waitcnt vmcnt(0)" ::: "memory");
        } else {
            XB_SPIN(xb_ld(&bar[XB_XGEN(b.x)]) == gen, bar);
            __builtin_amdgcn_fence(__ATOMIC_ACQUIRE, "agent");
            asm volatile("s_waitcnt vmcnt(0)" ::: "memory");
        }
    }
    __syncthreads();
}

namespace pg8 {
constexpr int BM = 256, BK = 64, HALF = 128, HTB = HALF * BK * 2, STAGE_BYTES = 8 * HTB;
DI int lds_byte(int r, int c) { const int st = (r >> 4) * 2 + (c >> 5), rr = r & 15, cc = c & 31, ob = rr * 64 + cc * 2; return st * 1024 + (ob ^ (((ob >> 9) & 1) << 5)); }
DI void stage_rc(int b, int& R, int& C) { const int st = b / 1024, sb = b % 1024, swz = sb ^ (((sb >> 9) & 1) << 5); R = (st >> 1) * 16 + swz / 64; C = (st & 1) * 32 + (swz % 64) / 2; }
DI int perm32(int rho) { const int n = rho >> 4, i = rho & 15; return 8 * (i >> 2) + 4 * n + (i & 3); }
DI int perm32inv(int c) { return 16 * ((c >> 2) & 1) + 4 * (c >> 3) + (c & 3); }
struct Unit { int pm, pn, ui; };

template <class Epi, class Sched, bool GATHER, bool ALIGN_EPI, bool F8>
DI void gemm_phase(LAS unsigned char* lds, const LAS int* idx_lds, const void* A, const int K, const Sched& S, const Epi& E) {
    const int tid = threadIdx.x, wid = __builtin_amdgcn_readfirstlane(tid >> 6), lane = tid & 63, wr = wid >> 2, wc = wid & 3, fr = lane & 15, fq = lane >> 4;
    const int PB = F8 ? K : 2 * K, nt = PB / 128;
    unsigned voffA[2][2], voffB[2];
    int RA[2], CA[2];
#pragma unroll
    for (int i = 0; i < 2; ++i) { int R, C; stage_rc(tid * 16 + i * 8192, R, C); RA[i] = R; CA[i] = C; voffB[i] = (unsigned)(R * PB + C * 2); }
    const size_t kstep = (size_t)(BK * 2);
    const size_t hstep = (size_t)HALF * PB;
    const unsigned ldsw = (unsigned)wid * 1024u;
    const int aoff = lds_byte(wr * 64 + fr, fq * 8), boff = lds_byte(wc * 32 + fr, fq * 8);
#define PG8_SA(b, h) (((b) * 2 + (h)) * HTB)
#define PG8_SB(b, h) ((4 + (b) * 2 + (h)) * HTB)
#define PG8_STAGE(bufoff, gbase, voff) do { _Pragma("unroll") for (int _i = 0; _i < 2; ++_i) \
        __builtin_amdgcn_global_load_lds((const unsigned*)((const char*)(gbase) + (voff)[_i]), (LAS unsigned*)(lds + (bufoff) + ldsw + _i * 8192), 16, 0, 0); } while (0)
#define PG8_LDA(dst, b, h) do { _Pragma("unroll") for (int m = 0; m < 4; ++m) _Pragma("unroll") for (int k = 0; k < 2; ++k) dst[m][k] = *(const LAS bf16x8*)(lds + PG8_SA(b, h) + aoff + m * 2048 + k * 1024); } while (0)
#define PG8_LDB(dst, b, h) do { _Pragma("unroll") for (int n = 0; n < 2; ++n) _Pragma("unroll") for (int k = 0; k < 2; ++k) dst[n][k] = *(const LAS bf16x8*)(lds + PG8_SB(b, h) + boff + n * 2048 + k * 1024); } while (0)
#define PG8_MMA(ai, bj, At, Bt) do { __builtin_amdgcn_s_setprio(1); _Pragma("unroll") for (int m = 0; m < 4; ++m) _Pragma("unroll") for (int n = 0; n < 2; ++n) { \
        if constexpr (F8) acc[ai][bj][m][n] = __builtin_amdgcn_mfma_scale_f32_16x16x128_f8f6f4( \
            __builtin_shufflevector(__builtin_bit_cast(i32x4, Bt[n][0]), __builtin_bit_cast(i32x4, Bt[n][1]), 0, 1, 2, 3, 4, 5, 6, 7), \
            __builtin_shufflevector(__builtin_bit_cast(i32x4, At[m][0]), __builtin_bit_cast(i32x4, At[m][1]), 0, 1, 2, 3, 4, 5, 6, 7), acc[ai][bj][m][n], 0, 0, 0, 0x7f7f7f7f, 0, 0x7f7f7f7f); \
        else { _Pragma("unroll") for (int k = 0; k < 2; ++k) acc[ai][bj][m][n] = __builtin_amdgcn_mfma_f32_16x16x32_bf16(Bt[n][k], At[m][k], acc[ai][bj][m][n], 0, 0, 0); } } \
        __builtin_amdgcn_s_setprio(0); } while (0)
#define PG8_WAIT_V(n) asm volatile("s_waitcnt vmcnt(" #n ")" ::: "memory")
#define PG8_WAIT_L(n) asm volatile("s_waitcnt lgkmcnt(" #n ")" ::: "memory")
#define PG8_BAR __builtin_amdgcn_s_barrier()
#define PG8_SCHED __builtin_amdgcn_sched_barrier(0)
#define PG8_SETA(ui_, u_) do { _Pragma("unroll") for (int _h = 0; _h < 2; ++_h) _Pragma("unroll") for (int _i = 0; _i < 2; ++_i) { \
        const int _row = GATHER ? idx_lds[(ui_) * 256 + _h * 128 + RA[_i]] : (u_).pm * 256 + _h * 128 + RA[_i]; voffA[_h][_i] = (unsigned)(_row * PB + CA[_i] * 2); } } while (0)
    Unit cur, nxt; int ui = 0;
    if (!S.next(0, cur)) return;
    f32x4 acc[2][2][4][2];
#pragma unroll
    for (int a = 0; a < 2; ++a)
#pragma unroll
        for (int b = 0; b < 2; ++b)
#pragma unroll
            for (int m = 0; m < 4; ++m)
#pragma unroll
                for (int n = 0; n < 2; ++n) acc[a][b][m][n] = (f32x4){0.f, 0.f, 0.f, 0.f};
    bf16x8 At[4][2], B0[2][2], B1[2][2];
    const char* const Ab = (const char*)A;
    const char* cB = S.bptr(cur);
    PG8_SETA(0, cur);
    PG8_STAGE(PG8_SB(0, 0), cB, voffB); PG8_STAGE(PG8_SB(0, 1), cB + hstep, voffB); PG8_STAGE(PG8_SA(0, 0), Ab, voffA[0]); PG8_STAGE(PG8_SA(0, 1), Ab, voffA[1]);
    if (wr == 1) PG8_BAR;
    PG8_WAIT_V(2); PG8_BAR;
    PG8_STAGE(PG8_SB(1, 0), cB + kstep, voffB); PG8_STAGE(PG8_SA(1, 0), Ab + kstep, voffA[0]); PG8_STAGE(PG8_SB(1, 1), cB + hstep + kstep, voffB);
    PG8_WAIT_V(6); PG8_BAR;
    for (;;) {
        const bool has_next = S.next(ui + 1, nxt);
        const char* nB = has_next ? S.bptr(nxt) : cB;
        for (int t = 0; t < nt; t += 2) {
            const bool last = (t == nt - 2);
            const char* a1 = Ab + (size_t)(t + 1) * kstep;
            const char* a2 = last ? Ab : Ab + (size_t)(t + 2) * kstep; const char* b2 = last ? nB : cB + (size_t)(t + 2) * kstep;
            const char* a3 = a2 + kstep; const char* b3 = b2 + kstep;
            PG8_LDB(B0, 0, 0); PG8_LDB(B1, 0, 1); PG8_SCHED; PG8_LDA(At, 0, 0); PG8_STAGE(PG8_SA(1, 1), a1, voffA[1]);
            if (last && has_next) PG8_SETA(ui + 1, nxt);
            PG8_WAIT_V(8); PG8_WAIT_L(0); PG8_BAR; PG8_MMA(0, 0, At, B0); PG8_MMA(0, 1, At, B1); PG8_BAR; PG8_SCHED;
            PG8_LDA(At, 0, 1); PG8_STAGE(PG8_SB(0, 0), b2, voffB); PG8_STAGE(PG8_SB(0, 1), b2 + hstep, voffB); PG8_STAGE(PG8_SA(0, 0), a2, voffA[0]);
            PG8_WAIT_V(8); PG8_WAIT_L(0); PG8_BAR; PG8_MMA(1, 0, At, B0); PG8_MMA(1, 1, At, B1); PG8_BAR; PG8_SCHED;
            PG8_LDB(B0, 1, 0); PG8_LDB(B1, 1, 1); PG8_SCHED; PG8_LDA(At, 1, 0); PG8_STAGE(PG8_SA(0, 1), a2, voffA[1]);
            PG8_WAIT_V(8); PG8_WAIT_L(0); PG8_BAR; PG8_MMA(0, 0, At, B0); PG8_MMA(0, 1, At, B1); PG8_BAR; PG8_SCHED;
            PG8_LDA(At, 1, 1); PG8_STAGE(PG8_SB(1, 0), b3, voffB); PG8_STAGE(PG8_SB(1, 1), b3 + hstep, voffB); PG8_STAGE(PG8_SA(1, 0), a3, voffA[0]);
            PG8_WAIT_V(8); PG8_WAIT_L(0); PG8_BAR; PG8_MMA(1, 0, At, B0); PG8_MMA(1, 1, At, B1); PG8_BAR; PG8_SCHED;
        }
        if constexpr (ALIGN_EPI) { if (wr == 0) PG8_BAR; }
        cur.ui = ui;
        if constexpr (!Epi::AFTER_DRAIN) E(acc, cur, wr, wc, fr, fq);
        if (!has_next) break;
#pragma unroll
        for (int a = 0; a < 2; ++a)
#pragma unroll
            for (int b = 0; b < 2; ++b)
#pragma unroll
                for (int m = 0; m < 4; ++m)
#pragma unroll
                    for (int n = 0; n < 2; ++n) acc[a][b][m][n] = (f32x4){0.f, 0.f, 0.f, 0.f};
        cur = nxt; cB = nB; ++ui;
        if constexpr (ALIGN_EPI) { if (wr == 1) PG8_BAR; }
    }
    PG8_WAIT_V(0);
    if constexpr (!ALIGN_EPI) { if (wr == 0) PG8_BAR; }
    PG8_BAR;
    if constexpr (Epi::AFTER_DRAIN) E.fused(acc, cur, wr, wc, fr, fq, lds);
#undef PG8_SA
#undef PG8_SB
#undef PG8_STAGE
#undef PG8_LDA
#undef PG8_LDB
#undef PG8_MMA
#undef PG8_WAIT_V
#undef PG8_WAIT_L
#undef PG8_BAR
#undef PG8_SCHED
#undef PG8_SETA
}

struct DenseOrder {
    int nM, nN, nwg, G, c; const bf16_t* Bt; int K;
    DI void init(int M_, int N_, int G_, int c_, const bf16_t* Bt_, int K_) { nM = M_ / BM; nN = N_ / BM; nwg = nM * nN; G = G_; c = c_; Bt = Bt_; K = K_; }
    DI bool next(int i, Unit& u) const {
        const long L = (long)i * G + c; if (L >= nwg) return false;
        int wgid = (int)L; { const int q = nwg / 8, r = nwg % 8, xcd = wgid % 8, off = wgid / 8; wgid = (xcd < r ? xcd * (q + 1) : r * (q + 1) + (xcd - r) * q) + off; }
        const int nig = 8 * nN, gid = wgid / nig, fm = gid * 8, gsz = (nM - fm) < 8 ? (nM - fm) : 8;
        u.pm = fm + ((wgid % nig) % gsz); u.pn = (wgid % nig) / gsz; return true;
    }
    DI const char* bptr(const Unit& u) const { return (const char*)(Bt + (size_t)u.pn * BM * K); }
};

struct DenseOrder8 : DenseOrder { DI const char* bptr(const Unit& u) const { return (const char*)Bt + (size_t)u.pn * BM * K; } };

struct EpiQKV {
    static constexpr bool AFTER_DRAIN = false;
    bf16_t *Q, *Kb, *Vb; const float *qg, *kg;
    DI void operator()(const f32x4 (&acc)[2][2][4][2], const Unit& u, int wr, int wc, int fr, int fq) const {
        const int pn = u.pn; bf16_t* base; int ld; const float* g; float sc;
        if (pn < 4) { base = Q + (pn * 4 + wc) * 64; ld = 1024; g = qg; sc = 0.125f * LOG2E; }
        else if (pn == 4) { base = Kb + wc * 64; ld = 256; g = kg; sc = 1.f; }
        else { base = Vb + wc * 64; ld = 256; g = kg; sc = 0.f; }
        f32x4 gv[2][2];
#pragma unroll
        for (int bj = 0; bj < 2; ++bj)
#pragma unroll
            for (int n = 0; n < 2; ++n) { gv[bj][n] = *(const f32x4*)(g + 32 * bj + 8 * fq + 4 * n) * sc; if (pn == 5) gv[bj][n] = (f32x4){1.f, 1.f, 1.f, 1.f}; }
#pragma unroll
        for (int ai = 0; ai < 2; ++ai)
#pragma unroll
            for (int m = 0; m < 4; ++m) {
                const int row = u.pm * BM + ai * HALF + wr * 64 + m * 16 + fr;
                float ss = 0.f;
#pragma unroll
                for (int bj = 0; bj < 2; ++bj)
#pragma unroll
                    for (int n = 0; n < 2; ++n) { const f32x4 x = acc[ai][bj][m][n]; ss += (x[0] * x[0] + x[1] * x[1]) + (x[2] * x[2] + x[3] * x[3]); }
                ss += __shfl_xor(ss, 16); ss += __shfl_xor(ss, 32);
                const float rinv = (pn == 5) ? 0.0625f : __builtin_amdgcn_rsqf(ss * (1.f / 64.f) + RMS_EPS);
#pragma unroll
                for (int bj = 0; bj < 2; ++bj) {
                    const f32x4 v0 = acc[ai][bj][m][0] * rinv * gv[bj][0], v1 = acc[ai][bj][m][1] * rinv * gv[bj][1];
                    u32x4 w; w.x = cvt_pk_bf16(v0[0], v0[1]); w.y = cvt_pk_bf16(v0[2], v0[3]); w.z = cvt_pk_bf16(v1[0], v1[1]); w.w = cvt_pk_bf16(v1[2], v1[3]);
                    *(u32x4*)(base + (size_t)row * ld + 32 * bj + 8 * fq) = w; }
            }
    }
};
template <bool RB, bool OB> struct EpiRes {
    static constexpr bool AFTER_DRAIN = false;
    const void* resid; void* out; int ldc; float cscale;
    DI void operator()(const f32x4 (&acc)[2][2][4][2], const Unit& u, int wr, int wc, int fr, int fq) const {
        const int row0 = u.pm * BM + wr * 64 + fr, col0 = u.pn * BM + wc * 32 + 4 * fq;
#pragma unroll
        for (int ai = 0; ai < 2; ++ai)
#pragma unroll
          for (int mp = 0; mp < 4; mp += 2) {
            f32x4 rr[2][2][2];
#pragma unroll
            for (int m = 0; m < 2; ++m) { const size_t off = (size_t)(row0 + ai * HALF + (mp + m) * 16) * ldc + col0;
#pragma unroll
                for (int bj = 0; bj < 2; ++bj)
#pragma unroll
                    for (int n = 0; n < 2; ++n) {
                        if constexpr (RB) { const u32x2 w = *(const u32x2*)((const bf16_t*)resid + off + bj * HALF + n * 16);
                            rr[m][bj][n] = (f32x4){__builtin_bit_cast(float, w.x << 16), __builtin_bit_cast(float, w.x & 0xffff0000u), __builtin_bit_cast(float, w.y << 16), __builtin_bit_cast(float, w.y & 0xffff0000u)}; }
                        else rr[m][bj][n] = *(const f32x4*)((const float*)resid + off + bj * HALF + n * 16); } }
#pragma unroll
            for (int m = 0; m < 2; ++m) { const size_t off = (size_t)(row0 + ai * HALF + (mp + m) * 16) * ldc + col0;
#pragma unroll
                for (int bj = 0; bj < 2; ++bj)
#pragma unroll
                    for (int n = 0; n < 2; ++n) { const f32x4 o = rr[m][bj][n] + acc[ai][bj][mp + m][n] * cscale;
                        if constexpr (OB) { u32x2 w; w.x = cvt_pk_bf16(o[0], o[1]); w.y = cvt_pk_bf16(o[2], o[3]); *(u32x2*)((bf16_t*)out + off + bj * HALF + n * 16) = w; }
                        else *(f32x4*)((float*)out + off + bj * HALF + n * 16) = o; } }
            asm volatile("" ::: "memory"); }
    }
};
template <bool RB> struct EpiResRoute {
    static constexpr bool AFTER_DRAIN = true;
    const void* resid; bf16_t* X1; unsigned char* XG8; float* part; const float* g; const float* Wr; float cscale;
    DI void operator()(const f32x4 (&)[2][2][4][2], const Unit&, int, int, int, int) const {}
    DI void fused(f32x4 (&acc)[2][2][4][2], const Unit& u, int wr, int wc, int fr, int fq, LAS unsigned char* lds) const {
        const int tid = threadIdx.x;
        LAS unsigned short* WH = (LAS unsigned short*)lds;
        LAS unsigned short* WL = WH + 16 * 256;
        LAS float* RED = (LAS float*)(lds + 16384);
#pragma unroll
        for (int i = 0; i < 2; ++i) { const int idx = tid + i * 512, c = idx >> 2, e4 = idx & 3; const int col = u.pn * BM + c;
            const f32x4 w = *(const f32x4*)(Wr + (size_t)col * NE + 4 * e4) * g[col];
#pragma unroll
            for (int q = 0; q < 4; ++q) { const unsigned hb = f2bf(w[q]); const float lo = w[q] - __builtin_bit_cast(float, hb << 16);
                WH[(4 * e4 + q) * 256 + c] = (unsigned short)hb; WL[(4 * e4 + q) * 256 + c] = (unsigned short)f2bf(lo); } }
        const int row0 = u.pm * BM + wr * 64 + fr, col0 = u.pn * BM + wc * 32 + 4 * fq;
        f32x4 gc[2][2];
#pragma unroll
        for (int bj = 0; bj < 2; ++bj)
#pragma unroll
            for (int n = 0; n < 2; ++n) gc[bj][n] = *(const f32x4*)(g + col0 + bj * HALF + n * 16);
#pragma unroll
        for (int ai = 0; ai < 2; ++ai)
#pragma unroll
          for (int mp = 0; mp < 4; mp += 2) {
            f32x4 rr[2][2][2];
#pragma unroll
            for (int m = 0; m < 2; ++m) { const size_t off = (size_t)(row0 + ai * HALF + (mp + m) * 16) * D + col0;
#pragma unroll
                for (int bj = 0; bj < 2; ++bj)
#pragma unroll
                    for (int n = 0; n < 2; ++n) {
                        if constexpr (RB) { const u32x2 w = *(const u32x2*)((const bf16_t*)resid + off + bj * HALF + n * 16);
                            rr[m][bj][n] = (f32x4){__builtin_bit_cast(float, w.x << 16), __builtin_bit_cast(float, w.x & 0xffff0000u), __builtin_bit_cast(float, w.y << 16), __builtin_bit_cast(float, w.y & 0xffff0000u)}; }
                        else rr[m][bj][n] = *(const f32x4*)((const float*)resid + off + bj * HALF + n * 16); } }
#pragma unroll
            for (int m = 0; m < 2; ++m) { const size_t off = (size_t)(row0 + ai * HALF + (mp + m) * 16) * D + col0;
#pragma unroll
                for (int bj = 0; bj < 2; ++bj)
#pragma unroll
                    for (int n = 0; n < 2; ++n) { const f32x4 o = rr[m][bj][n] + acc[ai][bj][mp + m][n] * cscale; acc[ai][bj][mp + m][n] = o;
                        u32x2 w; w.x = cvt_pk_bf16(o[0], o[1]); w.y = cvt_pk_bf16(o[2], o[3]); *(u32x2*)(X1 + off + bj * HALF + n * 16) = w;
                        const f32x4 og = o * gc[bj][n]; *(unsigned*)(XG8 + off + bj * HALF + n * 16) = pk4_fp8(og[0], og[1], og[2], og[3]); } }
            asm volatile("" ::: "memory"); }
        __syncthreads();
#pragma unroll
        for (int ai = 0; ai < 2; ++ai)
#pragma unroll
            for (int m = 0; m < 4; ++m) { float ssl = 0.f;
#pragma unroll
                for (int bj = 0; bj < 2; ++bj)
#pragma unroll
                    for (int n = 0; n < 2; ++n) { const f32x4 x = acc[ai][bj][m][n]; ssl += (x[0] * x[0] + x[1] * x[1]) + (x[2] * x[2] + x[3] * x[3]); }
                ssl += __shfl_xor(ssl, 16); ssl += __shfl_xor(ssl, 32);
                if (fq == 0) RED[((ai * HALF + wr * 64 + m * 16 + fr) * 4 + wc) * 17 + 16] = ssl; }
        bf16x8 bh[2], bl[2];
#pragma unroll
        for (int bj = 0; bj < 2; ++bj) { const int cb = bj * HALF + wc * 32 + 4 * fq;
            const u32x2 h0 = *(const LAS u32x2*)(WH + fr * 256 + cb), h1 = *(const LAS u32x2*)(WH + fr * 256 + cb + 16), l0 = *(const LAS u32x2*)(WL + fr * 256 + cb), l1 = *(const LAS u32x2*)(WL + fr * 256 + cb + 16);
            bh[bj] = __builtin_bit_cast(bf16x8, (u32x4){h0.x, h0.y, h1.x, h1.y}); bl[bj] = __builtin_bit_cast(bf16x8, (u32x4){l0.x, l0.y, l1.x, l1.y}); }
#pragma unroll
        for (int ai = 0; ai < 2; ++ai)
#pragma unroll
            for (int m = 0; m < 4; ++m) { f32x4 lg = (f32x4){0.f, 0.f, 0.f, 0.f};
#pragma unroll
                for (int bj = 0; bj < 2; ++bj) { const f32x4 x0 = acc[ai][bj][m][0], x1v = acc[ai][bj][m][1];
                    u32x4 hi, lo; float r[8] = {x0[0], x0[1], x0[2], x0[3], x1v[0], x1v[1], x1v[2], x1v[3]};
#pragma unroll
                    for (int q = 0; q < 4; ++q) { const unsigned h2 = cvt_pk_bf16(r[2 * q], r[2 * q + 1]); hi[q] = h2;
                        lo[q] = cvt_pk_bf16(r[2 * q] - __builtin_bit_cast(float, h2 << 16), r[2 * q + 1] - __builtin_bit_cast(float, h2 & 0xffff0000u)); }
                    const bf16x8 ah = __builtin_bit_cast(bf16x8, hi), al = __builtin_bit_cast(bf16x8, lo);
                    lg = __builtin_amdgcn_mfma_f32_16x16x32_bf16(ah, bh[bj], lg, 0, 0, 0);
                    lg = __builtin_amdgcn_mfma_f32_16x16x32_bf16(al, bh[bj], lg, 0, 0, 0);
                    lg = __builtin_amdgcn_mfma_f32_16x16x32_bf16(ah, bl[bj], lg, 0, 0, 0); }
#pragma unroll
                for (int j = 0; j < 4; ++j) RED[((ai * HALF + wr * 64 + m * 16 + 4 * fq + j) * 4 + wc) * 17 + fr] = lg[j]; }
        __syncthreads();
        for (int idx = tid; idx < 256 * 17; idx += 512) { const int e17 = idx >> 8, row = idx & 255;
            const float v = (RED[(row * 4 + 0) * 17 + e17] + RED[(row * 4 + 1) * 17 + e17]) + (RED[(row * 4 + 2) * 17 + e17] + RED[(row * 4 + 3) * 17 + e17]);
            part[(size_t)(u.pn * 17 + e17) * M + u.pm * BM + row] = v; }
    }
};
struct EpiSwiGLU {
    static constexpr bool AFTER_DRAIN = false;
    unsigned char* H; const LAS float* rsl;
    DI void operator()(const f32x4 (&acc)[2][2][4][2], const Unit& u, int wr, int wc, int fr, int fq) const {
        const int row0 = u.pm * BM + wr * 64 + fr, col = u.pn * 128 + wc * 32 + 8 * fq;
        float rsv[2][4];
#pragma unroll
        for (int ai = 0; ai < 2; ++ai)
#pragma unroll
            for (int m = 0; m < 4; ++m) rsv[ai][m] = rsl[u.ui * 256 + ai * HALF + wr * 64 + m * 16 + fr] * 0.0625f;
#pragma unroll
        for (int ai = 0; ai < 2; ++ai)
#pragma unroll
            for (int m = 0; m < 4; ++m) {
                float hv[8]; const float rs = rsv[ai][m];
#pragma unroll
                for (int n = 0; n < 2; ++n)
#pragma unroll
                    for (int j = 0; j < 4; ++j) { const float a = acc[ai][0][m][n][j] * rs, uu = acc[ai][1][m][n][j] * rs;
                        const float hh = a * __builtin_amdgcn_rcpf(1.f + __builtin_amdgcn_exp2f(-a * LOG2E)) * uu; hv[4 * n + j] = fminf(fmaxf(hh, -448.f), 448.f); }
                u32x2 w; w.x = pk4_fp8(hv[0], hv[1], hv[2], hv[3]); w.y = pk4_fp8(hv[4], hv[5], hv[6], hv[7]);
                __builtin_nontemporal_store(w, (u32x2*)(H + (size_t)(row0 + ai * HALF + m * 16) * DE + col));
            }
    }
};
struct EpiBf16 {
    static constexpr bool AFTER_DRAIN = false;
    bf16_t* O; int ldc; const float* rowscale; float cscale; int coloff;
    DI void operator()(const f32x4 (&acc)[2][2][4][2], const Unit& u, int wr, int wc, int fr, int fq) const {
        const int row0 = u.pm * BM + wr * 64 + fr, col0 = coloff + u.pn * BM + wc * 32 + 8 * fq;
#pragma unroll
        for (int ai = 0; ai < 2; ++ai)
#pragma unroll
            for (int m = 0; m < 4; ++m) { const int row = row0 + ai * HALF + m * 16; const float sc = rowscale ? rowscale[row] * cscale : cscale;
#pragma unroll
                for (int bj = 0; bj < 2; ++bj) { const f32x4 v0 = acc[ai][bj][m][0] * sc, v1 = acc[ai][bj][m][1] * sc;
                    u32x4 w; w.x = cvt_pk_bf16(v0[0], v0[1]); w.y = cvt_pk_bf16(v0[2], v0[3]); w.z = cvt_pk_bf16(v1[0], v1[1]); w.w = cvt_pk_bf16(v1[2], v1[3]);
                    *(u32x4*)(O + (size_t)row * ldc + col0 + bj * HALF) = w; } }
    }
};
struct EpiFp8 {
    static constexpr bool AFTER_DRAIN = false;
    unsigned char* O; int ldc; const float* rowscale; float cscale;
    DI void operator()(const f32x4 (&acc)[2][2][4][2], const Unit& u, int wr, int wc, int fr, int fq) const {
        const int row0 = u.pm * BM + wr * 64 + fr, col0 = u.pn * BM + wc * 32 + 8 * fq;
#pragma unroll
        for (int ai = 0; ai < 2; ++ai)
#pragma unroll
            for (int m = 0; m < 4; ++m) { const int row = row0 + ai * HALF + m * 16; const float sc = rowscale ? rowscale[row] * cscale : cscale;
#pragma unroll
                for (int bj = 0; bj < 2; ++bj) { const f32x4 v0 = acc[ai][bj][m][0] * sc, v1 = acc[ai][bj][m][1] * sc;
                    u32x2 w; w.x = pk4_fp8(v0[0], v0[1], v0[2], v0[3]); w.y = pk4_fp8(v1[0], v1[1], v1[2], v1[3]);
                    *(u32x2*)(O + (size_t)row * ldc + col0 + bj * HALF) = w; } }
    }
};
struct MoeUpOrder {
    int vcu, G; const char* W;
    DI bool next(int i, Unit& u) const { const int L = i * G + vcu; if (L >= 2048) return false; const int ii = L >> 8, v = L & 255, x = v >> 5, j = v & 31, e = 2 * ii + (x >> 2);
        u.pm = 8 * e + (j & 7); u.pn = 4 * (x & 3) + (j >> 3); return true; }
    DI const char* bptr(const Unit& u) const { return W + (size_t)(u.pm >> 3) * 4096 * 1024 + (size_t)u.pn * BM * 1024; }
};
struct MoeDownOrder {
    int vcu, G; const char* W;
    DI bool next(int i, Unit& u) const { const int L = i * G + vcu; if (L >= 512) return false; const int ii = L >> 8, v = L & 255, x = v >> 5, j = v & 31, e = 8 * ii + x;
        u.pm = 8 * e + (j & 7); u.pn = j >> 3; return true; }
    DI const char* bptr(const Unit& u) const { return W + (size_t)(u.pm >> 3) * 1024 * 2048 + (size_t)u.pn * BM * 2048; }
};
}

struct Args { const float* in[19]; float* out; unsigned char* ws; int ph_lo, ph_hi; };
struct Frame {
    LAS unsigned char* lds; volatile LAS unsigned* MISC; unsigned* ctl;
    int tid, lane, wave, vcu, G;
};
enum { IN_X = 0, IN_RELB, IN_ANG, IN_AWIN, IN_AQG, IN_AKG, IN_ASINK, IN_AWOUT, IN_MNG, IN_MWIN, IN_MBI, IN_MBF, IN_MOG, IN_MWOUT, IN_FNG, IN_RW, IN_W1, IN_W3, IN_W2 };

DI void conv_item(const float* W, int ldw, int cbase, bf16_t* dst, int K, int drow0, int k0, bool perm, float scale, LAS float* scr, int lane) {
#pragma unroll 8
    for (int i = 0; i < 32; ++i) { const int kk = 2 * i + (lane >> 5); scr[kk * 33 + (lane & 31)] = W[(size_t)(k0 + kk) * ldw + cbase + (lane & 31)]; }
    LDS_WAIT(); asm volatile("" ::: "memory");
    const int c = lane & 7;
#pragma unroll
    for (int j = 0; j < 4; ++j) { const int n = (lane >> 3) + 8 * j; const LAS float* s = scr + (8 * c) * 33 + n;
        u32x4 o; o.x = pk2(s[0 * 33] * scale, s[1 * 33] * scale); o.y = pk2(s[2 * 33] * scale, s[3 * 33] * scale); o.z = pk2(s[4 * 33] * scale, s[5 * 33] * scale); o.w = pk2(s[6 * 33] * scale, s[7 * 33] * scale);
        const int rho = perm ? pg8::perm32inv(n) : n;
        *(u32x4*)(dst + (size_t)(drow0 + rho) * K + k0 + 8 * c) = o; }
    LDS_WAIT(); asm volatile("" ::: "memory");
}
DI void conv_item8(const float* W, int ldw, int cbase, unsigned char* dst, int K, int drow0, int k0, float scale, LAS float* scr, int lane, bool perm = true) {
    const int a = lane >> 3, b = lane & 7;
    f32x4 v[16];
#pragma unroll
    for (int i = 0; i < 16; ++i) v[i] = __builtin_nontemporal_load((const f32x4*)(W + (size_t)(k0 + 8 * i + a) * ldw + cbase + 4 * b));
#pragma unroll
    for (int i = 0; i < 16; ++i) { const int k = 8 * i + a; LAS float* d = scr + k * 33 + 4 * (k >> 4) + 4 * b; d[0] = v[i].x; d[1] = v[i].y; d[2] = v[i].z; d[3] = v[i].w; }
    LDS_WAIT(); asm volatile("" ::: "memory");
    const int c = lane & 7;
#pragma unroll
    for (int j = 0; j < 4; ++j) { const int n = (lane >> 3) + 8 * j; const LAS float* s = scr + (16 * c) * 33 + 4 * c + n;
        u32x4 o;
#pragma unroll
        for (int q = 0; q < 4; ++q) o[q] = pk4_fp8(s[(4 * q) * 33] * scale, s[(4 * q + 1) * 33] * scale, s[(4 * q + 2) * 33] * scale, s[(4 * q + 3) * 33] * scale);
        __builtin_nontemporal_store(o, (u32x4*)(dst + (size_t)(drow0 + (perm ? pg8::perm32inv(n) : n)) * K + k0 + 16 * c)); }
    LDS_WAIT(); asm volatile("" ::: "memory");
}
DI void rms_row_to_bf16(const float* xrow, const float* g, bf16_t* orow, int lane) {
    const f32x4* xr = (const f32x4*)xrow + lane; const f32x4* gr = (const f32x4*)g + lane;
    f32x4 v[4]; float s = 0.f;
#pragma unroll
    for (int j = 0; j < 4; ++j) { v[j] = xr[64 * j]; s += (v[j].x * v[j].x + v[j].y * v[j].y) + (v[j].z * v[j].z + v[j].w * v[j].w); }
    const float rinv = __builtin_amdgcn_rsqf(wave_sum(s) * (1.f / D) + RMS_EPS);
    unsigned long long* o8 = (unsigned long long*)orow + lane;
#pragma unroll
    for (int j = 0; j < 4; ++j) { const f32x4 gg = gr[64 * j]; const f32x4 y = v[j] * rinv * gg;
        o8[64 * j] = (unsigned long long)pk2(y.x, y.y) | ((unsigned long long)pk2(y.z, y.w) << 32); }
}
constexpr int XI_PER_LE = 1536, XI_TOTAL = 32 * XI_PER_LE;
constexpr int XI_NA = 128 * NWAVES * 6, XI_NB = 192 * NWAVES * 6, XI_NC = 192 * NWAVES * 5, XI_ND = 128 * NWAVES * 16;
constexpr int XI_PRO_END = XI_TOTAL - XI_NA - XI_NB - XI_NC - XI_ND, XI_A_END = XI_PRO_END + XI_NA, XI_B_END = XI_A_END + XI_NB, XI_C_END = XI_TOTAL - XI_ND;
static_assert(XI_B_END >= XI_TOTAL / 2, "the slots after MoE layer 0 may only hold layer-1 items");
DI void expert_conv_items(Frame& F, const Args& a, int it0, int it1, int rank, int nrank) {
    LAS float* scr8 = (LAS float*)(F.lds + F.wave * 17152);
    unsigned char* ws = a.ws;
    for (int it = it0 + rank; it < it1; it += nrank) {
        const int le = it / XI_PER_LE, r = it % XI_PER_LE;
        if (r < 1024) { const int kb = r / 128, g = r % 128, pn = g >> 3, bj = (g >> 2) & 1, wc = g & 3;
            const float* W = (bj ? a.in[IN_W3] : a.in[IN_W1]) + (size_t)le * D * DE;
            conv_item8(W, DE, 128 * pn + 32 * wc, ws + WS_W13 + (size_t)le * 4096 * D, D, 32 * g, 128 * kb, 16.f, scr8, F.lane);
        } else { const int r2 = r - 1024, kb = r2 / 32, g = r2 % 32;
            conv_item8(a.in[IN_W2] + (size_t)le * DE * D, D, 32 * g, ws + WS_W2 + (size_t)le * D * DE, DE, 32 * g, 128 * kb, 32.f, scr8, F.lane); }
    }
}
DI void rms_row_to_fp8(const float* xrow, const float* g, unsigned char* orow, int lane) {
    const f32x4* xr = (const f32x4*)xrow + lane; const f32x4* gr = (const f32x4*)g + lane;
    f32x4 v[4]; float s = 0.f;
#pragma unroll
    for (int j = 0; j < 4; ++j) { v[j] = xr[64 * j]; s += (v[j].x * v[j].x + v[j].y * v[j].y) + (v[j].z * v[j].z + v[j].w * v[j].w); }
    const float rinv = __builtin_amdgcn_rsqf(wave_sum(s) * (1.f / D) + RMS_EPS);
#pragma unroll
    for (int j = 0; j < 4; ++j) { const f32x4 y = v[j] * rinv * gr[64 * j]; *((unsigned*)orow + lane + 64 * j) = pk4_fp8(y.x, y.y, y.z, y.w); }
}
DI void p0_prologue(Frame& F, const Args& a) {
    LAS float* scr = (LAS float*)(F.lds + F.wave * 17152);
    const int gw = F.vcu * NWAVES + F.wave, NGW = F.G * NWAVES;
    unsigned char* ws = a.ws;
    LAS float* scr8 = (LAS float*)(F.lds + F.wave * 17152);
    constexpr int I_QKV = 8 * 48, I_AO = 8 * 32, I_MINA = 16 * 32, I_MINB = 8 * 64, I_MO = 16 * 32, I_SMALL = I_QKV + I_AO + I_MINA + I_MINB + I_MO;
    for (int it = gw; it < I_SMALL; it += NGW) {
        int r = it;
        if (r < I_QKV) { const int kb = r / 48, g = r % 48, pn = g >> 3, bj = (g >> 2) & 1, wc = g & 3;
            conv_item8(a.in[IN_AWIN], NQKV, 256 * pn + 64 * wc + 32 * bj, ws + WS_WQKV, D, 32 * g, 128 * kb, 16.f, scr8, F.lane, true); continue; } r -= I_QKV;
        if (r < I_AO) { const int kb = r / 32, g = r % 32; conv_item8(a.in[IN_AWOUT], D, 32 * g, ws + WS_WAO, D, 32 * g, 128 * kb, 16.f, scr8, F.lane, false); continue; } r -= I_AO;
        if (r < I_MINA) { const int kb = r / 32, g = r % 32; const float sc = g >= 16 ? 0.125f : 1.f;
            conv_item(a.in[IN_MWIN], MIN_LD, 32 * g, (bf16_t*)(ws + WS_WMIN), D, 32 * g, 64 * kb, true, sc, scr, F.lane); continue; } r -= I_MINA;
        if (r < I_MINB) { const int kb = r / 64, g = r % 64;
            conv_item8(a.in[IN_MWIN], MIN_LD, 1024 + 32 * g, ws + WS_WMIN8, D, 32 * g, 128 * kb, 16.f, scr8, F.lane, true); continue; } r -= I_MINB;
        { const int kb = r / 32, g = r % 32; conv_item(a.in[IN_MWOUT], D, 32 * g, (bf16_t*)(ws + WS_WMO), D, 32 * g, 64 * kb, false, 1.f, scr, F.lane); }
    }
    for (int m = gw; m < M; m += NGW) rms_row_to_fp8(a.in[IN_X] + (size_t)m * D, a.in[IN_ANG], ws + WS_XN8 + (size_t)m * D, F.lane);
    expert_conv_items(F, a, 0, XI_PRO_END, gw, NGW);
}

constexpr int AT_K = 0, AT_V = 49152, AT_TB = 98304, AT_TB_COPY = 324, AT_TB_HEAD = 4 * AT_TB_COPY;
DI int t5_bucket_dev(int rel) {
    const int n = rel < 0 ? -rel : rel; int b;
    if (n < 8) b = n; else if (n < 12) b = 8; else if (n < 16) b = 9; else if (n < 23) b = 10; else if (n < 32) b = 11; else if (n < 46) b = 12; else if (n < 64) b = 13; else if (n < 91) b = 14; else b = 15;
    return b + (rel > 0 ? 16 : 0);
}
DI bf16x8 pack_step(const f32x16& x, int s) {
    u32x4 p;
    p.x = cvt_pk_bf16(x[8 * s + 0], x[8 * s + 1]); p.y = cvt_pk_bf16(x[8 * s + 2], x[8 * s + 3]); p.z = cvt_pk_bf16(x[8 * s + 4], x[8 * s + 5]); p.w = cvt_pk_bf16(x[8 * s + 6], x[8 * s + 7]);
    return __builtin_bit_cast(bf16x8, p);
}
typedef short v4i16_t __attribute__((ext_vector_type(4)));
DI s16x4 tr_read(const LAS unsigned char* p) { return __builtin_bit_cast(s16x4, __builtin_amdgcn_ds_read_tr16_b64_v4i16((LAS v4i16_t*)p)); }
DI bf16x8 cat8(s16x4 lo, s16x4 hi) { return __builtin_shufflevector(lo, hi, 0, 1, 2, 3, 4, 5, 6, 7); }

DI void attn_phase(Frame& F, const Args& a) {
    LAS unsigned char* lds = F.lds;
    const bf16_t* Qg = (const bf16_t*)(a.ws + WS_Q); const bf16_t* Kg = (const bf16_t*)(a.ws + WS_K); const bf16_t* Vg = (const bf16_t*)(a.ws + WS_V); unsigned char* Og = a.ws + WS_O;
    const float* relb = a.in[IN_RELB]; const float* sink = a.in[IN_ASINK];
    const int lane = F.lane, wave = F.wave, r = lane & 31, h = lane >> 5;
    const int g = wave >> 1, half = wave & 1;
    LAS float* TB = (LAS float*)(lds + AT_TB);
    constexpr int NPF = 6;
    u32x4 kvr[NPF];
#define AT_LOAD(u_) do { const int qb_ = (u_) & 31, kvh_ = ((u_) >> 5) & 3, b_ = (u_) >> 7, kb_ = qb_ * 128 - 128; \
        _Pragma("unroll") for (int i = 0; i < NPF; ++i) { const int idx = F.tid + i * NTHR, isv = idx >= 3072, rem = isv ? idx - 3072 : idx, row = rem >> 3, c = rem & 7; int kp = kb_ + row; kp = kp < 0 ? 0 : (kp >= SEQ ? SEQ - 1 : kp); \
            kvr[i] = *(const u32x4*)((isv ? Vg : Kg) + (size_t)(b_ * SEQ + kp) * 256 + kvh_ * 64 + c * 8); } } while (0)
    int tb_kvh = -1;
    if (F.vcu < 512) AT_LOAD(F.vcu);
    for (int u = F.vcu; u < 512; u += F.G) {
        const int qb = u & 31, kvh = (u >> 5) & 3, b = u >> 7;
        const int kbase = qb * 128 - 128;
        __syncthreads();
        if (kvh != tb_kvh) { tb_kvh = kvh;
#pragma unroll 4
            for (int idx = F.tid; idx < 4 * AT_TB_HEAD; idx += NTHR) {
                const int gg = idx / AT_TB_HEAD, rem = idx % AT_TB_HEAD, c = rem / AT_TB_COPY, i = rem % AT_TB_COPY, rel = i + c - 160;
                float v = -__builtin_inff();
                if (rel >= -128 && rel <= 128) v = relb[t5_bucket_dev(rel) * 16 + kvh * 4 + gg] * LOG2E;
                TB[idx] = v;
            } }
        u32x4 late[12 - NPF];
#pragma unroll
        for (int i = NPF; i < 12; ++i) { const int idx = F.tid + i * NTHR, isv = idx >= 3072, rem = isv ? idx - 3072 : idx, row = rem >> 3, c = rem & 7; int kp = kbase + row; kp = kp < 0 ? 0 : (kp >= SEQ ? SEQ - 1 : kp);
            late[i - NPF] = *(const u32x4*)((isv ? Vg : Kg) + (size_t)(b * SEQ + kp) * 256 + kvh * 64 + c * 8); }
#pragma unroll
        for (int i = 0; i < 12; ++i) { const int idx = F.tid + i * NTHR, isv = idx >= 3072, rem = isv ? idx - 3072 : idx, row = rem >> 3, c = rem & 7;
            const int pos = isv ? (c ^ (((row >> 1) & 1) << 2)) : (c ^ ((row >> 1) & 7));
            *(LAS u32x4*)(lds + (isv ? AT_V : AT_K) + row * 128 + pos * 16) = i < NPF ? kvr[i] : late[i < NPF ? 0 : i - NPF]; }
        if (u + F.G < 512) AT_LOAD(u + F.G);
        const int head = kvh * 4 + g, qw0 = qb * 128 + 64 * half;
        bf16x8 qf[2][4];
#pragma unroll
        for (int qt = 0; qt < 2; ++qt)
#pragma unroll
            for (int s = 0; s < 4; ++s) qf[qt][s] = *(const bf16x8*)(Qg + (size_t)(b * SEQ + qw0 + 32 * qt + r) * 1024 + head * 64 + 16 * s + 8 * h);
        __syncthreads();
        const float sk = sink[head] * LOG2E;
        float mrun[2] = {sk, sk}, lrun[2] = {h == 0 ? 1.f : 0.f, h == 0 ? 1.f : 0.f};
        f32x16 o[2][2];
#pragma unroll
        for (int qt = 0; qt < 2; ++qt)
#pragma unroll
            for (int dt = 0; dt < 2; ++dt)
#pragma unroll
                for (int i = 0; i < 16; ++i) o[qt][dt][i] = 0.f;
        const int cpy = (4 - (r & 3)) & 3;
        const LAS float* tbl = TB + g * AT_TB_HEAD + cpy * AT_TB_COPY + (32 + 4 * h - r - cpy);
        const int q4 = (lane & 15) >> 2, p4 = lane & 3, blk = (lane >> 4) & 1;
        for (int T = 2 * half; T < 2 * half + 10; ++T) {
            const int kp0 = kbase + 32 * T;
            if (kp0 < 0 || kp0 >= SEQ) continue;
            bf16x8 kf[4];
            { const int row = 32 * T + r;
#pragma unroll
              for (int s = 0; s < 4; ++s) kf[s] = *(const LAS bf16x8*)(lds + AT_K + row * 128 + (((2 * s + h) ^ ((row >> 1) & 7)) << 4)); }
            bf16x8 vf[2][2];
#pragma unroll
            for (int dt = 0; dt < 2; ++dt)
#pragma unroll
                for (int s = 0; s < 2; ++s) {
                    const int row0 = 32 * T + 16 * s + 4 * h + q4, row1 = row0 + 8, cb = 64 * dt + 32 * blk + 8 * p4;
                    const s16x4 lo = tr_read(lds + AT_V + row0 * 128 + (cb ^ (((row0 >> 1) & 1) << 6)));
                    const s16x4 hi = tr_read(lds + AT_V + row1 * 128 + (cb ^ (((row1 >> 1) & 1) << 6)));
                    vf[dt][s] = cat8(lo, hi);
                }
#pragma unroll
            for (int qt = 0; qt < 2; ++qt) {
                const int kt = T - 2 * half - qt;
                if (kt < 0 || kt > 8) continue;
                f32x16 sacc;
#pragma unroll
                for (int G4 = 0; G4 < 4; ++G4) { const f32x4 t = *(const LAS f32x4*)(tbl + 32 * kt + 8 * G4);
                    sacc[4 * G4 + 0] = t[0]; sacc[4 * G4 + 1] = t[1]; sacc[4 * G4 + 2] = t[2]; sacc[4 * G4 + 3] = t[3]; }
#pragma unroll
                for (int s = 0; s < 4; ++s) sacc = __builtin_amdgcn_mfma_f32_32x32x16_bf16(kf[s], qf[qt][s], sacc, 0, 0, 0);
                float mx = sacc[0];
#pragma unroll
                for (int i = 1; i < 16; ++i) mx = fmaxf(mx, sacc[i]);
                mx = fmaxf(mx, __shfl_xor(mx, 32));
                const float mnew = fmaxf(mrun[qt], mx), alpha = __builtin_amdgcn_exp2f(mrun[qt] - mnew);
                mrun[qt] = mnew;
                float ls = 0.f;
#pragma unroll
                for (int i = 0; i < 16; ++i) { sacc[i] = __builtin_amdgcn_exp2f(sacc[i] - mnew); ls += sacc[i]; }
                lrun[qt] = lrun[qt] * alpha + ls;
#pragma unroll
                for (int dt = 0; dt < 2; ++dt)
#pragma unroll
                    for (int i = 0; i < 16; ++i) o[qt][dt][i] *= alpha;
                const bf16x8 p0 = pack_step(sacc, 0), p1 = pack_step(sacc, 1);
#pragma unroll
                for (int dt = 0; dt < 2; ++dt) {
                    o[qt][dt] = __builtin_amdgcn_mfma_f32_32x32x16_bf16(vf[dt][0], p0, o[qt][dt], 0, 0, 0);
                    o[qt][dt] = __builtin_amdgcn_mfma_f32_32x32x16_bf16(vf[dt][1], p1, o[qt][dt], 0, 0, 0);
                }
            }
        }
#pragma unroll
        for (int qt = 0; qt < 2; ++qt) {
            const float lt = lrun[qt] + __shfl_xor(lrun[qt], 32), inv = 16.f / lt;
            unsigned char* orow = Og + (size_t)(b * SEQ + qw0 + 32 * qt + r) * 1024 + head * 64;
#pragma unroll
            for (int dt = 0; dt < 2; ++dt)
#pragma unroll
                for (int G4 = 0; G4 < 4; ++G4)
                    *(unsigned*)(orow + 32 * dt + 8 * G4 + 4 * h) = pk4_fp8(o[qt][dt][4 * G4] * inv, o[qt][dt][4 * G4 + 1] * inv, o[qt][dt][4 * G4 + 2] * inv, o[qt][dt][4 * G4 + 3] * inv);
        }
    }
#undef AT_LOAD
}

template <int N> DI int multi_reduce(float (&v)[N], int lane) {
    int idx = 0;
#pragma unroll
    for (int bit = 32, cnt = N / 2; cnt >= 1; bit >>= 1, cnt >>= 1) {
        const bool upper = (lane & bit) != 0;
#pragma unroll
        for (int i = 0; i < cnt; ++i) { const float lo = v[i], hi = v[i + cnt]; const float send = upper ? lo : hi, keep = upper ? hi : lo; v[i] = keep + __shfl_xor(send, bit); }
        idx |= upper ? cnt : 0;
    }
#pragma unroll
    for (int bit = 32 / N; bit >= 1; bit >>= 1) v[0] += __shfl_xor(v[0], bit);
    return idx;
}
DI float log_sigmoid(float x) { return x < 0.f ? x - log1pf(expf(x)) : -log1pf(expf(-x)); }
DI void add_routed_rows(f32x4 (&x)[4], const unsigned char* Y, int sl, int b, int lane) {
    unsigned long long mask = __ballot(sl >= 0);
    while (mask) {
        const unsigned char* yr[4]; float wq[4];
#pragma unroll
        for (int q = 0; q < 4; ++q) { const bool v = mask != 0ull; const int e = v ? __builtin_ctzll(mask) : 0; if (v) mask &= mask - 1;
            const int sv = __builtin_amdgcn_readlane(sl, e); wq[q] = v ? 1.f / YS8 : 0.f;
            yr[q] = (v || q == 0) ? Y + (size_t)((e * NB + b) * CAP + sv) * D : yr[0]; }
        unsigned w[4][4];
#pragma unroll
        for (int q = 0; q < 4; ++q)
#pragma unroll
            for (int j = 0; j < 4; ++j) w[q][j] = __builtin_nontemporal_load((const unsigned*)yr[q] + lane + 64 * j);
#pragma unroll
        for (int q = 0; q < 4; ++q)
#pragma unroll
            for (int j = 0; j < 4; ++j) { const f32x2 lo = __builtin_amdgcn_cvt_pk_f32_fp8(w[q][j], false), hi = __builtin_amdgcn_cvt_pk_f32_fp8(w[q][j], true);
                x[j].x += wq[q] * lo.x; x[j].y += wq[q] * lo.y; x[j].z += wq[q] * hi.x; x[j].w += wq[q] * hi.y; }
    }
}
template <int NEV, bool COMBINE>
DI void nr_phase(Frame& F, const bf16_t* base, const unsigned char* Y, const int* slot, bf16_t* xout, const float* g, bf16_t* XN, unsigned char* XN8,
                 const float* Wsrc, int ldw, int col0, float* outv, const float* b_i, const float* b_f) {
    LAS float* Wt = (LAS float*)F.lds;
    { f32x4 wv[NEV / 2];
#pragma unroll
      for (int i = 0; i < NEV / 2; ++i) { const int idx = F.tid + i * NTHR, d = idx / (NEV / 4), e4 = idx % (NEV / 4); wv[i] = *(const f32x4*)(Wsrc + (size_t)d * ldw + col0 + 4 * e4); }
#pragma unroll
      for (int i = 0; i < NEV / 2; ++i) { const int idx = F.tid + i * NTHR, d = idx / (NEV / 4), e4 = idx % (NEV / 4);
#pragma unroll
          for (int q = 0; q < 4; ++q) Wt[(4 * e4 + q) * 1024 + d] = wv[i][q]; } }
    const int gw = F.vcu * NWAVES + F.wave, NGW = F.G * NWAVES, lane = F.lane;
    LAS float* res = (LAS float*)(F.lds + AUX_OFF) + F.wave * 64;
    f32x4 gg[4];
#pragma unroll
    for (int j = 0; j < 4; ++j) gg[j] = *((const f32x4*)g + lane + 64 * j);
    __syncthreads();
#pragma unroll 1
    for (int m0 = gw; m0 < M; m0 += 4 * NGW) {
        f32x4 x[4][4]; int sl[4];
#pragma unroll
        for (int t4 = 0; t4 < 4; ++t4) { const int m = m0 + t4 * NGW < M ? m0 + t4 * NGW : m0;
#pragma unroll
            for (int j = 0; j < 4; ++j) { const u32x2 w = __builtin_nontemporal_load((const u32x2*)(base + (size_t)m * D) + lane + 64 * j);
                x[t4][j] = (f32x4){__builtin_bit_cast(float, w.x << 16), __builtin_bit_cast(float, w.x & 0xffff0000u), __builtin_bit_cast(float, w.y << 16), __builtin_bit_cast(float, w.y & 0xffff0000u)}; }
            sl[t4] = (COMBINE && lane < NE) ? slot[(size_t)m * NE + lane] : -1; }
#pragma unroll
        for (int pp = 0; pp < 4; pp += 2) {
            int mm[2]; float ssv[2];
#pragma unroll
            for (int u = 0; u < 2; ++u) {
                const int t4 = pp + u; const int m = m0 + t4 * NGW < M ? m0 + t4 * NGW : m0; mm[u] = m;
                if (COMBINE) add_routed_rows(x[t4], Y, sl[t4], m / SEQ, lane);
                if (xout) {
#pragma unroll
                    for (int j = 0; j < 4; ++j) { u32x2 w; w.x = cvt_pk_bf16(x[t4][j].x, x[t4][j].y); w.y = cvt_pk_bf16(x[t4][j].z, x[t4][j].w); *((u32x2*)(xout + (size_t)m * D) + lane + 64 * j) = w;
                        x[t4][j] = (f32x4){__builtin_bit_cast(float, w.x << 16), __builtin_bit_cast(float, w.x & 0xffff0000u), __builtin_bit_cast(float, w.y << 16), __builtin_bit_cast(float, w.y & 0xffff0000u)}; }
                }
                float ss = 0.f;
#pragma unroll
                for (int j = 0; j < 4; ++j) ss += (x[t4][j].x * x[t4][j].x + x[t4][j].y * x[t4][j].y) + (x[t4][j].z * x[t4][j].z + x[t4][j].w * x[t4][j].w);
                const float sst = wave_sum(ss); ssv[u] = sst;
                const float rinv = NEV == 16 ? 1.f : __builtin_amdgcn_rsqf(sst * (1.f / D) + RMS_EPS);
#pragma unroll
                for (int j = 0; j < 4; ++j) { x[t4][j] = x[t4][j] * rinv * gg[j];
                    if (NEV == 32) *((unsigned long long*)(XN + (size_t)m * D) + lane + 64 * j) = (unsigned long long)pk2(x[t4][j].x, x[t4][j].y) | ((unsigned long long)pk2(x[t4][j].z, x[t4][j].w) << 32);
                    else *((unsigned*)(XN8 + (size_t)m * D) + lane + 64 * j) = pk4_fp8(x[t4][j].x, x[t4][j].y, x[t4][j].z, x[t4][j].w); }
            }
#pragma unroll 1
            for (int eg = 0; eg < NEV / 4; ++eg) {
                float v8[8];
#pragma unroll
                for (int e4 = 0; e4 < 4; ++e4) { float s0 = 0.f, s1 = 0.f;
#pragma unroll
                    for (int j = 0; j < 4; ++j) { const f32x4 w = *((const LAS f32x4*)(Wt + (4 * eg + e4) * 1024) + lane + 64 * j);
                        s0 += (x[pp][j].x * w.x + x[pp][j].y * w.y) + (x[pp][j].z * w.z + x[pp][j].w * w.w); s1 += (x[pp + 1][j].x * w.x + x[pp + 1][j].y * w.y) + (x[pp + 1][j].z * w.z + x[pp + 1][j].w * w.w); }
                    v8[e4] = s0; v8[4 + e4] = s1; }
                const int i8 = multi_reduce<8>(v8, lane);
                if ((lane & 7) == 0) res[(i8 >> 2) * 32 + 4 * eg + (i8 & 3)] = v8[0];
            }
            asm volatile("s_waitcnt lgkmcnt(0)" ::: "memory");
            if (NEV == 16) {
                const int u = (lane >> 4) & 1, e = lane & 15, m = mm[u];
                if (lane < 32) { outv[(size_t)e * M + m] = res[u * 32 + e]; if (e == 0) outv[(size_t)16 * M + m] = ssv[u]; }
#pragma unroll
                for (int q = 0; q < 2; ++q) { const int idx = lane + 64 * q; if (idx < 102) { const int uu = idx / 51, r51 = idx % 51; outv[(size_t)(17 + r51) * M + mm[uu]] = 0.f; } }
            } else {
                const int u = lane >> 5, k = lane & 31, m = mm[u];
                const float v = res[u * 32 + k];
                const int kind = k >> 3, hd = k & 7, dir = kind >> 1;
                outv[(size_t)m * 32 + k] = (kind & 1) ? log_sigmoid(v + b_f[dir * 8 + hd]) : v + b_i[dir * 8 + hd];
            }
            asm volatile("" ::: "memory");
        }
    }
}
constexpr int NRM_WB = 0, NRM_WB_LD = 2128, NRM_XR = 32 * NRM_WB_LD, NRM_XR_LD = 2112;
static_assert(NRM_XR + NWAVES * 4 * NRM_XR_LD <= AUX_OFF + AUX_BYTES, "nrm_phase LDS");
DI void nrm_phase(Frame& F, const bf16_t* base, const unsigned char* Y, const int* slot, bf16_t* xout, const float* g, bf16_t* XN, unsigned char* XN8,
                  const float* Wsrc, int ldw, int col0, float* outv, const float* b_i, const float* b_f) {
    LAS unsigned char* lds = F.lds;
    { f32x4 wv[16];
#pragma unroll
      for (int i = 0; i < 16; ++i) { const int idx = F.tid + i * NTHR, d = idx >> 3, e4 = idx & 7; wv[i] = *(const f32x4*)(Wsrc + (size_t)d * ldw + col0 + 4 * e4); }
#pragma unroll
      for (int i = 0; i < 16; ++i) { const int idx = F.tid + i * NTHR, d = idx >> 3, e4 = idx & 7;
#pragma unroll
          for (int q = 0; q < 4; ++q) *(LAS unsigned short*)(lds + NRM_WB + (4 * e4 + q) * NRM_WB_LD + d * 2) = (unsigned short)f2bf(wv[i][q]); } }
    const int gw = F.vcu * NWAVES + F.wave, NGW = F.G * NWAVES, lane = F.lane, fr = lane & 15, fq = lane >> 4;
    LAS unsigned char* xr = lds + NRM_XR + F.wave * 4 * NRM_XR_LD;
    f32x4 gg[4];
#pragma unroll
    for (int j = 0; j < 4; ++j) gg[j] = *((const f32x4*)g + lane + 64 * j);
    float bias[2]; bool isf[2];
#pragma unroll
    for (int n = 0; n < 2; ++n) { const int k = fr + 16 * n, kind = k >> 3, hd = k & 7, dir = kind >> 1; isf[n] = (kind & 1) != 0; bias[n] = isf[n] ? b_f[dir * 8 + hd] : b_i[dir * 8 + hd]; }
    __syncthreads();
#pragma unroll 1
    for (int m0 = gw; m0 < M; m0 += 4 * NGW) {
        f32x4 x[4][4]; int sl[4]; int mm[4];
#pragma unroll
        for (int t4 = 0; t4 < 4; ++t4) { const int m = m0 + t4 * NGW < M ? m0 + t4 * NGW : m0; mm[t4] = m;
#pragma unroll
            for (int j = 0; j < 4; ++j) { const u32x2 w = __builtin_nontemporal_load((const u32x2*)(base + (size_t)m * D) + lane + 64 * j);
                x[t4][j] = (f32x4){__builtin_bit_cast(float, w.x << 16), __builtin_bit_cast(float, w.x & 0xffff0000u), __builtin_bit_cast(float, w.y << 16), __builtin_bit_cast(float, w.y & 0xffff0000u)}; }
            sl[t4] = lane < NE ? slot[(size_t)m * NE + lane] : -1; }
#pragma unroll
        for (int t4 = 0; t4 < 4; ++t4) { const int m = mm[t4];
            add_routed_rows(x[t4], Y, sl[t4], m / SEQ, lane);
#pragma unroll
            for (int j = 0; j < 4; ++j) { u32x2 w; w.x = cvt_pk_bf16(x[t4][j].x, x[t4][j].y); w.y = cvt_pk_bf16(x[t4][j].z, x[t4][j].w); *((u32x2*)(xout + (size_t)m * D) + lane + 64 * j) = w;
                x[t4][j] = (f32x4){__builtin_bit_cast(float, w.x << 16), __builtin_bit_cast(float, w.x & 0xffff0000u), __builtin_bit_cast(float, w.y << 16), __builtin_bit_cast(float, w.y & 0xffff0000u)}; }
            float ss = 0.f;
#pragma unroll
            for (int j = 0; j < 4; ++j) ss += (x[t4][j].x * x[t4][j].x + x[t4][j].y * x[t4][j].y) + (x[t4][j].z * x[t4][j].z + x[t4][j].w * x[t4][j].w);
            const float rinv = __builtin_amdgcn_rsqf(wave_sum(ss) * (1.f / D) + RMS_EPS);
#pragma unroll
            for (int j = 0; j < 4; ++j) { const f32x4 hn = x[t4][j] * rinv * gg[j]; u32x2 w; w.x = cvt_pk_bf16(hn.x, hn.y); w.y = cvt_pk_bf16(hn.z, hn.w);
                *((u32x2*)(XN + (size_t)m * D) + lane + 64 * j) = w; *(LAS u32x2*)(xr + t4 * NRM_XR_LD + (4 * lane + 256 * j) * 2) = w;
                *((unsigned*)(XN8 + (size_t)m * D) + lane + 64 * j) = pk4_fp8(hn.x, hn.y, hn.z, hn.w); }
        }
        asm volatile("s_waitcnt lgkmcnt(0)" ::: "memory");
        f32x4 ga[2] = {(f32x4){0.f, 0.f, 0.f, 0.f}, (f32x4){0.f, 0.f, 0.f, 0.f}};
#pragma unroll 4
        for (int ks = 0; ks < 32; ++ks) {
            bf16x8 a = (bf16x8){0, 0, 0, 0, 0, 0, 0, 0};
            if (fr < 4) a = *(const LAS bf16x8*)(xr + fr * NRM_XR_LD + (32 * ks + 8 * fq) * 2);
            const bf16x8 b0 = *(const LAS bf16x8*)(lds + NRM_WB + fr * NRM_WB_LD + (32 * ks + 8 * fq) * 2), b1 = *(const LAS bf16x8*)(lds + NRM_WB + (16 + fr) * NRM_WB_LD + (32 * ks + 8 * fq) * 2);
            ga[0] = __builtin_amdgcn_mfma_f32_16x16x32_bf16(a, b0, ga[0], 0, 0, 0); ga[1] = __builtin_amdgcn_mfma_f32_16x16x32_bf16(a, b1, ga[1], 0, 0, 0);
        }
        if (fq == 0) {
#pragma unroll
            for (int n = 0; n < 2; ++n)
#pragma unroll
                for (int j = 0; j < 4; ++j) { const float v = ga[n][j] + bias[n]; outv[(size_t)mm[j] * 32 + fr + 16 * n] = isf[n] ? log_sigmoid(v) : v; } }
        asm volatile("" ::: "memory");
    }
}
DI int block_excl_scan(int v, LAS int* wsum, int lane, int wave, int& total) {
    int inc = v;
#pragma unroll
    for (int o = 1; o < 64; o <<= 1) { const int t = __shfl_up(inc, o); if (lane >= o) inc += t; }
    if (lane == 63) wsum[wave] = inc;
    __syncthreads();
    int basev = 0, tot = 0;
#pragma unroll
    for (int w = 0; w < NWAVES; ++w) { const int x = wsum[w]; basev += (w < wave) ? x : 0; tot += x; }
    __syncthreads();
    total = tot;
    return basev + inc - v;
}
DI void topk_phase(Frame& F, const float* part, int* idxrow, float* gate, float* rsc, int* slot) {
    LAS unsigned* hist = (LAS unsigned*)F.lds; LAS unsigned* sh = hist + 4096; LAS int* wsum = (LAS int*)(hist + 4112);
    const int tid = F.tid;
    for (int p = blockIdx.x; p < NB * NE; p += F.G) {
        const int b = p / NE, e = p % NE;
        unsigned v[8]; float rinv8[8];
        { const float* pb = part + (size_t)b * SEQ + 8 * tid;
          float ssum[8], mx[8], sm[8], lm[8];
#pragma unroll
          for (int i = 0; i < 8; ++i) { ssum[i] = 0.f; mx[i] = -__builtin_inff(); sm[i] = 0.f; lm[i] = 0.f; }
#pragma unroll
          for (int pn = 0; pn < 4; ++pn) { const f32x4 a0 = *(const f32x4*)(pb + (size_t)(pn * 17 + 16) * M), a1 = *(const f32x4*)(pb + (size_t)(pn * 17 + 16) * M + 4);
#pragma unroll
              for (int i = 0; i < 4; ++i) { ssum[i] += a0[i]; ssum[4 + i] += a1[i]; } }
#pragma unroll
          for (int i = 0; i < 8; ++i) rinv8[i] = __builtin_amdgcn_rsqf(ssum[i] * (1.f / D) + RMS_EPS);
#pragma unroll 4
          for (int ee = 0; ee < NE; ++ee) { float l[8];
#pragma unroll
              for (int i = 0; i < 8; ++i) l[i] = 0.f;
#pragma unroll
              for (int pn = 0; pn < 4; ++pn) { const f32x4 a0 = *(const f32x4*)(pb + (size_t)(pn * 17 + ee) * M), a1 = *(const f32x4*)(pb + (size_t)(pn * 17 + ee) * M + 4);
#pragma unroll
                  for (int i = 0; i < 4; ++i) { l[i] += a0[i]; l[4 + i] += a1[i]; } }
#pragma unroll
              for (int i = 0; i < 8; ++i) { const float li = l[i] * rinv8[i], mn = fmaxf(mx[i], li); sm[i] = sm[i] * __expf(mx[i] - mn) + __expf(li - mn); mx[i] = mn; lm[i] = ee == e ? li : lm[i]; } }
#pragma unroll
          for (int i = 0; i < 8; ++i) v[i] = __builtin_bit_cast(unsigned, __expf(lm[i] - mx[i]) / sm[i]); }
        unsigned prefix = 0u; int need = CAP;
#pragma unroll 1
        for (int pass = 0; pass < 3; ++pass) {
            const int shift = pass == 0 ? 20 : (pass == 1 ? 8 : 0), hs = pass == 0 ? 31 : (pass == 1 ? 20 : 8);
            *((LAS u32x4*)hist + 2 * tid) = (u32x4){0u, 0u, 0u, 0u}; *((LAS u32x4*)hist + 2 * tid + 1) = (u32x4){0u, 0u, 0u, 0u};
            __syncthreads();
#pragma unroll
            for (int i = 0; i < 8; ++i) if (pass == 0 || (v[i] >> hs) == prefix) __hip_atomic_fetch_add(&hist[(v[i] >> shift) & (pass == 2 ? 0xffu : 0xfffu)], 1u, __ATOMIC_RELAXED, __HIP_MEMORY_SCOPE_WORKGROUP);
            __syncthreads();
            const u32x4 c0 = *((const LAS u32x4*)hist + 2 * tid), c1 = *((const LAS u32x4*)hist + 2 * tid + 1);
            const int cnt[8] = {(int)c0.x, (int)c0.y, (int)c0.z, (int)c0.w, (int)c1.x, (int)c1.y, (int)c1.z, (int)c1.w};
            const int ls = ((cnt[0] + cnt[1]) + (cnt[2] + cnt[3])) + ((cnt[4] + cnt[5]) + (cnt[6] + cnt[7]));
            int tot; const int pre = block_excl_scan(ls, wsum, F.lane, F.wave, tot);
            int run = tot - pre - ls;
#pragma unroll
            for (int j = 7; j >= 0; --j) { if (run < need && run + cnt[j] >= need) { sh[0] = (unsigned)(8 * tid + j); sh[1] = (unsigned)(need - run); } run += cnt[j]; }
            __syncthreads();
            prefix = pass == 0 ? sh[0] : ((prefix << (pass == 1 ? 12 : 8)) | sh[0]); need = (int)sh[1];
        }
        const unsigned T = prefix;
        int ce = 0;
#pragma unroll
        for (int i = 0; i < 8; ++i) ce += (v[i] == T) ? 1 : 0;
        int tot;
        int eqr = block_excl_scan(ce, wsum, F.lane, F.wave, tot);
        unsigned selm = 0u; int cs = 0;
#pragma unroll
        for (int i = 0; i < 8; ++i) { bool sel = v[i] > T; if (v[i] == T) { sel = eqr < need; ++eqr; } if (sel) { selm |= 1u << i; ++cs; } }
        int pos = block_excl_scan(cs, wsum, F.lane, F.wave, tot);
#pragma unroll
        for (int i = 0; i < 8; ++i) { const int t = 8 * tid + i; int sv = -1;
            if (selm & (1u << i)) { const int row = (e * NB + b) * CAP + pos; idxrow[row] = b * SEQ + t; gate[row] = __builtin_bit_cast(float, v[i]); rsc[row] = rinv8[i]; sv = pos; ++pos; }
            slot[(size_t)(b * SEQ + t) * NE + e] = sv; }
        __syncthreads();
    }
}
DI void combine_phase(Frame& F, const bf16_t* base, const unsigned char* Y, const int* slot, float* out) {
    const int gw = F.vcu * NWAVES + F.wave, NGW = F.G * NWAVES, lane = F.lane;
    for (int m0 = gw; m0 < M; m0 += 4 * NGW) {
        f32x4 x[4][4]; int sl[4];
#pragma unroll
        for (int t4 = 0; t4 < 4; ++t4) { const int m = m0 + t4 * NGW < M ? m0 + t4 * NGW : m0;
#pragma unroll
            for (int j = 0; j < 4; ++j) { const u32x2 w = __builtin_nontemporal_load((const u32x2*)(base + (size_t)m * D) + lane + 64 * j);
                x[t4][j] = (f32x4){__builtin_bit_cast(float, w.x << 16), __builtin_bit_cast(float, w.x & 0xffff0000u), __builtin_bit_cast(float, w.y << 16), __builtin_bit_cast(float, w.y & 0xffff0000u)}; }
            sl[t4] = lane < NE ? slot[(size_t)m * NE + lane] : -1; }
#pragma unroll
        for (int t4 = 0; t4 < 4; ++t4) { const int m = m0 + t4 * NGW < M ? m0 + t4 * NGW : m0;
            add_routed_rows(x[t4], Y, sl[t4], m / SEQ, lane);
#pragma unroll
            for (int j = 0; j < 4; ++j) __builtin_nontemporal_store(x[t4][j], (f32x4*)(out + (size_t)m * D) + lane + 64 * j); }
    }
}
DI void moe_up_phase(Frame& F, unsigned char* ws, int l) {
    pg8::MoeUpOrder S{F.vcu, F.G, (const char*)(ws + WS_W13 + (size_t)l * W13_LAYER)};
    LAS int* il = (LAS int*)(F.lds + AUX_OFF); const int* idxrow = (const int*)(ws + WS_IDX);
    pg8::Unit u;
    LAS float* rl = (LAS float*)(F.lds + AUX_OFF + 8192); const float* rsc = (const float*)(ws + WS_RSC);
    for (int i = 0; i < 8 && S.next(i, u); ++i) { if (F.tid < 256) il[i * 256 + F.tid] = idxrow[u.pm * 256 + F.tid]; else rl[i * 256 + F.tid - 256] = rsc[u.pm * 256 + F.tid - 256]; }
    __syncthreads();
    pg8::EpiSwiGLU E{(unsigned char*)(ws + WS_H), rl};
    pg8::gemm_phase<pg8::EpiSwiGLU, pg8::MoeUpOrder, true, true, true>(F.lds, il, (const void*)(ws + WS_XN8), D, S, E);
}
DI void moe_down_phase(Frame& F, unsigned char* ws, int l) {
    pg8::MoeDownOrder S{F.vcu, F.G, (const char*)(ws + WS_W2 + (size_t)l * W2_LAYER)};
    pg8::EpiFp8 E{ws + WS_Y, D, (const float*)(ws + WS_GATE), 0.03125f * YS8};
    pg8::gemm_phase<pg8::EpiFp8, pg8::MoeDownOrder, false, true, true>(F.lds, nullptr, (const void*)(ws + WS_H), DE, S, E);
}

DI int off128r(int row, int chunk) { return row * 128 + ((chunk ^ ((row >> 1) & 7)) << 4); }
DI int off128t(int row, int colbyte) { return row * 128 + (colbyte ^ (((row >> 1) & 1) << 6)); }
DI int off256t(int row, int colbyte) { return row * 256 + (colbyte ^ ((row & 3) << 6)); }
DI float wave_max(float v) {
#pragma unroll
    for (int o = 1; o < 64; o <<= 1) v = fmaxf(v, __shfl_xor(v, o));
    return v;
}
DI float incl_prefix(float v, int lane) {
#pragma unroll
    for (int o = 1; o < 64; o <<= 1) { const float t = __shfl_up(v, o); if (lane >= o) v += t; }
    return v;
}
DI float incl_suffix(float v, int lane) {
#pragma unroll
    for (int o = 1; o < 64; o <<= 1) { const float t = __shfl_down(v, o); if (lane + o < 64) v += t; }
    return v;
}
DI u32x4 scale_bf16x8(u32x4 v, float w) {
    u32x4 o;
#pragma unroll
    for (int i = 0; i < 4; ++i) { const float lo = __builtin_bit_cast(float, v[i] << 16) * w, hi = __builtin_bit_cast(float, v[i] & 0xffff0000u) * w; o[i] = cvt_pk_bf16(lo, hi); }
    return o;
}
constexpr int SS_KW = 0, SS_V = 32768, SS_WS = 98304, SS_SC = 114688;
DI int ss_kw_off(int row, int colbyte) { return row * 128 + (colbyte ^ ((((row >> 1) & 1) | (((row >> 3) & 1) << 1)) << 5)); }
DI int ss_v_off(int row, int colbyte) { return row * 256 + (colbyte ^ ((row & 3) << 6) ^ (((row >> 3) & 1) << 5)); }
template <int ES> DI void mlstm_scan_seq(Frame& F, unsigned char* ws, int seq, int half) {
    static_assert(ES == 2, "the fp8 v tile staging is written for two workgroups per sequence");
    constexpr int NT = 4 / ES, VB = 16384 / ES; const int eoff = half * (128 / ES); const unsigned char* PV = ws + WS_PVO;
    LAS unsigned char* lds = F.lds;
    const bf16_t* P = (const bf16_t*)(ws + WS_PROJ); const float* MG = (const float*)(ws + WS_MG);
    bf16_t* STATE = (bf16_t*)(ws + WS_STATE); float* NST = (float*)(ws + WS_NST); float* MST = (float*)(ws + WS_MST);
    const int tid = F.tid, lane = F.lane, wave = F.wave, fr = lane & 15, fq = lane >> 4;
    LAS float* WS = (LAS float*)(lds + SS_WS); LAS float* ML = (LAS float*)(lds + SS_SC); LAS float* BL = ML + 64; LAS float* DEC = ML + 128; LAS float* LINJ = ML + 192; LAS float* MENT = ML + 256;
    {
        const int dir = seq >> 5, bh = seq & 31, b = bh >> 3, hd = bh & 7;
        __syncthreads();
        float igv[8], lfv[8];
#pragma unroll
        for (int i = 0; i < 8; ++i) { const float* mg = MG + ((size_t)b * SEQ + 64 * (8 * wave + i) + lane) * 32 + hd; igv[i] = mg[dir ? 16 : 0]; lfv[i] = mg[dir ? 24 : 8]; }
#pragma unroll
        for (int i = 0; i < 8; ++i) { const int c = 8 * wave + i; const float ig = igv[i], lf = lfv[i];
            float g, bl;
            if (dir == 0) { const float bf = incl_prefix(lf, lane); bl = __shfl(bf, 63); g = bl - bf + ig; }
            else { const float sb = incl_suffix(lf, lane); bl = __shfl(sb, 0); g = (bl - sb) + ig; }
            const float ml = wave_max(g);
            WS[c * 64 + lane] = g - ml; if (lane == 0) { ML[c] = ml; BL[c] = bl; } }
        __syncthreads();
        if (wave == 0) { const int cl = dir ? 63 - lane : lane; const float mlv = ML[cl], blv = BL[cl];
            float m = 0.f, dec = 0.f, linj = 0.f, ment = 0.f;
            for (int k = 0; k < 64; ++k) { const float ml = __shfl(mlv, k), bl = __shfl(blv, k); const float mn = fmaxf(bl + m, ml);
                if (lane == k) { dec = __expf(bl + m - mn); linj = ml - mn; ment = m; } m = mn; }
            DEC[lane] = dec; LINJ[cl] = linj; MENT[lane] = ment;
            if (half == 0) MST[(size_t)seq * 64 + cl] = ment; }
        __syncthreads();
#pragma unroll
        for (int i = 0; i < 8; ++i) { const int idx = tid + i * NTHR; WS[idx] = __expf(WS[idx] + LINJ[idx >> 6]); }
        const int krow = tid >> 3, kc = tid & 7;
        const int eh = wave >> 2, dt = wave & 3;
        f32x4 C[NT], Nacc = (f32x4){0.f, 0.f, 0.f, 0.f};
#pragma unroll
        for (int i = 0; i < NT; ++i) C[i] = (f32x4){0.f, 0.f, 0.f, 0.f};
        const bf16x8 ones = (bf16x8){0x3f80, 0x3f80, 0x3f80, 0x3f80, 0x3f80, 0x3f80, 0x3f80, 0x3f80};
        const size_t tokb = (size_t)b * SEQ;
        u32x4 kreg[2][2], vreg[2][2][2 / ES];
#define SS_LOAD(st_, kp_) do { _Pragma("unroll") for (int sb_ = 0; sb_ < 2; ++sb_) { const int kk_ = 2 * (kp_) + sb_; const int cn_ = dir ? 63 - kk_ : kk_; \
            kreg[st_][sb_] = *(const u32x4*)(P + (tokb + 64 * cn_ + krow) * MIN_N + 512 + hd * 64 + kc * 8); \
            vreg[st_][sb_][0] = *(const u32x4*)(PV + (tokb + 64 * cn_ + ((tid & 255) >> 2)) * 2048 + hd * 128 + eoff + (tid & 3) * 16); } } while (0)
#define SS_PAIR(st, kp) do { const int buf = (kp) & 1; \
            _Pragma("unroll") for (int sb = 0; sb < 2; ++sb) { const int k = 2 * (kp) + sb, c = dir ? 63 - k : k; \
                *(LAS u32x4*)(lds + SS_KW + (buf * 2 + sb) * 8192 + ss_kw_off(krow, kc * 16)) = scale_bf16x8(kreg[st][sb], WS[c * 64 + krow]); \
                if (tid < 256) { u32x4 v0_, v1_; fp8x16_to_bf16(vreg[st][sb][0], v0_, v1_); const int vr = tid >> 2, vc2 = 2 * (tid & 3); \
                    *(LAS u32x4*)(lds + SS_V + (buf * 2 + sb) * VB + ss_kw_off(vr, vc2 * 16)) = v0_; *(LAS u32x4*)(lds + SS_V + (buf * 2 + sb) * VB + ss_kw_off(vr, (vc2 + 1) * 16)) = v1_; } } \
            if ((kp) + 2 < 32) SS_LOAD(st, (kp) + 2); \
            asm volatile("s_waitcnt lgkmcnt(0)" ::: "memory"); __builtin_amdgcn_s_barrier(); asm volatile("" ::: "memory"); \
            _Pragma("unroll") for (int sb = 0; sb < 2; ++sb) { const int k = 2 * (kp) + sb, c = dir ? 63 - k : k; \
                _Pragma("unroll") for (int i = 0; i < NT; ++i) { u32x2 w; w.x = cvt_pk_bf16(C[i].x, C[i].y); w.y = cvt_pk_bf16(C[i].z, C[i].w); \
                    *(u32x2*)(STATE + ((size_t)seq * 64 + c) * 8192 + (size_t)(eoff + 16 * (eh + 2 * i) + fr) * 64 + 16 * dt + 4 * fq) = w; } \
                if (half == 0 && eh == 0 && fr == 0) *(f32x4*)(NST + ((size_t)seq * 64 + c) * 64 + 16 * dt + 4 * fq) = Nacc; \
                const float dec = DEC[k]; Nacc = Nacc * dec; \
                _Pragma("unroll") for (int i = 0; i < NT; ++i) C[i] = C[i] * dec; \
                _Pragma("unroll") for (int s2 = 0; s2 < 2; ++s2) { \
                    const int r0 = 32 * s2 + 8 * fq + ((lane & 15) >> 2), r1 = r0 + 4, cbk = 32 * dt + 8 * (lane & 3); \
                    const bf16x8 af = cat8(tr_read(lds + SS_KW + (buf * 2 + sb) * 8192 + ss_kw_off(r0, cbk)), tr_read(lds + SS_KW + (buf * 2 + sb) * 8192 + ss_kw_off(r1, cbk))); \
                    _Pragma("unroll") for (int i = 0; i < NT; ++i) { const int cbv = 32 * (eh + 2 * i) + 8 * (lane & 3); \
                        const bf16x8 bfv = cat8(tr_read(lds + SS_V + (buf * 2 + sb) * VB + (ES == 1 ? ss_v_off(r0, cbv) : ss_kw_off(r0, cbv))), tr_read(lds + SS_V + (buf * 2 + sb) * VB + (ES == 1 ? ss_v_off(r1, cbv) : ss_kw_off(r1, cbv)))); \
                        C[i] = __builtin_amdgcn_mfma_f32_16x16x32_bf16(af, bfv, C[i], 0, 0, 0); } \
                    if (eh == 0) Nacc = __builtin_amdgcn_mfma_f32_16x16x32_bf16(af, ones, Nacc, 0, 0, 0); } } } while (0)
        SS_LOAD(0, 0); SS_LOAD(1, 1);
        __syncthreads();
#pragma unroll 1
        for (int kp2 = 0; kp2 < 32; kp2 += 2) { SS_PAIR(0, kp2); SS_PAIR(1, kp2 + 1); }
#undef SS_PAIR
#undef SS_LOAD
    }
}
constexpr int SCAN_ES = 2, SCAN_WGS = 64 * SCAN_ES, SCAN_STRIDE = 256 / SCAN_WGS;
DI void mlstm_scan_phase(Frame& F, const Args& a) {
    if (F.G == 256) {
        if (F.vcu % SCAN_STRIDE == 0) { const int sw = F.vcu / SCAN_STRIDE; mlstm_scan_seq<SCAN_ES>(F, a.ws, sw / SCAN_ES, sw % SCAN_ES); }
        else expert_conv_items(F, a, XI_C_END, XI_TOTAL, ((F.vcu / SCAN_STRIDE) * (SCAN_STRIDE - 1) + F.vcu % SCAN_STRIDE - 1) * NWAVES + F.wave, (256 - SCAN_WGS) * NWAVES);
    } else {
        for (int sw = F.vcu; sw < SCAN_WGS; sw += F.G) mlstm_scan_seq<SCAN_ES>(F, a.ws, sw / SCAN_ES, sw % SCAN_ES);
        if (F.vcu == 0) expert_conv_items(F, a, XI_C_END, XI_TOTAL, F.wave, NWAVES);
    }
}
constexpr int S3_Q = 0, S3_KF = 8192, S3_KB = 16384, S3_V = 24576, S3_CF = 40960, S3_CB = 57344, S3_HS = 73728, S3_HS_LD = 132, S3_SM = 108544;
DI float incl_prefix_max(float v, int lane) {
#pragma unroll
    for (int o = 1; o < 64; o <<= 1) { const float t = __shfl_up(v, o); if (lane >= o) v = fmaxf(v, t); }
    return v;
}
DI float incl_suffix_max(float v, int lane) {
#pragma unroll
    for (int o = 1; o < 64; o <<= 1) { const float t = __shfl_down(v, o); if (lane + o < 64) v = fmaxf(v, t); }
    return v;
}
DI void mlstm_s3_phase(Frame& F, const Args& a) {
    unsigned char* ws = a.ws; LAS unsigned char* lds = F.lds;
    const bf16_t* P = (const bf16_t*)(ws + WS_PROJ); const float* MG = (const float*)(ws + WS_MG);
    const bf16_t* STATE = (const bf16_t*)(ws + WS_STATE); const float* NST = (const float*)(ws + WS_NST); const float* MST = (const float*)(ws + WS_MST);
    bf16_t* Y2 = (bf16_t*)(ws + WS_Y2); const float* outg = a.in[IN_MOG];
    const int tid = F.tid, lane = F.lane, wave = F.wave, r = lane & 31, h = lane >> 5;
    const int q4 = (lane & 15) >> 2, p4 = lane & 3, blk = (lane >> 4) & 1;
    LAS float* ALPHA = (LAS float*)(lds + S3_SM); LAS float* EA = ALPHA + 128; LAS float* EMT = ALPHA + 256; LAS unsigned short* NB16 = (LAS unsigned short*)(ALPHA + 384);
    LAS float* HS = (LAS float*)(lds + S3_HS);
    const unsigned char* PV = ws + WS_PVO;
    u32x4 rq, rk, rv, rcf[2], rcb[2], rog; float pg[4], pn[2], pm_f = 0.f, pm_b = 0.f;
#define S3_LOAD(u_) do { const int c_ = (u_) & 63, bh_ = (u_) >> 6, b_ = bh_ >> 3, hd_ = bh_ & 7; const size_t tk_ = (size_t)b_ * SEQ + 64 * c_; \
        { const int row = tid >> 3, kc = tid & 7; rq = *(const u32x4*)(P + (tk_ + row) * MIN_N + hd_ * 64 + kc * 8); rk = *(const u32x4*)(P + (tk_ + row) * MIN_N + 512 + hd_ * 64 + kc * 8); } \
        rv = *(const u32x4*)(PV + (tk_ + (tid >> 3)) * 2048 + hd_ * 128 + (tid & 7) * 16); \
        _Pragma("unroll") for (int i = 0; i < 2; ++i) { const int idx = tid + i * NTHR; \
            rcf[i] = __builtin_nontemporal_load((const u32x4*)(STATE + ((size_t)(0 * 32 + bh_) * 64 + c_) * 8192) + idx); rcb[i] = __builtin_nontemporal_load((const u32x4*)(STATE + ((size_t)(1 * 32 + bh_) * 64 + c_) * 8192) + idx); } \
        rog = *(const u32x4*)(PV + (tk_ + (tid >> 3)) * 2048 + 1024 + hd_ * 128 + (tid & 7) * 16); \
        pm_f = MST[(size_t)(0 * 32 + bh_) * 64 + c_]; pm_b = MST[(size_t)(1 * 32 + bh_) * 64 + c_]; \
        { const float* mg = MG + (tk_ + lane) * 32; pg[0] = mg[hd_]; pg[1] = mg[8 + hd_]; pg[2] = mg[16 + hd_]; pg[3] = mg[24 + hd_]; \
          pn[0] = NST[((size_t)(0 * 32 + bh_) * 64 + c_) * 64 + lane]; pn[1] = NST[((size_t)(1 * 32 + bh_) * 64 + c_) * 64 + lane]; } } while (0)
    if (F.vcu < 2048) S3_LOAD(F.vcu);
    for (int u = F.vcu; u < 2048; u += F.G) {
        const int c = u & 63, bh = u >> 6, b = bh >> 3, hd = bh & 7; const size_t tok0 = (size_t)b * SEQ + 64 * c;
        const float m_f = pm_f, m_b = pm_b;
        const float bf = incl_prefix(pg[1], lane), uf = pg[0] - bf, umf = wave_max(uf), cmf = incl_prefix_max(uf, lane);
        const float sb = incl_suffix(pg[3], lane), ub = pg[2] - sb, umb = wave_max(ub), cmb = incl_suffix_max(ub, lane);
        const float beta_f = __expf(uf - umf), beta_b = __expf(ub - umb);
        const float af_ = bf + m_f, mtf = fmaxf(af_, bf + cmf), ab_ = sb + m_b, mtb = fmaxf(ab_, sb + cmb);
        __syncthreads();
        if (wave == 0) { ALPHA[lane] = __expf(bf + umf - mtf); EA[lane] = __expf(af_ - mtf); EMT[lane] = __expf(-mtf);
            ALPHA[64 + lane] = __expf(sb + umb - mtb); EA[64 + lane] = __expf(ab_ - mtb); EMT[64 + lane] = __expf(-mtb);
            NB16[lane] = (unsigned short)f2bf(pn[0]); NB16[64 + lane] = (unsigned short)f2bf(pn[1]); }
        { const int row = tid >> 3, kc = tid & 7; const float wf = __shfl(beta_f, row & 63), wb = __shfl(beta_b, row & 63);
          *(LAS u32x4*)(lds + S3_Q + off128r(row, kc)) = rq;
          *(LAS u32x4*)(lds + S3_KF + off128r(row, kc)) = scale_bf16x8(rk, wf); *(LAS u32x4*)(lds + S3_KB + off128r(row, kc)) = scale_bf16x8(rk, wb); }
#pragma unroll
        for (int i = 0; i < 2; ++i) { const int idx = tid + i * NTHR, erow = idx >> 3, ec = idx & 7;
            *(LAS u32x4*)(lds + S3_CF + off128r(erow, ec)) = rcf[i]; *(LAS u32x4*)(lds + S3_CB + off128r(erow, ec)) = rcb[i]; }
        { u32x4 v0_, v1_; fp8x16_to_bf16(rv, v0_, v1_); const int vr = tid >> 3, vc2 = 2 * (tid & 7);
          *(LAS u32x4*)(lds + S3_V + off256t(vr, vc2 * 16)) = v0_; *(LAS u32x4*)(lds + S3_V + off256t(vr, (vc2 + 1) * 16)) = v1_; }
        u32x4 og0, og1; fp8x16_to_bf16(rog, og0, og1);
        if (u + F.G < 2048) S3_LOAD(u + F.G);
        __syncthreads();
        const int et = wave >> 1, tt = wave & 1, t = 32 * tt + r;
        bf16x8 qf[4];
#pragma unroll
        for (int s4 = 0; s4 < 4; ++s4) qf[s4] = *(const LAS bf16x8*)(lds + S3_Q + off128r(t, 2 * s4 + h));
        f32x16 pF, pB, pO;
#pragma unroll
        for (int i = 0; i < 16; ++i) { pF[i] = 0.f; pB[i] = 0.f; pO[i] = 0.f; }
        const int so = 1 - tt; const int koff = tt == 0 ? S3_KB : S3_KF;
#pragma unroll
        for (int s4 = 0; s4 < 4; ++s4) {
            const bf16x8 kF = *(const LAS bf16x8*)(lds + S3_KF + off128r(32 * tt + r, 2 * s4 + h)), kB = *(const LAS bf16x8*)(lds + S3_KB + off128r(32 * tt + r, 2 * s4 + h));
            const bf16x8 kO = *(const LAS bf16x8*)(lds + koff + off128r(32 * so + r, 2 * s4 + h));
            pF = __builtin_amdgcn_mfma_f32_32x32x16_bf16(kF, qf[s4], pF, 0, 0, 0);
            pB = __builtin_amdgcn_mfma_f32_32x32x16_bf16(kB, qf[s4], pB, 0, 0, 0);
            pO = __builtin_amdgcn_mfma_f32_32x32x16_bf16(kO, qf[s4], pO, 0, 0, 0);
        }
        float rsF = 0.f, rsB = 0.f, rsO = 0.f;
#pragma unroll
        for (int i = 0; i < 16; ++i) { const int sl_ = (i & 3) + 8 * (i >> 2) + 4 * h;
            pF[i] = sl_ <= r ? pF[i] : 0.f; pB[i] = sl_ >= r ? pB[i] : 0.f; rsF += pF[i]; rsB += pB[i]; rsO += pO[i]; }
        rsF += __shfl_xor(rsF, 32); rsB += __shfl_xor(rsB, 32); rsO += __shfl_xor(rsO, 32);
        if (tt == 0) rsB += rsO; else rsF += rsO;
        asm volatile("" ::: "memory");
        float qnf, qnb;
        {   f32x16 qn;
#pragma unroll
            for (int i = 0; i < 16; ++i) qn[i] = 0.f;
#pragma unroll
            for (int s4 = 0; s4 < 4; ++s4) { const bf16x8 nF = *(const LAS bf16x8*)(NB16 + 16 * s4 + 8 * h); qn = __builtin_amdgcn_mfma_f32_32x32x16_bf16(nF, qf[s4], qn, 0, 0, 0); }
            qnf = qn[0];
#pragma unroll
            for (int i = 0; i < 16; ++i) qn[i] = 0.f;
#pragma unroll
            for (int s4 = 0; s4 < 4; ++s4) { const bf16x8 nB = *(const LAS bf16x8*)(NB16 + 64 + 16 * s4 + 8 * h); qn = __builtin_amdgcn_mfma_f32_32x32x16_bf16(nB, qf[s4], qn, 0, 0, 0); }
            qnb = qn[0]; }
        const float alF = ALPHA[t], eaF = EA[t], emF = EMT[t], alB = ALPHA[64 + t], eaB = EA[64 + t], emB = EMT[64 + t];
        const float invF = 1.f / fmaxf(fabsf(eaF * qnf + alF * rsF), emF), invB = 1.f / fmaxf(fabsf(eaB * qnb + alB * rsB), emB);
        asm volatile("" ::: "memory");
        f32x16 hs;
        const int cbv = 64 * et + 32 * blk + 8 * p4;
        {   f32x16 it, in;
#pragma unroll
            for (int i = 0; i < 16; ++i) { it[i] = 0.f; in[i] = 0.f; }
#pragma unroll
            for (int s4 = 0; s4 < 4; ++s4) { const bf16x8 cF = *(const LAS bf16x8*)(lds + S3_CF + off128r(32 * et + r, 2 * s4 + h)); it = __builtin_amdgcn_mfma_f32_32x32x16_bf16(cF, qf[s4], it, 0, 0, 0); }
#pragma unroll
            for (int s2 = 0; s2 < 2; ++s2) { const int rd0 = 32 * tt + 16 * s2 + 4 * h + q4;
                const bf16x8 vD = cat8(tr_read(lds + S3_V + off256t(rd0, cbv)), tr_read(lds + S3_V + off256t(rd0 + 8, cbv)));
                in = __builtin_amdgcn_mfma_f32_32x32x16_bf16(vD, pack_step(pF, s2), in, 0, 0, 0);
                if (tt == 1) { const int ro0 = 16 * s2 + 4 * h + q4; const bf16x8 vO = cat8(tr_read(lds + S3_V + off256t(ro0, cbv)), tr_read(lds + S3_V + off256t(ro0 + 8, cbv)));
                    in = __builtin_amdgcn_mfma_f32_32x32x16_bf16(vO, pack_step(pO, s2), in, 0, 0, 0); } }
#pragma unroll
            for (int i = 0; i < 16; ++i) hs[i] = (eaF * it[i] + alF * in[i]) * invF;
        }
        asm volatile("" ::: "memory");
        {   f32x16 it, in;
#pragma unroll
            for (int i = 0; i < 16; ++i) { it[i] = 0.f; in[i] = 0.f; }
#pragma unroll
            for (int s4 = 0; s4 < 4; ++s4) { const bf16x8 cB = *(const LAS bf16x8*)(lds + S3_CB + off128r(32 * et + r, 2 * s4 + h)); it = __builtin_amdgcn_mfma_f32_32x32x16_bf16(cB, qf[s4], it, 0, 0, 0); }
#pragma unroll
            for (int s2 = 0; s2 < 2; ++s2) { const int rd0 = 32 * tt + 16 * s2 + 4 * h + q4;
                const bf16x8 vD = cat8(tr_read(lds + S3_V + off256t(rd0, cbv)), tr_read(lds + S3_V + off256t(rd0 + 8, cbv)));
                in = __builtin_amdgcn_mfma_f32_32x32x16_bf16(vD, pack_step(pB, s2), in, 0, 0, 0);
                if (tt == 0) { const int ro0 = 32 + 16 * s2 + 4 * h + q4; const bf16x8 vO = cat8(tr_read(lds + S3_V + off256t(ro0, cbv)), tr_read(lds + S3_V + off256t(ro0 + 8, cbv)));
                    in = __builtin_amdgcn_mfma_f32_32x32x16_bf16(vO, pack_step(pO, s2), in, 0, 0, 0); } }
#pragma unroll
            for (int i = 0; i < 16; ++i) hs[i] += (eaB * it[i] + alB * in[i]) * invB;
        }
#pragma unroll
        for (int i = 0; i < 16; ++i) HS[t * S3_HS_LD + 32 * et + (i & 3) + 8 * (i >> 2) + 4 * h] = hs[i];
        __syncthreads();
        { const int tr = tid >> 3, e0 = (tid & 7) * 16; float vv[16]; float ss = 0.f;
#pragma unroll
          for (int i = 0; i < 4; ++i) { const f32x4 x = *(const LAS f32x4*)(HS + tr * S3_HS_LD + e0 + 4 * i); vv[4 * i] = x[0]; vv[4 * i + 1] = x[1]; vv[4 * i + 2] = x[2]; vv[4 * i + 3] = x[3]; ss += (x[0] * x[0] + x[1] * x[1]) + (x[2] * x[2] + x[3] * x[3]); }
          ss += __shfl_xor(ss, 1); ss += __shfl_xor(ss, 2); ss += __shfl_xor(ss, 4);
          const float rinv = __builtin_amdgcn_rsqf(ss * (1.f / 128.f) + RMS_EPS);
          unsigned ow[8];
#pragma unroll
          for (int i = 0; i < 8; ++i) { const unsigned w = i < 4 ? og0[i] : og1[i - 4];
              const float o0 = __builtin_bit_cast(float, w << 16), o1 = __builtin_bit_cast(float, w & 0xffff0000u);
              const float g0 = outg[hd * 128 + e0 + 2 * i], g1 = outg[hd * 128 + e0 + 2 * i + 1];
              const float y0 = vv[2 * i] * rinv * g0 / (1.f + __expf(-o0)), y1 = vv[2 * i + 1] * rinv * g1 / (1.f + __expf(-o1));
              ow[i] = cvt_pk_bf16(y0, y1); }
          bf16_t* yp = Y2 + (tok0 + tr) * D + hd * 128 + e0;
          *(u32x4*)yp = (u32x4){ow[0], ow[1], ow[2], ow[3]}; *(u32x4*)(yp + 8) = (u32x4){ow[4], ow[5], ow[6], ow[7]}; }
    }
#undef S3_LOAD
}

__global__ void __launch_bounds__(NTHR, 2) fwd_kernel(Args args) {
    extern __shared__ __attribute__((aligned(16))) unsigned char lds_raw[];
    Frame F;
    F.lds = (LAS unsigned char*)lds_raw;
    F.MISC = (volatile LAS unsigned*)(F.lds + MISC_OFF);
    F.tid = threadIdx.x; F.lane = F.tid & 63; F.wave = __builtin_amdgcn_readfirstlane(F.tid >> 6);
    F.G = gridDim.x; { const int bx = blockIdx.x; F.vcu = (F.G % 8 == 0) ? (bx % 8) * (F.G / 8) + bx / 8 : bx; }
    F.ctl = (unsigned*)(args.ws + WS_CTL);
    if (F.tid < 64) F.MISC[F.tid] = 0u;
    __syncthreads();
    XcdBarrier bar = xcd_barrier_post(F.ctl + CW_BAR, F.MISC + 8);
    const int lo = args.ph_lo, hi = args.ph_hi;
    unsigned char* ws = args.ws;
#define IN(k) (lo <= (k) && (k) < hi)
#define SEAM(k) do { if (IN(k) && IN((k) + 1)) xcd_barrier(bar); } while (0)

    if (IN(0)) { p0_prologue(F, args); } SEAM(0);
    if (IN(1)) {
        pg8::DenseOrder8 S; S.init(M, NQKV, F.G, (int)blockIdx.x, (const bf16_t*)(ws + WS_WQKV), D);
        pg8::EpiQKV E{(bf16_t*)(ws + WS_Q), (bf16_t*)(ws + WS_K), (bf16_t*)(ws + WS_V), args.in[IN_AQG], args.in[IN_AKG]};
        pg8::gemm_phase<pg8::EpiQKV, pg8::DenseOrder8, false, true, true>(F.lds, nullptr, (const void*)(ws + WS_XN8), D, S, E);
        if ((int)blockIdx.x >= 128 && F.G == 256) expert_conv_items(F, args, XI_PRO_END, XI_A_END, ((int)blockIdx.x - 128) * NWAVES + F.wave, 128 * NWAVES);
        else if (F.G != 256 && (int)blockIdx.x == 0) expert_conv_items(F, args, XI_PRO_END, XI_A_END, F.wave, NWAVES);
    } SEAM(1);
    if (IN(2)) { attn_phase(F, args); } SEAM(2);
    if (IN(3)) {
        pg8::DenseOrder8 S; S.init(M, D, F.G, (int)blockIdx.x, (const bf16_t*)(ws + WS_WAO), D);
        if (F.G == 256) { pg8::EpiResRoute<false> E{args.in[IN_X], (bf16_t*)(ws + WS_X1), ws + WS_XN8, (float*)(ws + WS_PART), args.in[IN_FNG], args.in[IN_RW], 1.f / 256.f};
            pg8::gemm_phase<pg8::EpiResRoute<false>, pg8::DenseOrder8, false, false, true>(F.lds, nullptr, (const void*)(ws + WS_O), D, S, E); }
        else { pg8::EpiRes<false, true> E{args.in[IN_X], (void*)(ws + WS_X1), D, 1.f / 256.f};
            pg8::gemm_phase<pg8::EpiRes<false, true>, pg8::DenseOrder8, false, false, true>(F.lds, nullptr, (const void*)(ws + WS_O), D, S, E); }
    } SEAM(3);
    if (IN(4) && F.G != 256) { nr_phase<16, false>(F, (const bf16_t*)(ws + WS_X1), nullptr, nullptr, nullptr, args.in[IN_FNG], nullptr, (unsigned char*)(ws + WS_XN8), args.in[IN_RW], NE, 0, (float*)(ws + WS_PART), nullptr, nullptr); }
    if (F.G != 256) SEAM(4);
    if (IN(5)) { topk_phase(F, (const float*)(ws + WS_PART), (int*)(ws + WS_IDX), (float*)(ws + WS_GATE), (float*)(ws + WS_RSC), (int*)(ws + WS_SLOT));
        if ((int)blockIdx.x >= 64) expert_conv_items(F, args, XI_A_END, XI_B_END, ((int)blockIdx.x - 64) * NWAVES + F.wave, (F.G - 64) * NWAVES); } SEAM(5);
    if (IN(6)) { moe_up_phase(F, ws, 0); } SEAM(6);
    if (IN(7)) { moe_down_phase(F, ws, 0); } SEAM(7);
    if (IN(8)) { nrm_phase(F, (const bf16_t*)(ws + WS_X1), (const unsigned char*)(ws + WS_Y), (const int*)(ws + WS_SLOT), (bf16_t*)(ws + WS_X2), args.in[IN_MNG], (bf16_t*)(ws + WS_XN), ws + WS_XN8,
                           args.in[IN_MWIN], MIN_LD, MIN_N, (float*)(ws + WS_MG), args.in[IN_MBI], args.in[IN_MBF]); } SEAM(8);
    if (IN(9)) {
        { pg8::DenseOrder S; S.init(M, 1024, F.G, (int)blockIdx.x, (const bf16_t*)(ws + WS_WMIN), D);
          pg8::EpiBf16 E{(bf16_t*)(ws + WS_PROJ), MIN_N, nullptr, 1.f, 0};
          pg8::gemm_phase<pg8::EpiBf16, pg8::DenseOrder, false, true, false>(F.lds, nullptr, (const bf16_t*)(ws + WS_XN), D, S, E); }
        { pg8::DenseOrder8 S; S.init(M, 2048, F.G, (int)blockIdx.x, (const bf16_t*)(ws + WS_WMIN8), D);
          pg8::EpiFp8 E{ws + WS_PVO, 2048, nullptr, 0.0625f};
          pg8::gemm_phase<pg8::EpiFp8, pg8::DenseOrder8, false, true, true>(F.lds, nullptr, (const void*)(ws + WS_XN8), D, S, E); }
    } SEAM(9);
    if (IN(10)) { mlstm_scan_phase(F, args); } SEAM(10);
    if (IN(12)) { mlstm_s3_phase(F, args); } SEAM(12);
    if (IN(13)) {
        pg8::DenseOrder S; S.init(M, D, F.G, (int)blockIdx.x, (const bf16_t*)(ws + WS_WMO), D);
        if (F.G == 256) { pg8::EpiResRoute<true> E{(const void*)(ws + WS_X2), (bf16_t*)(ws + WS_X3), ws + WS_XN8, (float*)(ws + WS_PART), args.in[IN_FNG] + D, args.in[IN_RW] + D * NE, 1.f};
            pg8::gemm_phase<pg8::EpiResRoute<true>, pg8::DenseOrder, false, false, false>(F.lds, nullptr, (const bf16_t*)(ws + WS_Y2), D, S, E); }
        else { pg8::EpiRes<true, true> E{(const void*)(ws + WS_X2), (void*)(ws + WS_X3), D, 1.f};
            pg8::gemm_phase<pg8::EpiRes<true, true>, pg8::DenseOrder, false, false, false>(F.lds, nullptr, (const bf16_t*)(ws + WS_Y2), D, S, E); }
    } SEAM(13);
    if (IN(14) && F.G != 256) { nr_phase<16, false>(F, (const bf16_t*)(ws + WS_X3), nullptr, nullptr, nullptr, args.in[IN_FNG] + D, nullptr, (unsigned char*)(ws + WS_XN8), args.in[IN_RW] + D * NE, NE, 0, (float*)(ws + WS_PART), nullptr, nullptr); }
    if (F.G != 256) SEAM(14);
    if (IN(15)) { topk_phase(F, (const float*)(ws + WS_PART), (int*)(ws + WS_IDX), (float*)(ws + WS_GATE), (float*)(ws + WS_RSC), (int*)(ws + WS_SLOT));
        if ((int)blockIdx.x >= 64) expert_conv_items(F, args, XI_C_END - XI_NC, XI_C_END, ((int)blockIdx.x - 64) * NWAVES + F.wave, (F.G - 64) * NWAVES); } SEAM(15);
    if (IN(16)) { moe_up_phase(F, ws, 1); } SEAM(16);
    if (IN(17)) { moe_down_phase(F, ws, 1); } SEAM(17);
    if (IN(18)) { combine_phase(F, (const bf16_t*)(ws + WS_X3), (const unsigned char*)(ws + WS_Y), (const int*)(ws + WS_SLOT), args.out); }
#undef IN
#undef SEAM
}

extern "C" void kernel_launch(void* const* d_in, const int* in_sizes, int n_in, void* d_out, int out_size, void* d_ws, size_t ws_size, hipStream_t stream) {
    static int grid = 0;
    if (grid == 0) {
        if (n_in != 19 || out_size != M * D || ws_size < WS_END) { fprintf(stderr, "kernel_launch: unexpected problem (n_in %d, out %d, ws %zu)\n", n_in, out_size, ws_size); grid = -1; return; }
        int dev = 0, cus = 0, per_cu = 0;
        if (hipGetDevice(&dev) != hipSuccess || hipDeviceGetAttribute(&cus, hipDeviceAttributeMultiprocessorCount, dev) != hipSuccess) { grid = -1; return; }
        if (hipFuncSetAttribute((const void*)fwd_kernel, hipFuncAttributeMaxDynamicSharedMemorySize, LDS_BYTES) != hipSuccess) { fprintf(stderr, "kernel_launch: hipFuncSetAttribute failed\n"); grid = -1; return; }
        if (hipOccupancyMaxActiveBlocksPerMultiprocessor(&per_cu, (const void*)fwd_kernel, NTHR, LDS_BYTES) != hipSuccess || per_cu < 1) fprintf(stderr, "kernel_launch: occupancy query reports %d\n", per_cu);
        (void)hipGetLastError();
        grid = cus;
    }
    if (grid < 0) return;
    if (hipMemsetAsync((char*)d_ws + WS_CTL, 0, CTL_ZERO_BYTES, stream) != hipSuccess) return;
    Args a{};
    for (int i = 0; i < 19; ++i) a.in[i] = (const float*)d_in[i];
    a.out = (float*)d_out; a.ws = (unsigned char*)d_ws; a.ph_lo = 0; a.ph_hi = 19;
#ifndef EXP_LO
    hipLaunchKernelGGL(fwd_kernel, dim3(grid), dim3(NTHR), LDS_BYTES, stream, a);
#else
    a.ph_lo = 0; a.ph_hi = EXP_HI; hipLaunchKernelGGL(fwd_kernel, dim3(grid), dim3(NTHR), LDS_BYTES, stream, a);
    hipMemsetAsync((char*)d_ws + WS_CTL, 0, CTL_ZERO_BYTES, stream);
    a.ph_lo = EXP_LO; a.ph_hi = 19; hipLaunchKernelGGL(fwd_kernel, dim3(grid), dim3(NTHR), LDS_BYTES, stream, a);
#endif
}
```

```cpp
#include <hip/hip_runtime.h>
#include <cstdio>
#include <cstdint>

#define GAS __attribute__((address_space(1)))
#define LAS __attribute__((address_space(3)))
typedef unsigned short bf16_t;
typedef short bf16x8 __attribute__((ext_vector_type(8)));
typedef short s16x4 __attribute__((ext_vector_type(4)));
typedef float f32x4 __attribute__((ext_vector_type(4)));
typedef float f32x2 __attribute__((ext_vector_type(2)));
typedef float f32x16 __attribute__((ext_vector_type(16)));
typedef unsigned u32x4 __attribute__((ext_vector_type(4)));
typedef unsigned u32x2 __attribute__((ext_vector_type(2)));
typedef int i32x4 __attribute__((ext_vector_type(4)));
typedef int i32x8 __attribute__((ext_vector_type(8)));
#define LDS_WAIT() asm volatile("s_waitcnt lgkmcnt(0)" ::: "memory")
#define VM_WAIT() asm volatile("s_waitcnt vmcnt(0)" ::: "memory")
#define DI __device__ __forceinline__

constexpr int NB = 4, SEQ = 4096, D = 1024, M = NB * SEQ;
constexpr int NQKV = 1536;
constexpr int MIN_N = 3072, MIN_LD = 3104;
constexpr int NE = 16, CAP = 512, DE = 2048, MROWS = NB * NE * CAP;
constexpr float RMS_EPS = 1e-6f, LOG2E = 1.4426950408889634f, YS8 = 64.f;
constexpr int NWAVES = 8, NTHR = 512;

constexpr size_t MiB = 1u << 20;
constexpr size_t WS_CTL = 0, CTL_ZERO_BYTES = 1 * MiB;
constexpr size_t WS_WQKV = 2 * MiB, WS_WAO = 6 * MiB, WS_WMIN = 8 * MiB, WS_WMIN8 = 11 * MiB, WS_WMO = 14 * MiB;
constexpr size_t WS_W13 = 16 * MiB, W13_LAYER = 64 * MiB;
constexpr size_t WS_W2 = 272 * MiB, W2_LAYER = 32 * MiB;
constexpr size_t WS_XN = 400 * MiB, WS_X1 = 432 * MiB, WS_X2 = 496 * MiB, WS_X3 = 464 * MiB;
constexpr size_t WS_XN8 = 904 * MiB;
constexpr size_t WS_AFF = 560 * MiB, WS_IDX = 561 * MiB, WS_GATE = 562 * MiB, WS_SLOT = 563 * MiB, WS_MG = 564 * MiB;
constexpr size_t WS_ACT = 568 * MiB;
constexpr size_t WS_Q = WS_ACT, WS_K = WS_ACT + 32 * MiB, WS_V = WS_ACT + 40 * MiB, WS_O = WS_ACT + 48 * MiB;
constexpr size_t WS_H = WS_ACT, WS_Y = WS_ACT + 128 * MiB;
constexpr size_t WS_GT = WS_ACT + 128 * MiB;
constexpr size_t WS_PVO = WS_ACT + 96 * MiB;
constexpr size_t WS_PROJ = WS_ACT, WS_CLOC = WS_ACT + 96 * MiB, WS_STATE = WS_ACT + 232 * MiB, WS_Y2 = WS_ACT + 300 * MiB;
constexpr size_t WS_NLOC = WS_ACT + 332 * MiB, WS_MLB = WS_ACT + 333 * MiB, WS_NST = WS_ACT + 334 * MiB, WS_MST = WS_ACT + 335 * MiB;
constexpr size_t WS_RINV2 = 926 * MiB;
constexpr size_t WS_PART = 920 * MiB;
constexpr size_t WS_RSC = WS_AFF;
constexpr size_t WS_END = 928 * MiB;
constexpr int CW_BAR = 4096;

constexpr int RING_BYTES = 131072;
constexpr int AUX_OFF = RING_BYTES, AUX_BYTES = 24576;
constexpr int MISC_OFF = AUX_OFF + AUX_BYTES;
constexpr int LDS_BYTES = MISC_OFF + 256;

DI unsigned f2bf(float f) { unsigned u = __builtin_bit_cast(unsigned, f); return (u + 0x7fffu + ((u >> 16) & 1u)) >> 16; }
DI unsigned pk2(float lo, float hi) { return f2bf(lo) | (f2bf(hi) << 16); }
DI unsigned cvt_pk_bf16(float lo, float hi) { unsigned r; asm volatile("v_cvt_pk_bf16_f32 %0, %1, %2" : "=v"(r) : "v"(lo), "v"(hi)); return r; }
DI unsigned pk4_fp8(float a, float b, float c, float d) { unsigned w = 0u; w = __builtin_amdgcn_cvt_pk_fp8_f32(a, b, w, false); w = __builtin_amdgcn_cvt_pk_fp8_f32(c, d, w, true); return w; }
DI unsigned pk4_fp8s(float a, float b, float c, float d) { return pk4_fp8(__builtin_amdgcn_fmed3f(a, -448.f, 448.f), __builtin_amdgcn_fmed3f(b, -448.f, 448.f), __builtin_amdgcn_fmed3f(c, -448.f, 448.f), __builtin_amdgcn_fmed3f(d, -448.f, 448.f)); }
DI void fp8x16_to_bf16(u32x4 v, u32x4& lo8, u32x4& hi8) {
    unsigned o[8];
#pragma unroll
    for (int i = 0; i < 4; ++i) { const f32x2 a = __builtin_amdgcn_cvt_pk_f32_fp8(v[i], false), b = __builtin_amdgcn_cvt_pk_f32_fp8(v[i], true); o[2 * i] = cvt_pk_bf16(a.x, a.y); o[2 * i + 1] = cvt_pk_bf16(b.x, b.y); }
    lo8 = (u32x4){o[0], o[1], o[2], o[3]}; hi8 = (u32x4){o[4], o[5], o[6], o[7]};
}
DI float bf2f(unsigned short b) { return __builtin_bit_cast(float, ((unsigned)b) << 16); }
DI float wave_sum(float v) {
#pragma unroll
    for (int o = 1; o < 64; o <<= 1) v += __shfl_xor(v, o);
    return v;
}

#define XB_TMO      128
#define XB_XCNT(j)  (256  + 64 * (j))
#define XB_XSUB(j)  (1280 + 64 * (j))
#define XB_XGEN(j)  (2304 + 64 * (j))
#define XB_TOP      3328
#define XB_TOPGEN   3392
#define XCD_BAR_WORDS 3456
#define XB_SPIN_CAP (1u << 18)
DI unsigned xb_ld(unsigned* p)              { return __hip_atomic_load(p, __ATOMIC_RELAXED, __HIP_MEMORY_SCOPE_AGENT); }
DI unsigned xb_add(unsigned* p, unsigned v) { return __hip_atomic_fetch_add(p, v, __ATOMIC_RELAXED, __HIP_MEMORY_SCOPE_AGENT); }
DI unsigned xb_xcc_id() { return (unsigned)__builtin_amdgcn_s_getreg((3 << 11) | 20) & 0xFu; }
#define XB_SPIN(cond, bar) do { unsigned _sp = 0; while (cond) { __builtin_amdgcn_s_sleep(1); \
    if ((++_sp & 255u) == 0u) { if (xb_ld(&(bar)[XB_TMO])) break; if (_sp > XB_SPIN_CAP) { atomicAdd(&(bar)[XB_TMO], 1u); break; } } } } while (0)
struct XcdBarrier { unsigned* bar; unsigned x; volatile LAS unsigned* st; };
DI XcdBarrier xcd_barrier_post(unsigned* bar, volatile LAS unsigned* st) {
    XcdBarrier b; b.bar = bar; b.x = xb_xcc_id(); b.st = st;
    if (threadIdx.x == 0) (void)xb_add(&bar[XB_XCNT(b.x)], 1u);
    return b;
}
DI void xcd_barrier_complete(unsigned* bar, unsigned x, unsigned& nloc, unsigned& nx) {
    const unsigned G = gridDim.x * gridDim.y * gridDim.z;
    unsigned sum, cnt, mine, sp = 0u;
    for (;;) {
        sum = 0u; cnt = 0u; mine = 0u;
#pragma unroll
        for (unsigned j = 0; j < 16; ++j) { const unsigned c = xb_ld(&bar[XB_XCNT(j)]); sum += c; cnt += (c > 0u) ? 1u : 0u; mine = (j == x) ? c : mine; }
        if (sum == G) break;
        __builtin_amdgcn_s_sleep(1);
        if ((++sp & 255u) == 0u) { if (xb_ld(&bar[XB_TMO])) break; if (sp > XB_SPIN_CAP) { atomicAdd(&bar[XB_TMO], 1u); break; } }
    }
    nloc = mine > 0u ? mine : 1u; nx = cnt > 0u ? cnt : 1u;
}
DI void xcd_barrier(const XcdBarrier& b) {
    asm volatile("s_waitcnt vmcnt(0)" ::: "memory");
    __syncthreads();
    if (threadIdx.x == 0) {
        unsigned* bar = b.bar;
        __builtin_amdgcn_s_waitcnt(0);
        unsigned nloc = b.st[0], nx = b.st[1];
        if (nloc == 0u) { xcd_barrier_complete(bar, b.x, nloc, nx); b.st[0] = nloc; b.st[1] = nx; }
        const unsigned old = xb_add(&bar[XB_XSUB(b.x)], 1u);
        const unsigned gen = old / nloc;
        if (old + 1u == (gen + 1u) * nloc) {
            __builtin_amdgcn_fence(__ATOMIC_RELEASE, "agent");
            asm volatile("s_waitcnt vmcnt(0)" ::: "memory");
            const unsigned og = xb_add(&bar[XB_TOP], 1u);
            const unsigned tg = og / nx;
            if (og + 1u == (tg + 1u) * nx) xb_add(&bar[XB_TOPGEN], 1u);
            else XB_SPIN(xb_ld(&bar[XB_TOPGEN]) == tg, bar);
            __builtin_amdgcn_fence(__ATOMIC_ACQUIRE, "agent");
            xb_add(&bar[XB_XGEN(b.x)], 1u);
            asm volatile("s_waitcnt vmcnt(0)" ::: "memory");
        } else {
            XB_SPIN(xb_ld(&bar[XB_XGEN(b.x)]) == gen, bar);
            __builtin_amdgcn_fence(__ATOMIC_ACQUIRE, "agent");
            asm volatile("s_waitcnt vmcnt(0)" ::: "memory");
        }
    }
    __syncthreads();
}

namespace pg8 {
constexpr int BM = 256, BK = 64, HALF = 128, HTB = HALF * BK * 2, STAGE_BYTES = 8 * HTB;
DI int lds_byte(int r, int c) { const int st = (r >> 4) * 2 + (c >> 5), rr = r & 15, cc = c & 31, ob = rr * 64 + cc * 2; return st * 1024 + (ob ^ (((ob >> 9) & 1) << 5)); }
DI void stage_rc(int b, int& R, int& C) { const int st = b / 1024, sb = b % 1024, swz = sb ^ (((sb >> 9) & 1) << 5); R = (st >> 1) * 16 + swz / 64; C = (st & 1) * 32 + (swz % 64) / 2; }
DI int perm32(int rho) { const int n = rho >> 4, i = rho & 15; return 8 * (i >> 2) + 4 * n + (i & 3); }
DI int perm32inv(int c) { return 16 * ((c >> 2) & 1) + 4 * (c >> 3) + (c & 3); }
struct Unit { int pm, pn, ui; };

template <class Epi, class Sched, bool GATHER, bool ALIGN_EPI, bool F8, bool ABLK = false>
DI void gemm_phase(LAS unsigned char* lds, const LAS int* idx_lds, const void* A, const int K, const Sched& S, const Epi& E) {
    const int tid = threadIdx.x, wid = __builtin_amdgcn_readfirstlane(tid >> 6), lane = tid & 63, wr = wid >> 2, wc = wid & 3, fr = lane & 15, fq = lane >> 4;
    const int PB = F8 ? K : 2 * K, nt = PB / 128;
    unsigned voffA[2][2], voffB[2];
    int RA[2], CA[2];
#pragma unroll
    for (int i = 0; i < 2; ++i) { int R, C; stage_rc(tid * 16 + i * 8192, R, C); RA[i] = R; CA[i] = C; voffB[i] = (unsigned)(R * PB + C * 2); }
    const size_t kstep = (size_t)(BK * 2);
    const size_t hstep = (size_t)HALF * PB;
    const unsigned ldsw = (unsigned)wid * 1024u;
    const int aoff = lds_byte(wr * 64 + fr, fq * 8), boff = lds_byte(wc * 32 + fr, fq * 8);
#define PG8_SA(b, h) (((b) * 2 + (h)) * HTB)
#define PG8_SB(b, h) ((4 + (b) * 2 + (h)) * HTB)
#define PG8_STAGE(bufoff, gbase, voff) do { _Pragma("unroll") for (int _i = 0; _i < 2; ++_i) \
        __builtin_amdgcn_global_load_lds((const unsigned*)((const char*)(gbase) + (voff)[_i]), (LAS unsigned*)(lds + (bufoff) + ldsw + _i * 8192), 16, 0, 0); } while (0)
#define PG8_LDA(dst, b, h) do { _Pragma("unroll") for (int m = 0; m < 4; ++m) _Pragma("unroll") for (int k = 0; k < 2; ++k) dst[m][k] = *(const LAS bf16x8*)(lds + PG8_SA(b, h) + aoff + m * 2048 + k * 1024); } while (0)
#define PG8_LDB(dst, b, h) do { _Pragma("unroll") for (int n = 0; n < 2; ++n) _Pragma("unroll") for (int k = 0; k < 2; ++k) dst[n][k] = *(const LAS bf16x8*)(lds + PG8_SB(b, h) + boff + n * 2048 + k * 1024); } while (0)
#define PG8_MMA(ai, bj, At, Bt) do { __builtin_amdgcn_s_setprio(1); _Pragma("unroll") for (int m = 0; m < 4; ++m) _Pragma("unroll") for (int n = 0; n < 2; ++n) { \
        if constexpr (F8) acc[ai][bj][m][n] = __builtin_amdgcn_mfma_scale_f32_16x16x128_f8f6f4( \
            __builtin_shufflevector(__builtin_bit_cast(i32x4, Bt[n][0]), __builtin_bit_cast(i32x4, Bt[n][1]), 0, 1, 2, 3, 4, 5, 6, 7), \
            __builtin_shufflevector(__builtin_bit_cast(i32x4, At[m][0]), __builtin_bit_cast(i32x4, At[m][1]), 0, 1, 2, 3, 4, 5, 6, 7), acc[ai][bj][m][n], 0, 0, 0, 0x7f7f7f7f, 0, 0x7f7f7f7f); \
        else { _Pragma("unroll") for (int k = 0; k < 2; ++k) acc[ai][bj][m][n] = __builtin_amdgcn_mfma_f32_16x16x32_bf16(Bt[n][k], At[m][k], acc[ai][bj][m][n], 0, 0, 0); } } \
        __builtin_amdgcn_s_setprio(0); } while (0)
#define PG8_WAIT_V(n) asm volatile("s_waitcnt vmcnt(" #n ")" ::: "memory")
#define PG8_WAIT_L(n) asm volatile("s_waitcnt lgkmcnt(" #n ")" ::: "memory")
#define PG8_BAR __builtin_amdgcn_s_barrier()
#define PG8_SCHED __builtin_amdgcn_sched_barrier(0)
#define PG8_SETA(ui_, u_) do { _Pragma("unroll") for (int _h = 0; _h < 2; ++_h) _Pragma("unroll") for (int _i = 0; _i < 2; ++_i) { \
        const int _row = GATHER ? idx_lds[(ui_) * 256 + _h * 128 + RA[_i]] : (u_).pm * 256 + _h * 128 + RA[_i]; \
        voffA[_h][_i] = ABLK ? (unsigned)((u_).pm * (nt * 32768) + (_h * 128 + RA[_i]) * 128 + CA[_i] * 2) : (unsigned)(_row * PB + CA[_i] * 2); } } while (0)
    Unit cur, nxt; int ui = 0;
    if (!S.next(0, cur)) return;
    f32x4 acc[2][2][4][2];
#pragma unroll
    for (int a = 0; a < 2; ++a)
#pragma unroll
        for (int b = 0; b < 2; ++b)
#pragma unroll
            for (int m = 0; m < 4; ++m)
#pragma unroll
                for (int n = 0; n < 2; ++n) acc[a][b][m][n] = (f32x4){0.f, 0.f, 0.f, 0.f};
    bf16x8 At[4][2], B0[2][2], B1[2][2];
    const char* const Ab = (const char*)A;
    const size_t kstepA = ABLK ? (size_t)32768 : kstep;
    const char* cB = S.bptr(cur);
    PG8_SETA(0, cur);
    PG8_STAGE(PG8_SB(0, 0), cB, voffB); PG8_STAGE(PG8_SB(0, 1), cB + hstep, voffB); PG8_STAGE(PG8_SA(0, 0), Ab, voffA[0]); PG8_STAGE(PG8_SA(0, 1), Ab, voffA[1]);
    if (wr == 1) PG8_BAR;
    PG8_WAIT_V(2); PG8_BAR;
    PG8_STAGE(PG8_SB(1, 0), cB + kstep, voffB); PG8_STAGE(PG8_SA(1, 0), Ab + kstepA, voffA[0]); PG8_STAGE(PG8_SB(1, 1), cB + hstep + kstep, voffB);
    PG8_WAIT_V(6); PG8_BAR;
    for (;;) {
        const bool has_next = S.next(ui + 1, nxt);
        const char* nB = has_next ? S.bptr(nxt) : cB;
        for (int t = 0; t < nt; t += 2) {
            const bool last = (t == nt - 2);
            const char* a1 = Ab + (size_t)(t + 1) * kstepA;
            const char* a2 = last ? Ab : Ab + (size_t)(t + 2) * kstepA; const char* b2 = last ? nB : cB + (size_t)(t + 2) * kstep;
            const char* a3 = a2 + kstepA; const char* b3 = b2 + kstep;
            PG8_LDB(B0, 0, 0); PG8_LDB(B1, 0, 1); PG8_SCHED; PG8_LDA(At, 0, 0); PG8_STAGE(PG8_SA(1, 1), a1, voffA[1]);
            if (last && has_next) PG8_SETA(ui + 1, nxt);
            PG8_WAIT_V(8); PG8_WAIT_L(0); PG8_BAR; PG8_MMA(0, 0, At, B0); PG8_MMA(0, 1, At, B1); PG8_BAR; PG8_SCHED;
            PG8_LDA(At, 0, 1); PG8_STAGE(PG8_SB(0, 0), b2, voffB); PG8_STAGE(PG8_SB(0, 1), b2 + hstep, voffB); PG8_STAGE(PG8_SA(0, 0), a2, voffA[0]);
            PG8_WAIT_V(8); PG8_WAIT_L(0); PG8_BAR; PG8_MMA(1, 0, At, B0); PG8_MMA(1, 1, At, B1); PG8_BAR; PG8_SCHED;
            PG8_LDB(B0, 1, 0); PG8_LDB(B1, 1, 1); PG8_SCHED; PG8_LDA(At, 1, 0); PG8_STAGE(PG8_SA(0, 1), a2, voffA[1]);
            PG8_WAIT_V(8); PG8_WAIT_L(0); PG8_BAR; PG8_MMA(0, 0, At, B0); PG8_MMA(0, 1, At, B1); PG8_BAR; PG8_SCHED;
            PG8_LDA(At, 1, 1); PG8_STAGE(PG8_SB(1, 0), b3, voffB); PG8_STAGE(PG8_SB(1, 1), b3 + hstep, voffB); PG8_STAGE(PG8_SA(1, 0), a3, voffA[0]);
            PG8_WAIT_V(8); PG8_WAIT_L(0); PG8_BAR; PG8_MMA(1, 0, At, B0); PG8_MMA(1, 1, At, B1); PG8_BAR; PG8_SCHED;
        }
        if constexpr (ALIGN_EPI) { if (wr == 0) PG8_BAR; }
        cur.ui = ui;
        if constexpr (!Epi::AFTER_DRAIN) E(acc, cur, wr, wc, fr, fq);
        if (!has_next) break;
#pragma unroll
        for (int a = 0; a < 2; ++a)
#pragma unroll
            for (int b = 0; b < 2; ++b)
#pragma unroll
                for (int m = 0; m < 4; ++m)
#pragma unroll
                    for (int n = 0; n < 2; ++n) acc[a][b][m][n] = (f32x4){0.f, 0.f, 0.f, 0.f};
        cur = nxt; cB = nB; ++ui;
        if constexpr (ALIGN_EPI) { if (wr == 1) PG8_BAR; }
    }
    PG8_WAIT_V(0);
    if constexpr (!ALIGN_EPI) { if (wr == 0) PG8_BAR; }
    PG8_BAR;
    if constexpr (Epi::AFTER_DRAIN) E.fused(acc, cur, wr, wc, fr, fq, lds);
#undef PG8_SA
#undef PG8_SB
#undef PG8_STAGE
#undef PG8_LDA
#undef PG8_LDB
#undef PG8_MMA
#undef PG8_WAIT_V
#undef PG8_WAIT_L
#undef PG8_BAR
#undef PG8_SCHED
#undef PG8_SETA
}

struct DenseOrder {
    int nM, nN, nwg, G, c; const bf16_t* Bt; int K;
    DI void init(int M_, int N_, int G_, int c_, const bf16_t* Bt_, int K_) { nM = M_ / BM; nN = N_ / BM; nwg = nM * nN; G = G_; c = c_; Bt = Bt_; K = K_; }
    DI bool next(int i, Unit& u) const {
        const long L = (long)i * G + c; if (L >= nwg) return false;
        int wgid = (int)L; { const int q = nwg / 8, r = nwg % 8, xcd = wgid % 8, off = wgid / 8; wgid = (xcd < r ? xcd * (q + 1) : r * (q + 1) + (xcd - r) * q) + off; }
        const int nig = 8 * nN, gid = wgid / nig, fm = gid * 8, gsz = (nM - fm) < 8 ? (nM - fm) : 8;
        u.pm = fm + ((wgid % nig) % gsz); u.pn = (wgid % nig) / gsz; return true;
    }
    DI const char* bptr(const Unit& u) const { return (const char*)(Bt + (size_t)u.pn * BM * K); }
};

struct DenseOrder8 : DenseOrder { DI const char* bptr(const Unit& u) const { return (const char*)Bt + (size_t)u.pn * BM * K; } };

struct EpiQKV {
    static constexpr bool AFTER_DRAIN = false;
    bf16_t *Q, *Kb, *Vb; const float *qg, *kg;
    DI void operator()(const f32x4 (&acc)[2][2][4][2], const Unit& u, int wr, int wc, int fr, int fq) const {
        const int pn = u.pn; bf16_t* base; int ld; const float* g; float sc;
        if (pn < 4) { base = Q + (pn * 4 + wc) * 64; ld = 1024; g = qg; sc = 0.125f * LOG2E; }
        else if (pn == 4) { base = Kb + wc * 64; ld = 256; g = kg; sc = 1.f; }
        else { base = Vb + wc * 64; ld = 256; g = kg; sc = 0.f; }
        f32x4 gv[2][2];
#pragma unroll
        for (int bj = 0; bj < 2; ++bj)
#pragma unroll
            for (int n = 0; n < 2; ++n) { gv[bj][n] = *(const f32x4*)(g + 32 * bj + 8 * fq + 4 * n) * sc; if (pn == 5) gv[bj][n] = (f32x4){1.f, 1.f, 1.f, 1.f}; }
#pragma unroll
        for (int ai = 0; ai < 2; ++ai)
#pragma unroll
            for (int m = 0; m < 4; ++m) {
                const int row = u.pm * BM + ai * HALF + wr * 64 + m * 16 + fr;
                float ss = 0.f;
#pragma unroll
                for (int bj = 0; bj < 2; ++bj)
#pragma unroll
                    for (int n = 0; n < 2; ++n) { const f32x4 x = acc[ai][bj][m][n]; ss += (x[0] * x[0] + x[1] * x[1]) + (x[2] * x[2] + x[3] * x[3]); }
                ss += __shfl_xor(ss, 16); ss += __shfl_xor(ss, 32);
                const float rinv = (pn == 5) ? 0.0625f : __builtin_amdgcn_rsqf(ss * (1.f / 64.f) + RMS_EPS);
#pragma unroll
                for (int bj = 0; bj < 2; ++bj) {
                    const f32x4 v0 = acc[ai][bj][m][0] * rinv * gv[bj][0], v1 = acc[ai][bj][m][1] * rinv * gv[bj][1];
                    u32x4 w; w.x = cvt_pk_bf16(v0[0], v0[1]); w.y = cvt_pk_bf16(v0[2], v0[3]); w.z = cvt_pk_bf16(v1[0], v1[1]); w.w = cvt_pk_bf16(v1[2], v1[3]);
                    *(u32x4*)(base + (size_t)row * ld + 32 * bj + 8 * fq) = w; }
            }
    }
};
DI void bf8_to_f32(const u32x4 w, f32x4& lo, f32x4& hi) {
    lo = (f32x4){__builtin_bit_cast(float, w.x << 16), __builtin_bit_cast(float, w.x & 0xffff0000u), __builtin_bit_cast(float, w.y << 16), __builtin_bit_cast(float, w.y & 0xffff0000u)};
    hi = (f32x4){__builtin_bit_cast(float, w.z << 16), __builtin_bit_cast(float, w.z & 0xffff0000u), __builtin_bit_cast(float, w.w << 16), __builtin_bit_cast(float, w.w & 0xffff0000u)};
}
template <bool RB, bool OB> struct EpiRes {
    static constexpr bool AFTER_DRAIN = false;
    const void* resid; void* out; int ldc; float cscale;
    DI void operator()(const f32x4 (&acc)[2][2][4][2], const Unit& u, int wr, int wc, int fr, int fq) const {
        const int row0 = u.pm * BM + wr * 64 + fr, col0 = u.pn * BM + wc * 32 + 8 * fq;
#pragma unroll
        for (int ai = 0; ai < 2; ++ai)
#pragma unroll
          for (int mp = 0; mp < 4; mp += 2) {
            f32x4 rr[2][2][2];
#pragma unroll
            for (int m = 0; m < 2; ++m) { const size_t off = (size_t)(row0 + ai * HALF + (mp + m) * 16) * ldc + col0;
#pragma unroll
                for (int bj = 0; bj < 2; ++bj) {
                    if constexpr (RB) bf8_to_f32(*(const u32x4*)((const bf16_t*)resid + off + bj * HALF), rr[m][bj][0], rr[m][bj][1]);
                    else { rr[m][bj][0] = *(const f32x4*)((const float*)resid + off + bj * HALF); rr[m][bj][1] = *(const f32x4*)((const float*)resid + off + bj * HALF + 4); } } }
#pragma unroll
            for (int m = 0; m < 2; ++m) { const size_t off = (size_t)(row0 + ai * HALF + (mp + m) * 16) * ldc + col0;
#pragma unroll
                for (int bj = 0; bj < 2; ++bj) { const f32x4 o0 = rr[m][bj][0] + acc[ai][bj][mp + m][0] * cscale, o1 = rr[m][bj][1] + acc[ai][bj][mp + m][1] * cscale;
                    if constexpr (OB) { u32x4 w; w.x = cvt_pk_bf16(o0[0], o0[1]); w.y = cvt_pk_bf16(o0[2], o0[3]); w.z = cvt_pk_bf16(o1[0], o1[1]); w.w = cvt_pk_bf16(o1[2], o1[3]); *(u32x4*)((bf16_t*)out + off + bj * HALF) = w; }
                    else { *(f32x4*)((float*)out + off + bj * HALF) = o0; *(f32x4*)((float*)out + off + bj * HALF + 4) = o1; } } }
            asm volatile("" ::: "memory"); }
    }
};
template <bool RB> struct EpiResRoute {
    static constexpr bool AFTER_DRAIN = true;
    const void* resid; bf16_t* X1; unsigned char* XG8; float* part; const float* g; const float* Wr; float cscale;
    DI void operator()(const f32x4 (&)[2][2][4][2], const Unit&, int, int, int, int) const {}
    DI void fused(f32x4 (&acc)[2][2][4][2], const Unit& u, int wr, int wc, int fr, int fq, LAS unsigned char* lds) const {
        const int tid = threadIdx.x;
        LAS unsigned short* WH = (LAS unsigned short*)lds;
        LAS unsigned short* WL = WH + 16 * 256;
        LAS float* RED = (LAS float*)(lds + 16384);
#pragma unroll
        for (int i = 0; i < 2; ++i) { const int idx = tid + i * 512, c = idx >> 2, e4 = idx & 3; const int col = u.pn * BM + c;
            const f32x4 w = *(const f32x4*)(Wr + (size_t)col * NE + 4 * e4) * g[col];
#pragma unroll
            for (int q = 0; q < 4; ++q) { const unsigned hb = f2bf(w[q]); const float lo = w[q] - __builtin_bit_cast(float, hb << 16);
                WH[(4 * e4 + q) * 256 + c] = (unsigned short)hb; WL[(4 * e4 + q) * 256 + c] = (unsigned short)f2bf(lo); } }
        const int row0 = u.pm * BM + wr * 64 + fr, col0 = u.pn * BM + wc * 32 + 8 * fq;
        f32x4 gc[2][2];
#pragma unroll
        for (int bj = 0; bj < 2; ++bj)
#pragma unroll
            for (int n = 0; n < 2; ++n) gc[bj][n] = *(const f32x4*)(g + col0 + bj * HALF + n * 4);
#pragma unroll
        for (int ai = 0; ai < 2; ++ai)
#pragma unroll
          for (int mp = 0; mp < 4; mp += 2) {
            f32x4 rr[2][2][2];
#pragma unroll
            for (int m = 0; m < 2; ++m) { const size_t off = (size_t)(row0 + ai * HALF + (mp + m) * 16) * D + col0;
#pragma unroll
                for (int bj = 0; bj < 2; ++bj) {
                    if constexpr (RB) bf8_to_f32(*(const u32x4*)((const bf16_t*)resid + off + bj * HALF), rr[m][bj][0], rr[m][bj][1]);
                    else { rr[m][bj][0] = *(const f32x4*)((const float*)resid + off + bj * HALF); rr[m][bj][1] = *(const f32x4*)((const float*)resid + off + bj * HALF + 4); } } }
            u32x2 w8[2][2];
#pragma unroll
            for (int m = 0; m < 2; ++m) { const size_t off = (size_t)(row0 + ai * HALF + (mp + m) * 16) * D + col0;
#pragma unroll
                for (int bj = 0; bj < 2; ++bj) { const f32x4 o0 = rr[m][bj][0] + acc[ai][bj][mp + m][0] * cscale, o1 = rr[m][bj][1] + acc[ai][bj][mp + m][1] * cscale;
                    acc[ai][bj][mp + m][0] = o0; acc[ai][bj][mp + m][1] = o1;
                    u32x4 w; w.x = cvt_pk_bf16(o0[0], o0[1]); w.y = cvt_pk_bf16(o0[2], o0[3]); w.z = cvt_pk_bf16(o1[0], o1[1]); w.w = cvt_pk_bf16(o1[2], o1[3]); *(u32x4*)(X1 + off + bj * HALF) = w;
                    const f32x4 g0 = o0 * gc[bj][0], g1 = o1 * gc[bj][1]; w8[m][bj].x = pk4_fp8(g0[0], g0[1], g0[2], g0[3]); w8[m][bj].y = pk4_fp8(g1[0], g1[1], g1[2], g1[3]); } }
#pragma unroll
            for (int bj = 0; bj < 2; ++bj) {
                const auto sx = __builtin_amdgcn_permlane16_swap(w8[0][bj].x, w8[1][bj].x, false, false), sy = __builtin_amdgcn_permlane16_swap(w8[0][bj].y, w8[1][bj].y, false, false);
                const u32x4 o = {sx[0], sy[0], sx[1], sy[1]};
                *(u32x4*)(XG8 + (size_t)(row0 + ai * HALF + (mp + (fq & 1)) * 16) * D + u.pn * BM + wc * 32 + 16 * (fq >> 1) + bj * HALF) = o; }
            asm volatile("" ::: "memory"); }
        __syncthreads();
#pragma unroll
        for (int ai = 0; ai < 2; ++ai)
#pragma unroll
            for (int m = 0; m < 4; ++m) { float ssl = 0.f;
#pragma unroll
                for (int bj = 0; bj < 2; ++bj)
#pragma unroll
                    for (int n = 0; n < 2; ++n) { const f32x4 x = acc[ai][bj][m][n]; ssl += (x[0] * x[0] + x[1] * x[1]) + (x[2] * x[2] + x[3] * x[3]); }
                ssl += __shfl_xor(ssl, 16); ssl += __shfl_xor(ssl, 32);
                if (fq == 0) RED[((ai * HALF + wr * 64 + m * 16 + fr) * 4 + wc) * 17 + 16] = ssl; }
        bf16x8 bh[2], bl[2];
#pragma unroll
        for (int bj = 0; bj < 2; ++bj) { const int cb = bj * HALF + wc * 32 + 8 * fq;
            bh[bj] = *(const LAS bf16x8*)(WH + fr * 256 + cb); bl[bj] = *(const LAS bf16x8*)(WL + fr * 256 + cb); }
#pragma unroll
        for (int ai = 0; ai < 2; ++ai)
#pragma unroll
            for (int m = 0; m < 4; ++m) { f32x4 lg = (f32x4){0.f, 0.f, 0.f, 0.f};
#pragma unroll
                for (int bj = 0; bj < 2; ++bj) { const f32x4 x0 = acc[ai][bj][m][0], x1v = acc[ai][bj][m][1];
                    u32x4 hi, lo; float r[8] = {x0[0], x0[1], x0[2], x0[3], x1v[0], x1v[1], x1v[2], x1v[3]};
#pragma unroll
                    for (int q = 0; q < 4; ++q) { const unsigned h2 = cvt_pk_bf16(r[2 * q], r[2 * q + 1]); hi[q] = h2;
                        lo[q] = cvt_pk_bf16(r[2 * q] - __builtin_bit_cast(float, h2 << 16), r[2 * q + 1] - __builtin_bit_cast(float, h2 & 0xffff0000u)); }
                    const bf16x8 ah = __builtin_bit_cast(bf16x8, hi), al = __builtin_bit_cast(bf16x8, lo);
                    lg = __builtin_amdgcn_mfma_f32_16x16x32_bf16(ah, bh[bj], lg, 0, 0, 0);
                    lg = __builtin_amdgcn_mfma_f32_16x16x32_bf16(al, bh[bj], lg, 0, 0, 0);
                    lg = __builtin_amdgcn_mfma_f32_16x16x32_bf16(ah, bl[bj], lg, 0, 0, 0); }
#pragma unroll
                for (int j = 0; j < 4; ++j) RED[((ai * HALF + wr * 64 + m * 16 + 4 * fq + j) * 4 + wc) * 17 + fr] = lg[j]; }
        __syncthreads();
        for (int idx = tid; idx < 256 * 17; idx += 512) { const int e17 = idx >> 8, row = idx & 255;
            const float v = (RED[(row * 4 + 0) * 17 + e17] + RED[(row * 4 + 1) * 17 + e17]) + (RED[(row * 4 + 2) * 17 + e17] + RED[(row * 4 + 3) * 17 + e17]);
            part[(size_t)(u.pn * 17 + e17) * M + u.pm * BM + row] = v; }
    }
};
struct EpiSwiGLU {
    static constexpr bool AFTER_DRAIN = false;
    unsigned char* H; const LAS float* rsl;
    DI void operator()(const f32x4 (&acc)[2][2][4][2], const Unit& u, int wr, int wc, int fr, int fq) const {
        const int row0 = u.pm * BM + wr * 64 + fr, col = u.pn * 128 + wc * 32 + 8 * fq;
        float rsv[2][4];
#pragma unroll
        for (int ai = 0; ai < 2; ++ai)
#pragma unroll
            for (int m = 0; m < 4; ++m) rsv[ai][m] = rsl[u.ui * 256 + ai * HALF + wr * 64 + m * 16 + fr] * 0.0625f;
        unsigned char* hb = H + ((size_t)(u.pm * 16 + u.pn) * 256 + wr * 64 + fr + (fq & 1) * 16) * 128 + wc * 32 + 16 * (fq >> 1);
#pragma unroll
        for (int ai = 0; ai < 2; ++ai)
#pragma unroll
            for (int mp = 0; mp < 4; mp += 2) {
                u32x2 w[2];
#pragma unroll
                for (int q = 0; q < 2; ++q) { const int m = mp + q;
                    float hv[8]; const float rs = rsv[ai][m]; const f32x2 c1 = {-rs * LOG2E, -rs * LOG2E}, rs2 = {rs * rs, rs * rs}, one = {1.f, 1.f};
#pragma unroll
                    for (int n = 0; n < 2; ++n)
#pragma unroll
                        for (int j = 0; j < 4; j += 2) { const f32x2 av = {acc[ai][0][m][n][j], acc[ai][0][m][n][j + 1]}, uv = {acc[ai][1][m][n][j], acc[ai][1][m][n][j + 1]};
                            const f32x2 t = av * c1; const f32x2 d = (f32x2){__builtin_amdgcn_exp2f(t.x), __builtin_amdgcn_exp2f(t.y)} + one;
                            const f32x2 r = (f32x2){__builtin_amdgcn_rcpf(d.x), __builtin_amdgcn_rcpf(d.y)} * rs2; const f32x2 hh = (av * uv) * r;
                            hv[4 * n + j] = __builtin_amdgcn_fmed3f(hh.x, -448.f, 448.f); hv[4 * n + j + 1] = __builtin_amdgcn_fmed3f(hh.y, -448.f, 448.f); }
                    w[q].x = pk4_fp8(hv[0], hv[1], hv[2], hv[3]); w[q].y = pk4_fp8(hv[4], hv[5], hv[6], hv[7]); }
                const auto sx = __builtin_amdgcn_permlane16_swap(w[0].x, w[1].x, false, false), sy = __builtin_amdgcn_permlane16_swap(w[0].y, w[1].y, false, false);
                const u32x4 o = {sx[0], sy[0], sx[1], sy[1]};
                __builtin_nontemporal_store(o, (u32x4*)(hb + (size_t)(ai * HALF + mp * 16) * 128));
            }
    }
};
struct EpiBf16 {
    static constexpr bool AFTER_DRAIN = false;
    bf16_t* O; int ldc; const float* rowscale; float cscale; int coloff;
    DI void operator()(const f32x4 (&acc)[2][2][4][2], const Unit& u, int wr, int wc, int fr, int fq) const {
        const int row0 = u.pm * BM + wr * 64 + fr, col0 = coloff + u.pn * BM + wc * 32 + 8 * fq;
#pragma unroll
        for (int ai = 0; ai < 2; ++ai)
#pragma unroll
            for (int m = 0; m < 4; ++m) { const int row = row0 + ai * HALF + m * 16; const float sc = rowscale ? rowscale[row] * cscale : cscale;
#pragma unroll
                for (int bj = 0; bj < 2; ++bj) { const f32x4 v0 = acc[ai][bj][m][0] * sc, v1 = acc[ai][bj][m][1] * sc;
                    u32x4 w; w.x = cvt_pk_bf16(v0[0], v0[1]); w.y = cvt_pk_bf16(v0[2], v0[3]); w.z = cvt_pk_bf16(v1[0], v1[1]); w.w = cvt_pk_bf16(v1[2], v1[3]);
                    *(u32x4*)(O + (size_t)row * ldc + col0 + bj * HALF) = w; } }
    }
};
struct EpiFp8 {
    static constexpr bool AFTER_DRAIN = false;
    unsigned char* O; int ldc; const float* rowscale; float cscale;
    DI void operator()(const f32x4 (&acc)[2][2][4][2], const Unit& u, int wr, int wc, int fr, int fq) const {
        const int row0 = u.pm * BM + wr * 64 + fr;
        unsigned char* ob = O + (size_t)(row0 + (fq & 1) * 16) * ldc + u.pn * BM + wc * 32 + 16 * (fq >> 1);
#pragma unroll
        for (int ai = 0; ai < 2; ++ai)
#pragma unroll
            for (int mp = 0; mp < 4; mp += 2) {
                float sc[2];
#pragma unroll
                for (int q = 0; q < 2; ++q) { const int row = row0 + ai * HALF + (mp + q) * 16; sc[q] = rowscale ? rowscale[row] * cscale : cscale; }
#pragma unroll
                for (int bj = 0; bj < 2; ++bj) {
                    u32x2 w[2];
#pragma unroll
                    for (int q = 0; q < 2; ++q) { const f32x4 v0 = acc[ai][bj][mp + q][0] * sc[q], v1 = acc[ai][bj][mp + q][1] * sc[q];
                        w[q].x = pk4_fp8(v0[0], v0[1], v0[2], v0[3]); w[q].y = pk4_fp8(v1[0], v1[1], v1[2], v1[3]); }
                    const auto sx = __builtin_amdgcn_permlane16_swap(w[0].x, w[1].x, false, false), sy = __builtin_amdgcn_permlane16_swap(w[0].y, w[1].y, false, false);
                    const u32x4 o = {sx[0], sy[0], sx[1], sy[1]};
                    *(u32x4*)(ob + (size_t)(ai * HALF + mp * 16) * ldc + bj * HALF) = o; } }
    }
};
struct MoeUpOrder {
    int vcu, G; const char* W;
    DI bool next(int i, Unit& u) const { const int L = i * G + vcu; if (L >= 2048) return false; const int ii = L >> 8, v = L & 255, x = v >> 5, j = v & 31, e = 2 * ii + (x >> 2);
        u.pm = 8 * e + (j & 7); u.pn = 4 * (x & 3) + (j >> 3); return true; }
    DI const char* bptr(const Unit& u) const { return W + (size_t)(u.pm >> 3) * 4096 * 1024 + (size_t)u.pn * BM * 1024; }
};
struct MoeDownOrder {
    int vcu, G; const char* W;
    DI bool next(int i, Unit& u) const { const int L = i * G + vcu; if (L >= 512) return false; const int ii = L >> 8, v = L & 255, x = v >> 5, j = v & 31, e = 8 * ii + x;
        u.pm = 8 * e + (j & 7); u.pn = j >> 3; return true; }
    DI const char* bptr(const Unit& u) const { return W + (size_t)(u.pm >> 3) * 1024 * 2048 + (size_t)u.pn * BM * 2048; }
};
}

struct Args { const float* in[19]; float* out; unsigned char* ws; int ph_lo, ph_hi; };
struct Frame {
    LAS unsigned char* lds; volatile LAS unsigned* MISC; unsigned* ctl;
    int tid, lane, wave, vcu, G;
};
enum { IN_X = 0, IN_RELB, IN_ANG, IN_AWIN, IN_AQG, IN_AKG, IN_ASINK, IN_AWOUT, IN_MNG, IN_MWIN, IN_MBI, IN_MBF, IN_MOG, IN_MWOUT, IN_FNG, IN_RW, IN_W1, IN_W3, IN_W2 };

DI void conv_item(const float* W, int ldw, int cbase, bf16_t* dst, int K, int drow0, int k0, bool perm, float scale, LAS float* scr, int lane, const float* kg = nullptr) {
    { const int a = lane >> 3, b = lane & 7;
      f32x4 v[8]; float gk[8];
#pragma unroll
      for (int i = 0; i < 8; ++i) { v[i] = *(const f32x4*)(W + (size_t)(k0 + 8 * i + a) * ldw + cbase + 4 * b); gk[i] = kg ? kg[k0 + 8 * i + a] : 1.f; }
#pragma unroll
      for (int i = 0; i < 8; ++i) { LAS float* d = scr + (8 * i + a) * 33 + 4 * b; d[0] = v[i].x * gk[i]; d[1] = v[i].y * gk[i]; d[2] = v[i].z * gk[i]; d[3] = v[i].w * gk[i]; } }
    LDS_WAIT(); asm volatile("" ::: "memory");
    const int c = lane & 7;
#pragma unroll
    for (int j = 0; j < 4; ++j) { const int n = (lane >> 3) + 8 * j; const LAS float* s = scr + (8 * c) * 33 + n;
        u32x4 o; o.x = pk2(s[0 * 33] * scale, s[1 * 33] * scale); o.y = pk2(s[2 * 33] * scale, s[3 * 33] * scale); o.z = pk2(s[4 * 33] * scale, s[5 * 33] * scale); o.w = pk2(s[6 * 33] * scale, s[7 * 33] * scale);
        const int rho = perm ? pg8::perm32inv(n) : n;
        *(u32x4*)(dst + (size_t)(drow0 + rho) * K + k0 + 8 * c) = o; }
    LDS_WAIT(); asm volatile("" ::: "memory");
}
DI void conv_item8(const float* W, int ldw, int cbase, unsigned char* dst, int K, int drow0, int k0, float scale, LAS float* scr, int lane, bool perm = true) {
    const int a = lane >> 3, b = lane & 7;
    f32x4 v[16];
#pragma unroll
    for (int i = 0; i < 16; ++i) v[i] = __builtin_nontemporal_load((const f32x4*)(W + (size_t)(k0 + 8 * i + a) * ldw + cbase + 4 * b));
#pragma unroll
    for (int i = 0; i < 16; ++i) { const int k = 8 * i + a; LAS float* d = scr + k * 33 + 4 * (k >> 4) + 4 * b; d[0] = v[i].x; d[1] = v[i].y; d[2] = v[i].z; d[3] = v[i].w; }
    LDS_WAIT(); asm volatile("" ::: "memory");
    const int c = lane & 7;
#pragma unroll
    for (int j = 0; j < 4; ++j) { const int n = (lane >> 3) + 8 * j; const LAS float* s = scr + (16 * c) * 33 + 4 * c + n;
        u32x4 o;
#pragma unroll
        for (int q = 0; q < 4; ++q) o[q] = pk4_fp8(s[(4 * q) * 33] * scale, s[(4 * q + 1) * 33] * scale, s[(4 * q + 2) * 33] * scale, s[(4 * q + 3) * 33] * scale);
        __builtin_nontemporal_store(o, (u32x4*)(dst + (size_t)(drow0 + (perm ? pg8::perm32inv(n) : n)) * K + k0 + 16 * c)); }
    LDS_WAIT(); asm volatile("" ::: "memory");
}
DI void rms_row_to_bf16(const float* xrow, const float* g, bf16_t* orow, int lane) {
    const f32x4* xr = (const f32x4*)xrow + lane; const f32x4* gr = (const f32x4*)g + lane;
    f32x4 v[4]; float s = 0.f;
#pragma unroll
    for (int j = 0; j < 4; ++j) { v[j] = xr[64 * j]; s += (v[j].x * v[j].x + v[j].y * v[j].y) + (v[j].z * v[j].z + v[j].w * v[j].w); }
    const float rinv = __builtin_amdgcn_rsqf(wave_sum(s) * (1.f / D) + RMS_EPS);
    unsigned long long* o8 = (unsigned long long*)orow + lane;
#pragma unroll
    for (int j = 0; j < 4; ++j) { const f32x4 gg = gr[64 * j]; const f32x4 y = v[j] * rinv * gg;
        o8[64 * j] = (unsigned long long)pk2(y.x, y.y) | ((unsigned long long)pk2(y.z, y.w) << 32); }
}
constexpr int XI_PER_LE = 1536, XI_TOTAL = 32 * XI_PER_LE;
constexpr int XI_NA = 128 * NWAVES * 6, XI_NB = 192 * NWAVES * 6, XI_NC = 192 * NWAVES * 5, XI_ND = 128 * NWAVES * 16;
constexpr int XI_PRO_END = XI_TOTAL - XI_NA - XI_NB - XI_NC - XI_ND, XI_A_END = XI_PRO_END + XI_NA, XI_B_END = XI_A_END + XI_NB, XI_C_END = XI_TOTAL - XI_ND;
static_assert(XI_B_END >= XI_TOTAL / 2, "the slots after MoE layer 0 may only hold layer-1 items");
DI void expert_conv_items(Frame& F, const Args& a, int it0, int it1, int rank, int nrank) {
    LAS float* scr8 = (LAS float*)(F.lds + F.wave * 17152);
    unsigned char* ws = a.ws;
    for (int it = it0 + rank; it < it1; it += nrank) {
        const int le = it / XI_PER_LE, r = it % XI_PER_LE;
        if (r < 1024) { const int kb = r / 128, j = r % 128, bj = j >> 6, pn = (j >> 2) & 15, wc = j & 3, g = pn * 8 + bj * 4 + wc;
            const float* W = (bj ? a.in[IN_W3] : a.in[IN_W1]) + (size_t)le * D * DE;
            conv_item8(W, DE, 128 * pn + 32 * wc, ws + WS_W13 + (size_t)le * 4096 * D, D, 32 * g, 128 * kb, 16.f, scr8, F.lane);
        } else { const int r2 = r - 1024, kb = r2 / 32, g = r2 % 32;
            conv_item8(a.in[IN_W2] + (size_t)le * DE * D, D, 32 * g, ws + WS_W2 + (size_t)le * D * DE, DE, 32 * g, 128 * kb, 32.f, scr8, F.lane); }
    }
}
DI void rms_row_to_fp8(const float* xrow, const float* g, unsigned char* orow, int lane) {
    const f32x4* xr = (const f32x4*)xrow + lane; const f32x4* gr = (const f32x4*)g + lane;
    f32x4 v[4]; float s = 0.f;
#pragma unroll
    for (int j = 0; j < 4; ++j) { v[j] = xr[64 * j]; s += (v[j].x * v[j].x + v[j].y * v[j].y) + (v[j].z * v[j].z + v[j].w * v[j].w); }
    const float rinv = __builtin_amdgcn_rsqf(wave_sum(s) * (1.f / D) + RMS_EPS);
#pragma unroll
    for (int j = 0; j < 4; ++j) { const f32x4 y = v[j] * rinv * gr[64 * j]; *((unsigned*)orow + lane + 64 * j) = pk4_fp8(y.x, y.y, y.z, y.w); }
}
DI void p0_prologue(Frame& F, const Args& a) {
    LAS float* scr = (LAS float*)(F.lds + F.wave * 17152);
    const int gw = F.vcu * NWAVES + F.wave, NGW = F.G * NWAVES;
    unsigned char* ws = a.ws;
    LAS float* scr8 = (LAS float*)(F.lds + F.wave * 17152);
    constexpr int I_QKV = 8 * 48, I_AO = 8 * 32, I_MINA = 16 * 32, I_MINB = 8 * 64, I_MO = 16 * 32, I_SMALL = I_QKV + I_AO + I_MINA + I_MINB + I_MO;
    for (int it = gw; it < I_SMALL; it += NGW) {
        int r = it;
        if (r < I_QKV) { const int kb = r / 48, g = r % 48, pn = g >> 3, bj = (g >> 2) & 1, wc = g & 3;
            conv_item8(a.in[IN_AWIN], NQKV, 256 * pn + 64 * wc + 32 * bj, ws + WS_WQKV, D, 32 * g, 128 * kb, 16.f, scr8, F.lane, true); continue; } r -= I_QKV;
        if (r < I_AO) { const int kb = r / 32, g = r % 32; conv_item8(a.in[IN_AWOUT], D, 32 * g, ws + WS_WAO, D, 32 * g, 128 * kb, 16.f, scr8, F.lane, true); continue; } r -= I_AO;
        if (r < I_MINA) { const int kb = r / 32, g = r % 32; const float sc = g >= 16 ? 0.125f : 1.f;
            conv_item(a.in[IN_MWIN], MIN_LD, 32 * g, (bf16_t*)(ws + WS_WMIN), D, 32 * g, 64 * kb, true, sc, scr, F.lane, a.in[IN_MNG]); continue; } r -= I_MINA;
        if (r < I_MINB) { const int kb = r / 64, g = r % 64;
            conv_item8(a.in[IN_MWIN], MIN_LD, 1024 + 32 * g, ws + WS_WMIN8, D, 32 * g, 128 * kb, 16.f, scr8, F.lane, true); continue; } r -= I_MINB;
        { const int kb = r / 32, g = r % 32; conv_item(a.in[IN_MWOUT], D, 32 * g, (bf16_t*)(ws + WS_WMO), D, 32 * g, 64 * kb, true, 1.f, scr, F.lane); }
    }
    for (int m = gw; m < M; m += NGW) rms_row_to_fp8(a.in[IN_X] + (size_t)m * D, a.in[IN_ANG], ws + WS_XN8 + (size_t)m * D, F.lane);
    expert_conv_items(F, a, 0, XI_PRO_END, gw, NGW);
}

constexpr int AT_K = 0, AT_V = 49152, AT_TB = 98304, AT_TB_COPY = 388, AT_TB_HEAD = 4 * AT_TB_COPY;
DI int t5_bucket_dev(int rel) {
    const int n = rel < 0 ? -rel : rel; int b;
    if (n < 8) b = n; else if (n < 12) b = 8; else if (n < 16) b = 9; else if (n < 23) b = 10; else if (n < 32) b = 11; else if (n < 46) b = 12; else if (n < 64) b = 13; else if (n < 91) b = 14; else b = 15;
    return b + (rel > 0 ? 16 : 0);
}
DI bf16x8 pack_step(const f32x16& x, int s) {
    u32x4 p;
    p.x = cvt_pk_bf16(x[8 * s + 0], x[8 * s + 1]); p.y = cvt_pk_bf16(x[8 * s + 2], x[8 * s + 3]); p.z = cvt_pk_bf16(x[8 * s + 4], x[8 * s + 5]); p.w = cvt_pk_bf16(x[8 * s + 6], x[8 * s + 7]);
    return __builtin_bit_cast(bf16x8, p);
}
typedef short v4i16_t __attribute__((ext_vector_type(4)));
DI s16x4 tr_read(const LAS unsigned char* p) { return __builtin_bit_cast(s16x4, __builtin_amdgcn_ds_read_tr16_b64_v4i16((LAS v4i16_t*)p)); }
DI bf16x8 cat8(s16x4 lo, s16x4 hi) { return __builtin_shufflevector(lo, hi, 0, 1, 2, 3, 4, 5, 6, 7); }

constexpr float AT_THR = 12.f;
template <bool D0, bool D1>
DI void attn_tile(const bf16x8 (&kf)[4], const bf16x8 (&vf)[2][2], const bf16x8 (&qf)[2][4], const LAS float* tbl, int kt0, float (&mrun)[2], float (&lrun)[2], f32x16 (&o)[2][2]) {
    f32x16 s0, s1;
#pragma unroll
    for (int G4 = 0; G4 < 4; ++G4) {
        if (D0) { const f32x4 t = *(const LAS f32x4*)(tbl + 32 * kt0 + 8 * G4); s0[4 * G4] = t[0]; s0[4 * G4 + 1] = t[1]; s0[4 * G4 + 2] = t[2]; s0[4 * G4 + 3] = t[3]; }
        if (D1) { const f32x4 t = *(const LAS f32x4*)(tbl + 32 * (kt0 - 1) + 8 * G4); s1[4 * G4] = t[0]; s1[4 * G4 + 1] = t[1]; s1[4 * G4 + 2] = t[2]; s1[4 * G4 + 3] = t[3]; } }
#pragma unroll
    for (int s = 0; s < 4; ++s) { if (D0) s0 = __builtin_amdgcn_mfma_f32_32x32x16_bf16(kf[s], qf[0][s], s0, 0, 0, 0); if (D1) s1 = __builtin_amdgcn_mfma_f32_32x32x16_bf16(kf[s], qf[1][s], s1, 0, 0, 0); }
    float mx0 = -__builtin_inff(), mx1 = -__builtin_inff();
#pragma unroll
    for (int i = 0; i < 16; ++i) { if (D0) mx0 = fmaxf(mx0, s0[i]); if (D1) mx1 = fmaxf(mx1, s1[i]); }
    if (__any((D0 && mx0 - mrun[0] > AT_THR) || (D1 && mx1 - mrun[1] > AT_THR))) {
        if (D0) { mx0 = fmaxf(mx0, __shfl_xor(mx0, 32)); const float mnew = fmaxf(mrun[0], mx0), alpha = __builtin_amdgcn_exp2f(mrun[0] - mnew); mrun[0] = mnew; lrun[0] *= alpha; o[0][0] = o[0][0] * alpha; o[0][1] = o[0][1] * alpha; }
        if (D1) { mx1 = fmaxf(mx1, __shfl_xor(mx1, 32)); const float mnew = fmaxf(mrun[1], mx1), alpha = __builtin_amdgcn_exp2f(mrun[1] - mnew); mrun[1] = mnew; lrun[1] *= alpha; o[1][0] = o[1][0] * alpha; o[1][1] = o[1][1] * alpha; }
    }
    float l0 = 0.f, l1 = 0.f;
#pragma unroll
    for (int i = 0; i < 16; ++i) { if (D0) { s0[i] = __builtin_amdgcn_exp2f(s0[i] - mrun[0]); l0 += s0[i]; } if (D1) { s1[i] = __builtin_amdgcn_exp2f(s1[i] - mrun[1]); l1 += s1[i]; } }
    if (D0) lrun[0] += l0;
    if (D1) lrun[1] += l1;
#pragma unroll
    for (int st = 0; st < 2; ++st) {
        if (D0) { const bf16x8 p = pack_step(s0, st); o[0][0] = __builtin_amdgcn_mfma_f32_32x32x16_bf16(vf[0][st], p, o[0][0], 0, 0, 0); o[0][1] = __builtin_amdgcn_mfma_f32_32x32x16_bf16(vf[1][st], p, o[0][1], 0, 0, 0); }
        if (D1) { const bf16x8 p = pack_step(s1, st); o[1][0] = __builtin_amdgcn_mfma_f32_32x32x16_bf16(vf[0][st], p, o[1][0], 0, 0, 0); o[1][1] = __builtin_amdgcn_mfma_f32_32x32x16_bf16(vf[1][st], p, o[1][1], 0, 0, 0); }
    }
}
DI void attn_phase(Frame& F, const Args& a) {
    LAS unsigned char* lds = F.lds;
    const bf16_t* Qg = (const bf16_t*)(a.ws + WS_Q); const bf16_t* Kg = (const bf16_t*)(a.ws + WS_K); const bf16_t* Vg = (const bf16_t*)(a.ws + WS_V); unsigned char* Og = a.ws + WS_O;
    const float* relb = a.in[IN_RELB]; const float* sink = a.in[IN_ASINK];
    const int lane = F.lane, wave = F.wave, r = lane & 31, h = lane >> 5;
    const int g = wave >> 1, half = wave & 1;
    LAS float* TB = (LAS float*)(lds + AT_TB);
    constexpr int NPF = 6;
    u32x4 kvr[NPF];
#define AT_LOAD(u_) do { const int qb_ = (u_) & 31, kvh_ = ((u_) >> 5) & 3, b_ = (u_) >> 7, kb_ = qb_ * 128 - 128; \
        _Pragma("unroll") for (int i = 0; i < NPF; ++i) { const int idx = F.tid + i * NTHR, isv = idx >= 3072, rem = isv ? idx - 3072 : idx, row = rem >> 3, c = rem & 7; int kp = kb_ + row; kp = kp < 0 ? 0 : (kp >= SEQ ? SEQ - 1 : kp); \
            kvr[i] = *(const u32x4*)((isv ? Vg : Kg) + (size_t)(b_ * SEQ + kp) * 256 + kvh_ * 64 + c * 8); } } while (0)
    int tb_kvh = -1;
    if (F.vcu < 512) AT_LOAD(F.vcu);
    for (int u = F.vcu; u < 512; u += F.G) {
        const int qb = u & 31, kvh = (u >> 5) & 3, b = u >> 7;
        const int kbase = qb * 128 - 128;
        __syncthreads();
        const bool newtb = kvh != tb_kvh; float rbv = 0.f;
        if (newtb && F.tid < 128) rbv = relb[(F.tid >> 2) * 16 + kvh * 4 + (F.tid & 3)];
        u32x4 late[12 - NPF];
#pragma unroll
        for (int i = NPF; i < 12; ++i) { const int idx = F.tid + i * NTHR, isv = idx >= 3072, rem = isv ? idx - 3072 : idx, row = rem >> 3, c = rem & 7; int kp = kbase + row; kp = kp < 0 ? 0 : (kp >= SEQ ? SEQ - 1 : kp);
            late[i - NPF] = *(const u32x4*)((isv ? Vg : Kg) + (size_t)(b * SEQ + kp) * 256 + kvh * 64 + c * 8); }
        const int head = kvh * 4 + g, qw0 = qb * 128 + 64 * half;
        bf16x8 qf[2][4];
#pragma unroll
        for (int qt = 0; qt < 2; ++qt)
#pragma unroll
            for (int s = 0; s < 4; ++s) qf[qt][s] = *(const bf16x8*)(Qg + (size_t)(b * SEQ + qw0 + 32 * qt + r) * 1024 + head * 64 + 16 * s + 8 * h);
        if (newtb) { tb_kvh = kvh;
            LAS float* RB = (LAS float*)(lds + AUX_OFF);
            if (F.tid < 128) RB[F.tid] = rbv * LOG2E;
            __syncthreads();
#pragma unroll 4
            for (int idx = F.tid; idx < 4 * AT_TB_HEAD; idx += NTHR) {
                const int gg = idx / AT_TB_HEAD, rem = idx % AT_TB_HEAD, c = rem / AT_TB_COPY, i = rem % AT_TB_COPY, rel = i + c - 192;
                float v = -__builtin_inff();
                if (rel >= -128 && rel <= 128) v = RB[t5_bucket_dev(rel) * 4 + gg];
                TB[idx] = v;
            } }
#pragma unroll
        for (int i = 0; i < 12; ++i) { const int idx = F.tid + i * NTHR, isv = idx >= 3072, rem = isv ? idx - 3072 : idx, row = rem >> 3, c = rem & 7;
            const int pos = isv ? (c ^ (((row >> 1) & 1) << 2)) : (c ^ ((row >> 1) & 7));
            *(LAS u32x4*)(lds + (isv ? AT_V : AT_K) + row * 128 + pos * 16) = i < NPF ? kvr[i] : late[i < NPF ? 0 : i - NPF]; }
        if (u + F.G < 512) AT_LOAD(u + F.G);
        __syncthreads();
        const float sk = sink[head] * LOG2E;
        float mrun[2] = {sk, sk}, lrun[2] = {h == 0 ? 1.f : 0.f, h == 0 ? 1.f : 0.f};
        f32x16 o[2][2];
#pragma unroll
        for (int qt = 0; qt < 2; ++qt)
#pragma unroll
            for (int dt = 0; dt < 2; ++dt)
#pragma unroll
                for (int i = 0; i < 16; ++i) o[qt][dt][i] = 0.f;
        const int cpy = (4 - (r & 3)) & 3;
        const LAS float* tbl = TB + g * AT_TB_HEAD + cpy * AT_TB_COPY + (64 + 4 * h - r - cpy);
        const int q4 = (lane & 15) >> 2, p4 = lane & 3, blk = (lane >> 4) & 1;
        for (int T = 2 * half; T < 2 * half + 10; ++T) {
            const int kp0 = kbase + 32 * T;
            if (kp0 < 0 || kp0 >= SEQ) continue;
            bf16x8 kf[4];
            { const int row = 32 * T + r;
#pragma unroll
              for (int s = 0; s < 4; ++s) kf[s] = *(const LAS bf16x8*)(lds + AT_K + row * 128 + (((2 * s + h) ^ ((row >> 1) & 7)) << 4)); }
            bf16x8 vf[2][2];
#pragma unroll
            for (int dt = 0; dt < 2; ++dt)
#pragma unroll
                for (int s = 0; s < 2; ++s) {
                    const int row0 = 32 * T + 16 * s + 4 * h + q4, row1 = row0 + 8, cb = 64 * dt + 32 * blk + 8 * p4;
                    const s16x4 lo = tr_read(lds + AT_V + row0 * 128 + (cb ^ (((row0 >> 1) & 1) << 6)));
                    const s16x4 hi = tr_read(lds + AT_V + row1 * 128 + (cb ^ (((row1 >> 1) & 1) << 6)));
                    vf[dt][s] = cat8(lo, hi);
                }
            const int kt0 = T - 2 * half;
            attn_tile<true, true>(kf, vf, qf, tbl, kt0, mrun, lrun, o);
        }
#pragma unroll
        for (int qt = 0; qt < 2; ++qt) {
            const float lt = lrun[qt] + __shfl_xor(lrun[qt], 32), inv = 16.f * __builtin_amdgcn_rcpf(lt);
            unsigned char* orow = Og + (size_t)(b * SEQ + qw0 + 32 * qt + r) * 1024 + head * 64;
#pragma unroll
            for (int dt = 0; dt < 2; ++dt)
#pragma unroll
                for (int G4 = 0; G4 < 4; G4 += 2) {
                    const unsigned wa = pk4_fp8(o[qt][dt][4 * G4] * inv, o[qt][dt][4 * G4 + 1] * inv, o[qt][dt][4 * G4 + 2] * inv, o[qt][dt][4 * G4 + 3] * inv);
                    const unsigned wb = pk4_fp8(o[qt][dt][4 * G4 + 4] * inv, o[qt][dt][4 * G4 + 5] * inv, o[qt][dt][4 * G4 + 6] * inv, o[qt][dt][4 * G4 + 7] * inv);
                    const auto sw = __builtin_amdgcn_permlane32_swap(wa, wb, false, false);
                    const u32x2 ow = {sw[0], sw[1]};
                    *(u32x2*)(orow + 32 * dt + 8 * (G4 + h)) = ow; }
        }
    }
#undef AT_LOAD
}

template <int N> DI int multi_reduce(float (&v)[N], int lane) {
    int idx = 0;
#pragma unroll
    for (int bit = 32, cnt = N / 2; cnt >= 1; bit >>= 1, cnt >>= 1) {
        const bool upper = (lane & bit) != 0;
#pragma unroll
        for (int i = 0; i < cnt; ++i) { const float lo = v[i], hi = v[i + cnt]; const float send = upper ? lo : hi, keep = upper ? hi : lo; v[i] = keep + __shfl_xor(send, bit); }
        idx |= upper ? cnt : 0;
    }
#pragma unroll
    for (int bit = 32 / N; bit >= 1; bit >>= 1) v[0] += __shfl_xor(v[0], bit);
    return idx;
}
DI float log_sigmoid(float x) { const float e = __builtin_amdgcn_exp2f(-fabsf(x) * LOG2E); return fminf(x, 0.f) - __builtin_amdgcn_logf(1.f + e) * 0.6931471805599453f; }
DI void add_routed_rows(f32x4 (&x)[4], const unsigned char* Y, int sl, int b, int lane) {
    unsigned long long mask = __ballot(sl >= 0);
    while (mask) {
        const unsigned char* yr[4]; float wq[4];
#pragma unroll
        for (int q = 0; q < 4; ++q) { const bool v = mask != 0ull; const int e = v ? __builtin_ctzll(mask) : 0; if (v) mask &= mask - 1;
            const int sv = __builtin_amdgcn_readlane(sl, e); wq[q] = v ? 1.f / YS8 : 0.f;
            yr[q] = (v || q == 0) ? Y + (size_t)((e * NB + b) * CAP + sv) * D : yr[0]; }
        unsigned w[4][4];
#pragma unroll
        for (int q = 0; q < 4; ++q)
#pragma unroll
            for (int j = 0; j < 4; ++j) w[q][j] = __builtin_nontemporal_load((const unsigned*)yr[q] + lane + 64 * j);
#pragma unroll
        for (int q = 0; q < 4; ++q)
#pragma unroll
            for (int j = 0; j < 4; ++j) { const f32x2 lo = __builtin_amdgcn_cvt_pk_f32_fp8(w[q][j], false), hi = __builtin_amdgcn_cvt_pk_f32_fp8(w[q][j], true);
                x[j].x += wq[q] * lo.x; x[j].y += wq[q] * lo.y; x[j].z += wq[q] * hi.x; x[j].w += wq[q] * hi.y; }
    }
}
template <int NEV, bool COMBINE>
DI void nr_phase(Frame& F, const bf16_t* base, const unsigned char* Y, const int* slot, bf16_t* xout, const float* g, bf16_t* XN, unsigned char* XN8,
                 const float* Wsrc, int ldw, int col0, float* outv, const float* b_i, const float* b_f) {
    LAS float* Wt = (LAS float*)F.lds;
    { f32x4 wv[NEV / 2];
#pragma unroll
      for (int i = 0; i < NEV / 2; ++i) { const int idx = F.tid + i * NTHR, d = idx / (NEV / 4), e4 = idx % (NEV / 4); wv[i] = *(const f32x4*)(Wsrc + (size_t)d * ldw + col0 + 4 * e4); }
#pragma unroll
      for (int i = 0; i < NEV / 2; ++i) { const int idx = F.tid + i * NTHR, d = idx / (NEV / 4), e4 = idx % (NEV / 4);
#pragma unroll
          for (int q = 0; q < 4; ++q) Wt[(4 * e4 + q) * 1024 + d] = wv[i][q]; } }
    const int gw = F.vcu * NWAVES + F.wave, NGW = F.G * NWAVES, lane = F.lane;
    LAS float* res = (LAS float*)(F.lds + AUX_OFF) + F.wave * 64;
    f32x4 gg[4];
#pragma unroll
    for (int j = 0; j < 4; ++j) gg[j] = *((const f32x4*)g + lane + 64 * j);
    __syncthreads();
#pragma unroll 1
    for (int m0 = gw; m0 < M; m0 += 4 * NGW) {
        f32x4 x[4][4]; int sl[4];
#pragma unroll
        for (int t4 = 0; t4 < 4; ++t4) { const int m = m0 + t4 * NGW < M ? m0 + t4 * NGW : m0;
#pragma unroll
            for (int j = 0; j < 4; ++j) { const u32x2 w = __builtin_nontemporal_load((const u32x2*)(base + (size_t)m * D) + lane + 64 * j);
                x[t4][j] = (f32x4){__builtin_bit_cast(float, w.x << 16), __builtin_bit_cast(float, w.x & 0xffff0000u), __builtin_bit_cast(float, w.y << 16), __builtin_bit_cast(float, w.y & 0xffff0000u)}; }
            sl[t4] = (COMBINE && lane < NE) ? slot[(size_t)m * NE + lane] : -1; }
#pragma unroll
        for (int pp = 0; pp < 4; pp += 2) {
            int mm[2]; float ssv[2];
#pragma unroll
            for (int u = 0; u < 2; ++u) {
                const int t4 = pp + u; const int m = m0 + t4 * NGW < M ? m0 + t4 * NGW : m0; mm[u] = m;
                if (COMBINE) add_routed_rows(x[t4], Y, sl[t4], m / SEQ, lane);
                if (xout) {
#pragma unroll
                    for (int j = 0; j < 4; ++j) { u32x2 w; w.x = cvt_pk_bf16(x[t4][j].x, x[t4][j].y); w.y = cvt_pk_bf16(x[t4][j].z, x[t4][j].w); *((u32x2*)(xout + (size_t)m * D) + lane + 64 * j) = w;
                        x[t4][j] = (f32x4){__builtin_bit_cast(float, w.x << 16), __builtin_bit_cast(float, w.x & 0xffff0000u), __builtin_bit_cast(float, w.y << 16), __builtin_bit_cast(float, w.y & 0xffff0000u)}; }
                }
                float ss = 0.f;
#pragma unroll
                for (int j = 0; j < 4; ++j) ss += (x[t4][j].x * x[t4][j].x + x[t4][j].y * x[t4][j].y) + (x[t4][j].z * x[t4][j].z + x[t4][j].w * x[t4][j].w);
                const float sst = wave_sum(ss); ssv[u] = sst;
                const float rinv = NEV == 16 ? 1.f : __builtin_amdgcn_rsqf(sst * (1.f / D) + RMS_EPS);
#pragma unroll
                for (int j = 0; j < 4; ++j) { x[t4][j] = x[t4][j] * rinv * gg[j];
                    if (NEV == 32) *((unsigned long long*)(XN + (size_t)m * D) + lane + 64 * j) = (unsigned long long)pk2(x[t4][j].x, x[t4][j].y) | ((unsigned long long)pk2(x[t4][j].z, x[t4][j].w) << 32);
                    else *((unsigned*)(XN8 + (size_t)m * D) + lane + 64 * j) = pk4_fp8(x[t4][j].x, x[t4][j].y, x[t4][j].z, x[t4][j].w); }
            }
#pragma unroll 1
            for (int eg = 0; eg < NEV / 4; ++eg) {
                float v8[8];
#pragma unroll
                for (int e4 = 0; e4 < 4; ++e4) { float s0 = 0.f, s1 = 0.f;
#pragma unroll
                    for (int j = 0; j < 4; ++j) { const f32x4 w = *((const LAS f32x4*)(Wt + (4 * eg + e4) * 1024) + lane + 64 * j);
                        s0 += (x[pp][j].x * w.x + x[pp][j].y * w.y) + (x[pp][j].z * w.z + x[pp][j].w * w.w); s1 += (x[pp + 1][j].x * w.x + x[pp + 1][j].y * w.y) + (x[pp + 1][j].z * w.z + x[pp + 1][j].w * w.w); }
                    v8[e4] = s0; v8[4 + e4] = s1; }
                const int i8 = multi_reduce<8>(v8, lane);
                if ((lane & 7) == 0) res[(i8 >> 2) * 32 + 4 * eg + (i8 & 3)] = v8[0];
            }
            asm volatile("s_waitcnt lgkmcnt(0)" ::: "memory");
            if (NEV == 16) {
                const int u = (lane >> 4) & 1, e = lane & 15, m = mm[u];
                if (lane < 32) { outv[(size_t)e * M + m] = res[u * 32 + e]; if (e == 0) outv[(size_t)16 * M + m] = ssv[u]; }
#pragma unroll
                for (int q = 0; q < 2; ++q) { const int idx = lane + 64 * q; if (idx < 102) { const int uu = idx / 51, r51 = idx % 51; outv[(size_t)(17 + r51) * M + mm[uu]] = 0.f; } }
            } else {
                const int u = lane >> 5, k = lane & 31, m = mm[u];
                const float v = res[u * 32 + k];
                const int kind = k >> 3, hd = k & 7, dir = kind >> 1;
                outv[(size_t)m * 32 + k] = (kind & 1) ? log_sigmoid(v + b_f[dir * 8 + hd]) : v + b_i[dir * 8 + hd];
            }
            asm volatile("" ::: "memory");
        }
    }
}
constexpr int NRM_WB = 0, NRM_WB_LD = 2128, NRM_XR = 32 * NRM_WB_LD, NRM_XR_LD = 2112;
static_assert(NRM_XR + NWAVES * 4 * NRM_XR_LD <= AUX_OFF + AUX_BYTES, "nrm_phase LDS");
DI void nrm_phase(Frame& F, const bf16_t* base, const unsigned char* Y, const int* slot, bf16_t* xout, const float* g, float* RINV, unsigned char* XN8,
                  const float* Wsrc, int ldw, int col0, float* outv, const float* b_i, const float* b_f) {
    LAS unsigned char* lds = F.lds;
    { f32x4 wv[16];
#pragma unroll
      for (int i = 0; i < 16; ++i) { const int idx = F.tid + i * NTHR, d = idx >> 3, e4 = idx & 7; wv[i] = *(const f32x4*)(Wsrc + (size_t)d * ldw + col0 + 4 * e4); }
#pragma unroll
      for (int i = 0; i < 16; ++i) { const int idx = F.tid + i * NTHR, d = idx >> 3, e4 = idx & 7;
#pragma unroll
          for (int q = 0; q < 4; ++q) *(LAS unsigned short*)(lds + NRM_WB + (4 * e4 + q) * NRM_WB_LD + d * 2) = (unsigned short)f2bf(wv[i][q]); } }
    const int gw = F.vcu * NWAVES + F.wave, NGW = F.G * NWAVES, lane = F.lane, fr = lane & 15, fq = lane >> 4;
    LAS unsigned char* xr = lds + NRM_XR + F.wave * 4 * NRM_XR_LD;
    f32x4 gg[4];
#pragma unroll
    for (int j = 0; j < 4; ++j) gg[j] = *((const f32x4*)g + lane + 64 * j);
    float bias[2]; bool isf[2];
#pragma unroll
    for (int n = 0; n < 2; ++n) { const int k = fr + 16 * n, kind = k >> 3, hd = k & 7, dir = kind >> 1; isf[n] = (kind & 1) != 0; bias[n] = isf[n] ? b_f[dir * 8 + hd] : b_i[dir * 8 + hd]; }
    __syncthreads();
#pragma unroll 1
    for (int m0 = gw; m0 < M; m0 += 4 * NGW) {
        f32x4 x[4][4]; int sl[4]; int mm[4];
#pragma unroll
        for (int t4 = 0; t4 < 4; ++t4) { const int m = m0 + t4 * NGW < M ? m0 + t4 * NGW : m0; mm[t4] = m;
#pragma unroll
            for (int j = 0; j < 4; ++j) { const u32x2 w = __builtin_nontemporal_load((const u32x2*)(base + (size_t)m * D) + lane + 64 * j);
                x[t4][j] = (f32x4){__builtin_bit_cast(float, w.x << 16), __builtin_bit_cast(float, w.x & 0xffff0000u), __builtin_bit_cast(float, w.y << 16), __builtin_bit_cast(float, w.y & 0xffff0000u)}; }
            sl[t4] = lane < NE ? slot[(size_t)m * NE + lane] : -1; }
#pragma unroll
        for (int t4 = 0; t4 < 4; ++t4) { const int m = mm[t4];
            add_routed_rows(x[t4], Y, sl[t4], m / SEQ, lane);
#pragma unroll
            for (int j = 0; j < 4; ++j) { u32x2 w; w.x = cvt_pk_bf16(x[t4][j].x, x[t4][j].y); w.y = cvt_pk_bf16(x[t4][j].z, x[t4][j].w); *((u32x2*)(xout + (size_t)m * D) + lane + 64 * j) = w;
                x[t4][j] = (f32x4){__builtin_bit_cast(float, w.x << 16), __builtin_bit_cast(float, w.x & 0xffff0000u), __builtin_bit_cast(float, w.y << 16), __builtin_bit_cast(float, w.y & 0xffff0000u)}; }
            float ss = 0.f;
#pragma unroll
            for (int j = 0; j < 4; ++j) ss += (x[t4][j].x * x[t4][j].x + x[t4][j].y * x[t4][j].y) + (x[t4][j].z * x[t4][j].z + x[t4][j].w * x[t4][j].w);
            const float rinv = __builtin_amdgcn_rsqf(wave_sum(ss) * (1.f / D) + RMS_EPS);
            if (lane == 0) RINV[m] = rinv;
#pragma unroll
            for (int j = 0; j < 4; ++j) { const f32x4 hn = x[t4][j] * rinv * gg[j]; u32x2 w; w.x = cvt_pk_bf16(hn.x, hn.y); w.y = cvt_pk_bf16(hn.z, hn.w);
                *(LAS u32x2*)(xr + t4 * NRM_XR_LD + (4 * lane + 256 * j) * 2) = w;
                *((unsigned*)(XN8 + (size_t)m * D) + lane + 64 * j) = pk4_fp8(hn.x, hn.y, hn.z, hn.w); }
        }
        asm volatile("s_waitcnt lgkmcnt(0)" ::: "memory");
        f32x4 ga[2] = {(f32x4){0.f, 0.f, 0.f, 0.f}, (f32x4){0.f, 0.f, 0.f, 0.f}};
#pragma unroll 4
        for (int ks = 0; ks < 32; ++ks) {
            bf16x8 a = (bf16x8){0, 0, 0, 0, 0, 0, 0, 0};
            if (fr < 4) a = *(const LAS bf16x8*)(xr + fr * NRM_XR_LD + (32 * ks + 8 * fq) * 2);
            const bf16x8 b0 = *(const LAS bf16x8*)(lds + NRM_WB + fr * NRM_WB_LD + (32 * ks + 8 * fq) * 2), b1 = *(const LAS bf16x8*)(lds + NRM_WB + (16 + fr) * NRM_WB_LD + (32 * ks + 8 * fq) * 2);
            ga[0] = __builtin_amdgcn_mfma_f32_16x16x32_bf16(a, b0, ga[0], 0, 0, 0); ga[1] = __builtin_amdgcn_mfma_f32_16x16x32_bf16(a, b1, ga[1], 0, 0, 0);
        }
        if (fq == 0) {
#pragma unroll
            for (int n = 0; n < 2; ++n)
#pragma unroll
                for (int j = 0; j < 4; ++j) { const float v = ga[n][j] + bias[n]; outv[(size_t)mm[j] * 32 + fr + 16 * n] = isf[n] ? log_sigmoid(v) : v; } }
        asm volatile("" ::: "memory");
    }
}
DI int block_excl_scan(int v, LAS int* wsum, int lane, int wave, int& total) {
    int inc = v;
#pragma unroll
    for (int o = 1; o < 64; o <<= 1) { const int t = __shfl_up(inc, o); if (lane >= o) inc += t; }
    if (lane == 63) wsum[wave] = inc;
    __syncthreads();
    int basev = 0, tot = 0;
#pragma unroll
    for (int w = 0; w < NWAVES; ++w) { const int x = wsum[w]; basev += (w < wave) ? x : 0; tot += x; }
    __syncthreads();
    total = tot;
    return basev + inc - v;
}
DI void topk_phase(Frame& F, const float* part, int* idxrow, float* gate, float* rsc, int* slot) {
    LAS unsigned* hist = (LAS unsigned*)F.lds; LAS unsigned* sh = hist + 4096; LAS int* wsum = (LAS int*)(hist + 4112);
    const int tid = F.tid;
    for (int p = blockIdx.x; p < NB * NE; p += F.G) {
        const int b = (p & 7) >> 1, e = 8 * (p & 1) + (p >> 3);
        unsigned v[8]; float rinv8[8];
        { const float* pb = part + (size_t)b * SEQ + 8 * tid;
          float ssum[8], mx[8], sm[8], lm[8];
#pragma unroll
          for (int i = 0; i < 8; ++i) { ssum[i] = 0.f; mx[i] = -__builtin_inff(); sm[i] = 0.f; lm[i] = 0.f; }
#pragma unroll
          for (int pn = 0; pn < 4; ++pn) { const f32x4 a0 = *(const f32x4*)(pb + (size_t)(pn * 17 + 16) * M), a1 = *(const f32x4*)(pb + (size_t)(pn * 17 + 16) * M + 4);
#pragma unroll
              for (int i = 0; i < 4; ++i) { ssum[i] += a0[i]; ssum[4 + i] += a1[i]; } }
#pragma unroll
          for (int i = 0; i < 8; ++i) rinv8[i] = __builtin_amdgcn_rsqf(ssum[i] * (1.f / D) + RMS_EPS);
#pragma unroll 4
          for (int ee = 0; ee < NE; ++ee) { float l[8];
#pragma unroll
              for (int i = 0; i < 8; ++i) l[i] = 0.f;
#pragma unroll
              for (int pn = 0; pn < 4; ++pn) { const f32x4 a0 = *(const f32x4*)(pb + (size_t)(pn * 17 + ee) * M), a1 = *(const f32x4*)(pb + (size_t)(pn * 17 + ee) * M + 4);
#pragma unroll
                  for (int i = 0; i < 4; ++i) { l[i] += a0[i]; l[4 + i] += a1[i]; } }
#pragma unroll
              for (int i = 0; i < 8; ++i) { const float li = l[i] * rinv8[i], mn = fmaxf(mx[i], li); sm[i] = sm[i] * __expf(mx[i] - mn) + __expf(li - mn); mx[i] = mn; lm[i] = ee == e ? li : lm[i]; } }
#pragma unroll
          for (int i = 0; i < 8; ++i) v[i] = __builtin_bit_cast(unsigned, __expf(lm[i] - mx[i]) * __builtin_amdgcn_rcpf(sm[i])); }
        unsigned prefix = 0u; int need = CAP;
#pragma unroll 1
        for (int pass = 0; pass < 3; ++pass) {
            const int shift = pass == 0 ? 19 : (pass == 1 ? 7 : 0), hs = pass == 0 ? 31 : (pass == 1 ? 19 : 7);
            *((LAS u32x4*)hist + 2 * tid) = (u32x4){0u, 0u, 0u, 0u}; *((LAS u32x4*)hist + 2 * tid + 1) = (u32x4){0u, 0u, 0u, 0u};
            __syncthreads();
#pragma unroll
            for (int i = 0; i < 8; ++i) if (pass == 0 || (v[i] >> hs) == prefix) __hip_atomic_fetch_add(&hist[(v[i] >> shift) & (pass == 2 ? 0x7fu : 0xfffu)], 1u, __ATOMIC_RELAXED, __HIP_MEMORY_SCOPE_WORKGROUP);
            __syncthreads();
            const u32x4 c0 = *((const LAS u32x4*)hist + 2 * tid), c1 = *((const LAS u32x4*)hist + 2 * tid + 1);
            const int cnt[8] = {(int)c0.x, (int)c0.y, (int)c0.z, (int)c0.w, (int)c1.x, (int)c1.y, (int)c1.z, (int)c1.w};
            const int ls = ((cnt[0] + cnt[1]) + (cnt[2] + cnt[3])) + ((cnt[4] + cnt[5]) + (cnt[6] + cnt[7]));
            int tot; const int pre = block_excl_scan(ls, wsum, F.lane, F.wave, tot);
            int run = tot - pre - ls;
#pragma unroll
            for (int j = 7; j >= 0; --j) { if (run < need && run + cnt[j] >= need) { sh[0] = (unsigned)(8 * tid + j); sh[1] = (unsigned)(need - run); } run += cnt[j]; }
            __syncthreads();
            prefix = pass == 0 ? sh[0] : ((prefix << (pass == 1 ? 12 : 7)) | sh[0]); need = (int)sh[1];
        }
        const unsigned T = prefix;
        int ce = 0;
#pragma unroll
        for (int i = 0; i < 8; ++i) ce += (v[i] == T) ? 1 : 0;
        int tot;
        int eqr = block_excl_scan(ce, wsum, F.lane, F.wave, tot);
        unsigned selm = 0u; int cs = 0;
#pragma unroll
        for (int i = 0; i < 8; ++i) { bool sel = v[i] > T; if (v[i] == T) { sel = eqr < need; ++eqr; } if (sel) { selm |= 1u << i; ++cs; } }
        int pos = block_excl_scan(cs, wsum, F.lane, F.wave, tot);
#pragma unroll
        for (int i = 0; i < 8; ++i) { const int t = 8 * tid + i; int sv = -1;
            if (selm & (1u << i)) { const int row = (e * NB + b) * CAP + pos; idxrow[row] = b * SEQ + t; gate[row] = __builtin_bit_cast(float, v[i]); rsc[row] = rinv8[i]; sv = pos; ++pos; }
            slot[(size_t)(b * SEQ + t) * NE + e] = sv; }
        __syncthreads();
    }
}
DI void combine_phase(Frame& F, const bf16_t* base, const unsigned char* Y, const int* slot, float* out) {
    const int gw = F.vcu * NWAVES + F.wave, NGW = F.G * NWAVES, lane = F.lane;
    for (int m0 = gw; m0 < M; m0 += 4 * NGW) {
        f32x4 x[4][4]; int sl[4];
#pragma unroll
        for (int t4 = 0; t4 < 4; ++t4) { const int m = m0 + t4 * NGW < M ? m0 + t4 * NGW : m0;
#pragma unroll
            for (int j = 0; j < 4; ++j) { const u32x2 w = __builtin_nontemporal_load((const u32x2*)(base + (size_t)m * D) + lane + 64 * j);
                x[t4][j] = (f32x4){__builtin_bit_cast(float, w.x << 16), __builtin_bit_cast(float, w.x & 0xffff0000u), __builtin_bit_cast(float, w.y << 16), __builtin_bit_cast(float, w.y & 0xffff0000u)}; }
            sl[t4] = lane < NE ? slot[(size_t)m * NE + lane] : -1; }
#pragma unroll
        for (int t4 = 0; t4 < 4; ++t4) { const int m = m0 + t4 * NGW < M ? m0 + t4 * NGW : m0;
            add_routed_rows(x[t4], Y, sl[t4], m / SEQ, lane);
#pragma unroll
            for (int j = 0; j < 4; ++j) __builtin_nontemporal_store(x[t4][j], (f32x4*)(out + (size_t)m * D) + lane + 64 * j); }
    }
}
DI void moe_up_phase(Frame& F, unsigned char* ws, int l) {
    pg8::MoeUpOrder S{F.vcu, F.G, (const char*)(ws + WS_W13 + (size_t)l * W13_LAYER)};
    LAS int* il = (LAS int*)(F.lds + AUX_OFF); const int* idxrow = (const int*)(ws + WS_IDX);
    pg8::Unit u;
    LAS float* rl = (LAS float*)(F.lds + AUX_OFF + 8192); const float* rsc = (const float*)(ws + WS_RSC);
    for (int i = 0; i < 8 && S.next(i, u); ++i) { if (F.tid < 256) il[i * 256 + F.tid] = idxrow[u.pm * 256 + F.tid]; else rl[i * 256 + F.tid - 256] = rsc[u.pm * 256 + F.tid - 256]; }
    __syncthreads();
    pg8::EpiSwiGLU E{(unsigned char*)(ws + WS_H), rl};
    pg8::gemm_phase<pg8::EpiSwiGLU, pg8::MoeUpOrder, true, true, true>(F.lds, il, (const void*)(ws + WS_XN8), D, S, E);
}
DI void moe_down_phase(Frame& F, unsigned char* ws, int l) {
    pg8::MoeDownOrder S{F.vcu, F.G, (const char*)(ws + WS_W2 + (size_t)l * W2_LAYER)};
    pg8::EpiFp8 E{ws + WS_Y, D, (const float*)(ws + WS_GATE), 0.03125f * YS8};
    pg8::gemm_phase<pg8::EpiFp8, pg8::MoeDownOrder, false, true, true, true>(F.lds, nullptr, (const void*)(ws + WS_H), DE, S, E);
}

constexpr float STS8 = 16.f;

DI int off128r(int row, int chunk) { return row * 128 + ((chunk ^ ((row >> 1) & 7)) << 4); }
DI int off128t(int row, int colbyte) { return row * 128 + (colbyte ^ (((row >> 1) & 1) << 6)); }
DI int off256t(int row, int colbyte) { return row * 256 + (colbyte ^ ((row & 3) << 6)); }
DI float wave_max(float v) {
#pragma unroll
    for (int o = 1; o < 64; o <<= 1) v = fmaxf(v, __shfl_xor(v, o));
    return v;
}
DI float incl_prefix(float v, int lane) {
#pragma unroll
    for (int o = 1; o < 64; o <<= 1) { const float t = __shfl_up(v, o); if (lane >= o) v += t; }
    return v;
}
DI float incl_suffix(float v, int lane) {
#pragma unroll
    for (int o = 1; o < 64; o <<= 1) { const float t = __shfl_down(v, o); if (lane + o < 64) v += t; }
    return v;
}
DI float incl_prefix_max(float v, int lane) {
#pragma unroll
    for (int o = 1; o < 64; o <<= 1) { const float t = __shfl_up(v, o); if (lane >= o) v = fmaxf(v, t); }
    return v;
}
DI float incl_suffix_max(float v, int lane) {
#pragma unroll
    for (int o = 1; o < 64; o <<= 1) { const float t = __shfl_down(v, o); if (lane + o < 64) v = fmaxf(v, t); }
    return v;
}
DI u32x4 scale_bf16x8(u32x4 v, float w) {
    u32x4 o;
#pragma unroll
    for (int i = 0; i < 4; ++i) { const float lo = __builtin_bit_cast(float, v[i] << 16) * w, hi = __builtin_bit_cast(float, v[i] & 0xffff0000u) * w; o[i] = cvt_pk_bf16(lo, hi); }
    return o;
}
constexpr int SS_KW = 0, SS_V = 32768, SS_WS = 98304, SS_SC = 114688;
DI int ss_kw_off(int row, int colbyte) { return row * 128 + (colbyte ^ ((((row >> 1) & 1) | (((row >> 3) & 1) << 1)) << 5)); }
DI int ss_v_off(int row, int colbyte) { return row * 256 + (colbyte ^ ((row & 3) << 6) ^ (((row >> 3) & 1) << 5)); }
template <int ES> DI void mlstm_scan_seq(Frame& F, unsigned char* ws, int seq, int half) {
    static_assert(ES == 2, "the fp8 v tile staging is written for two workgroups per sequence");
    constexpr int NT = 4 / ES, VB = 16384 / ES; const int eoff = half * (128 / ES); const unsigned char* PV = ws + WS_PVO;
    LAS unsigned char* lds = F.lds;
    const bf16_t* P = (const bf16_t*)(ws + WS_PROJ); const float* MG = (const float*)(ws + WS_MG);
    unsigned char* STATE = ws + WS_STATE; float* NST = (float*)(ws + WS_NST); float* MST = (float*)(ws + WS_MST);
    const int tid = F.tid, lane = F.lane, wave = F.wave, fr = lane & 15, fq = lane >> 4;
    LAS float* WS = (LAS float*)(lds + SS_WS); LAS float* ML = (LAS float*)(lds + SS_SC); LAS float* BL = ML + 64; LAS float* DEC = ML + 128; LAS float* LINJ = ML + 192; LAS float* MENT = ML + 256;
    {
        const int dir = seq >> 5, bh = seq & 31, b = bh >> 3, hd = bh & 7;
        __syncthreads();
        float igv[8], lfv[8];
#pragma unroll
        for (int i = 0; i < 8; ++i) { const float* mg = MG + ((size_t)b * SEQ + 64 * (8 * wave + i) + lane) * 32 + hd; igv[i] = mg[dir ? 16 : 0]; lfv[i] = mg[dir ? 24 : 8]; }
        float bT[8], cM[8], uM[8], be[8];
#pragma unroll
        for (int i = 0; i < 8; ++i) { const int c = 8 * wave + i; const float ig = igv[i], lf = lfv[i];
            float g, bl, u;
            if (dir == 0) { const float bf = incl_prefix(lf, lane); bl = __shfl(bf, 63); g = bl - bf + ig; bT[i] = bf; u = ig - bf; cM[i] = incl_prefix_max(u, lane); }
            else { const float sb = incl_suffix(lf, lane); bl = __shfl(sb, 0); g = (bl - sb) + ig; bT[i] = sb; u = ig - sb; cM[i] = incl_suffix_max(u, lane); }
            uM[i] = wave_max(u); be[i] = __expf(u - uM[i]);
            const float ml = wave_max(g);
            WS[c * 64 + lane] = g - ml; if (lane == 0) { ML[c] = ml; BL[c] = bl; } }
        __syncthreads();
        if (wave == 0) { const int cl = dir ? 63 - lane : lane; const float mlv = ML[cl], blv = BL[cl];
            float m = 0.f, ment = 0.f, mnv = 0.f;
#pragma unroll
            for (int k = 0; k < 64; ++k) { const float ml = __builtin_bit_cast(float, __builtin_amdgcn_readlane(__builtin_bit_cast(int, mlv), k)), bl = __builtin_bit_cast(float, __builtin_amdgcn_readlane(__builtin_bit_cast(int, blv), k));
                const float mn = fmaxf(bl + m, ml); if (lane == k) { ment = m; mnv = mn; } m = mn; }
            const float dec = __expf(blv + ment - mnv), linj = mlv - mnv;
            DEC[lane] = dec; LINJ[cl] = linj; MENT[lane] = ment;
            if (half == 0) MST[(size_t)seq * 64 + cl] = ment; }
        __syncthreads();
#pragma unroll
        for (int i = 0; i < 8; ++i) { const int idx = tid + i * NTHR; WS[idx] = __expf(WS[idx] + LINJ[idx >> 6]); }
        if (half == 0) {
#pragma unroll
            for (int i = 0; i < 8; ++i) { const int c = 8 * wave + i; const float ment = MENT[dir ? 63 - c : c], a_ = bT[i] + ment, mt = fmaxf(a_, bT[i] + cM[i]);
                ((f32x4*)(ws + WS_GT))[(size_t)seq * SEQ + 64 * c + lane] = (f32x4){be[i], __expf(bT[i] + uM[i] - mt), __expf(a_ - mt), __expf(-mt)}; } }
        const int krow = tid >> 3, kc = tid & 7;
        const int eh = wave >> 2, dt = wave & 3;
        f32x4 C[NT], Nacc = (f32x4){0.f, 0.f, 0.f, 0.f};
#pragma unroll
        for (int i = 0; i < NT; ++i) C[i] = (f32x4){0.f, 0.f, 0.f, 0.f};
        const bf16x8 ones = (bf16x8){0x3f80, 0x3f80, 0x3f80, 0x3f80, 0x3f80, 0x3f80, 0x3f80, 0x3f80};
        const size_t tokb = (size_t)b * SEQ;
        u32x4 kreg[2][2], vreg[2][2][2 / ES];
#define SS_LOAD(st_, kp_) do { _Pragma("unroll") for (int sb_ = 0; sb_ < 2; ++sb_) { const int kk_ = 2 * (kp_) + sb_; const int cn_ = dir ? 63 - kk_ : kk_; \
            kreg[st_][sb_] = *(const u32x4*)(P + (tokb + 64 * cn_ + krow) * MIN_N + 512 + hd * 64 + kc * 8); \
            vreg[st_][sb_][0] = *(const u32x4*)(PV + (tokb + 64 * cn_ + ((tid & 255) >> 2)) * 2048 + hd * 128 + eoff + (tid & 3) * 16); } } while (0)
#define SS_PAIR(st, kp) do { const int buf = (kp) & 1; \
            _Pragma("unroll") for (int sb = 0; sb < 2; ++sb) { const int k = 2 * (kp) + sb, c = dir ? 63 - k : k; \
                *(LAS u32x4*)(lds + SS_KW + (buf * 2 + sb) * 8192 + ss_kw_off(krow, kc * 16)) = scale_bf16x8(kreg[st][sb], WS[c * 64 + krow]); \
                if (tid < 256) { u32x4 v0_, v1_; fp8x16_to_bf16(vreg[st][sb][0], v0_, v1_); const int vr = tid >> 2, vc2 = 2 * (tid & 3); \
                    *(LAS u32x4*)(lds + SS_V + (buf * 2 + sb) * VB + ss_kw_off(vr, vc2 * 16)) = v0_; *(LAS u32x4*)(lds + SS_V + (buf * 2 + sb) * VB + ss_kw_off(vr, (vc2 + 1) * 16)) = v1_; } } \
            if ((kp) + 2 < 32) SS_LOAD(st, (kp) + 2); \
            asm volatile("s_waitcnt lgkmcnt(0)" ::: "memory"); __builtin_amdgcn_s_barrier(); asm volatile("" ::: "memory"); \
            _Pragma("unroll") for (int sb = 0; sb < 2; ++sb) { const int k = 2 * (kp) + sb, c = dir ? 63 - k : k; \
                {   \
                    const auto sw_ = __builtin_amdgcn_permlane16_swap(pk4_fp8s(C[0].x * STS8, C[0].y * STS8, C[0].z * STS8, C[0].w * STS8), pk4_fp8s(C[1].x * STS8, C[1].y * STS8, C[1].z * STS8, C[1].w * STS8), false, false); \
                    const u32x2 w = {sw_[0], sw_[1]}; \
                    *(u32x2*)(STATE + ((size_t)seq * 64 + c) * 8192 + (size_t)(eoff + 16 * (eh + 2 * (fq & 1)) + fr) * 64 + 16 * dt + 8 * (fq >> 1)) = w; } \
                if (half == 0 && eh == 0 && fr == 0) *(f32x4*)(NST + ((size_t)seq * 64 + c) * 64 + 16 * dt + 4 * fq) = Nacc; \
                const float dec = DEC[k]; Nacc = Nacc * dec; \
                _Pragma("unroll") for (int i = 0; i < NT; ++i) C[i] = C[i] * dec; \
                _Pragma("unroll") for (int s2 = 0; s2 < 2; ++s2) { \
                    const int r0 = 32 * s2 + 8 * fq + ((lane & 15) >> 2), r1 = r0 + 4, cbk = 32 * dt + 8 * (lane & 3); \
                    const bf16x8 af = cat8(tr_read(lds + SS_KW + (buf * 2 + sb) * 8192 + ss_kw_off(r0, cbk)), tr_read(lds + SS_KW + (buf * 2 + sb) * 8192 + ss_kw_off(r1, cbk))); \
                    _Pragma("unroll") for (int i = 0; i < NT; ++i) { const int cbv = 32 * (eh + 2 * i) + 8 * (lane & 3); \
                        const bf16x8 bfv = cat8(tr_read(lds + SS_V + (buf * 2 + sb) * VB + (ES == 1 ? ss_v_off(r0, cbv) : ss_kw_off(r0, cbv))), tr_read(lds + SS_V + (buf * 2 + sb) * VB + (ES == 1 ? ss_v_off(r1, cbv) : ss_kw_off(r1, cbv)))); \
                        C[i] = __builtin_amdgcn_mfma_f32_16x16x32_bf16(af, bfv, C[i], 0, 0, 0); } \
                    if (eh == 0) Nacc = __builtin_amdgcn_mfma_f32_16x16x32_bf16(af, ones, Nacc, 0, 0, 0); } } } while (0)
        SS_LOAD(0, 0); SS_LOAD(1, 1);
        __syncthreads();
#pragma unroll 1
        for (int kp2 = 0; kp2 < 32; kp2 += 2) { SS_PAIR(0, kp2); SS_PAIR(1, kp2 + 1); }
#undef SS_PAIR
#undef SS_LOAD
    }
}
constexpr int SCAN_ES = 2, SCAN_WGS = 64 * SCAN_ES, SCAN_STRIDE = 256 / SCAN_WGS;
DI void mlstm_scan_phase(Frame& F, const Args& a) {
    if (F.G == 256) {
        if (F.vcu % SCAN_STRIDE == 0) { const int sw = F.vcu / SCAN_STRIDE; mlstm_scan_seq<SCAN_ES>(F, a.ws, sw / SCAN_ES, sw % SCAN_ES); }
        else expert_conv_items(F, a, XI_C_END, XI_TOTAL, ((F.vcu / SCAN_STRIDE) * (SCAN_STRIDE - 1) + F.vcu % SCAN_STRIDE - 1) * NWAVES + F.wave, (256 - SCAN_WGS) * NWAVES);
    } else {
        for (int sw = F.vcu; sw < SCAN_WGS; sw += F.G) mlstm_scan_seq<SCAN_ES>(F, a.ws, sw / SCAN_ES, sw % SCAN_ES);
        if (F.vcu == 0) expert_conv_items(F, a, XI_C_END, XI_TOTAL, F.wave, NWAVES);
    }
}
constexpr int S3_Q = 0, S3_KF = 8192, S3_KB = 16384, S3_V = 24576, S3_CF = 40960, S3_CB = 57344, S3_HS = 73728, S3_HS_LD = 132, S3_SM = 108544;
DI void mlstm_s3_phase(Frame& F, const Args& a) {
    unsigned char* ws = a.ws; LAS unsigned char* lds = F.lds;
    const bf16_t* P = (const bf16_t*)(ws + WS_PROJ); const float* MG = (const float*)(ws + WS_MG);
    const unsigned char* STATE = ws + WS_STATE; const float* NST = (const float*)(ws + WS_NST); const float* MST = (const float*)(ws + WS_MST);
    bf16_t* Y2 = (bf16_t*)(ws + WS_Y2); const float* outg = a.in[IN_MOG];
    const int tid = F.tid, lane = F.lane, wave = F.wave, r = lane & 31, h = lane >> 5;
    const int q4 = (lane & 15) >> 2, p4 = lane & 3, blk = (lane >> 4) & 1;
    LAS float* ALPHA = (LAS float*)(lds + S3_SM); LAS float* EA = ALPHA + 128; LAS float* EMT = ALPHA + 256; LAS unsigned short* NB16 = (LAS unsigned short*)(ALPHA + 384);
    LAS float* HS = (LAS float*)(lds + S3_HS);
    const unsigned char* PV = ws + WS_PVO;
    u32x4 rq, rk, rv, rcf, rcb, rog; f32x4 gt0, gt1; float pn[2];
#define S3_LOAD(u_) do { const int c_ = (u_) & 63, bh_ = (u_) >> 6, b_ = bh_ >> 3, hd_ = bh_ & 7; const size_t tk_ = (size_t)b_ * SEQ + 64 * c_; \
        { const int row = tid >> 3, kc = tid & 7; rq = *(const u32x4*)(P + (tk_ + row) * MIN_N + hd_ * 64 + kc * 8); rk = *(const u32x4*)(P + (tk_ + row) * MIN_N + 512 + hd_ * 64 + kc * 8); } \
        rv = *(const u32x4*)(PV + (tk_ + (tid >> 3)) * 2048 + hd_ * 128 + (tid & 7) * 16); \
        rcf = __builtin_nontemporal_load((const u32x4*)(STATE + ((size_t)(0 * 32 + bh_) * 64 + c_) * 8192) + tid); rcb = __builtin_nontemporal_load((const u32x4*)(STATE + ((size_t)(1 * 32 + bh_) * 64 + c_) * 8192) + tid); \
        rog = *(const u32x4*)(PV + (tk_ + (tid >> 3)) * 2048 + 1024 + hd_ * 128 + (tid & 7) * 16); \
        gt0 = ((const f32x4*)(ws + WS_GT))[(size_t)(0 * 32 + bh_) * SEQ + 64 * c_ + lane]; gt1 = ((const f32x4*)(ws + WS_GT))[(size_t)(1 * 32 + bh_) * SEQ + 64 * c_ + lane]; \
        pn[0] = NST[((size_t)(0 * 32 + bh_) * 64 + c_) * 64 + lane]; pn[1] = NST[((size_t)(1 * 32 + bh_) * 64 + c_) * 64 + lane]; } while (0)
    if (F.vcu < 2048) S3_LOAD(F.vcu);
    for (int u = F.vcu; u < 2048; u += F.G) {
        const int c = u & 63, bh = u >> 6, b = bh >> 3, hd = bh & 7; const size_t tok0 = (size_t)b * SEQ + 64 * c;
        const float beta_f = gt0.x, beta_b = gt1.x;
        __syncthreads();
        if (wave == 0) { ALPHA[lane] = gt0.y; EA[lane] = gt0.z; EMT[lane] = gt0.w; ALPHA[64 + lane] = gt1.y; EA[64 + lane] = gt1.z; EMT[64 + lane] = gt1.w;
            NB16[lane] = (unsigned short)f2bf(pn[0]); NB16[64 + lane] = (unsigned short)f2bf(pn[1]); }
        { const int row = tid >> 3, kc = tid & 7; const float wf = __shfl(beta_f, row & 63), wb = __shfl(beta_b, row & 63);
          *(LAS u32x4*)(lds + S3_Q + off128r(row, kc)) = rq;
          *(LAS u32x4*)(lds + S3_KF + off128r(row, kc)) = scale_bf16x8(rk, wf); *(LAS u32x4*)(lds + S3_KB + off128r(row, kc)) = scale_bf16x8(rk, wb); }
#pragma unroll
        for (int dd = 0; dd < 2; ++dd) { const int erow = tid >> 2, ec = 2 * (tid & 3); u32x4 c0_, c1_; fp8x16_to_bf16(dd ? rcb : rcf, c0_, c1_);
            *(LAS u32x4*)(lds + (dd ? S3_CB : S3_CF) + off128r(erow, ec)) = c0_; *(LAS u32x4*)(lds + (dd ? S3_CB : S3_CF) + off128r(erow, ec + 1)) = c1_; }
        { u32x4 v0_, v1_; fp8x16_to_bf16(rv, v0_, v1_); const int vr = tid >> 3, vc2 = 2 * (tid & 7);
          *(LAS u32x4*)(lds + S3_V + off256t(vr, vc2 * 16)) = v0_; *(LAS u32x4*)(lds + S3_V + off256t(vr, (vc2 + 1) * 16)) = v1_; }
        u32x4 og0, og1; fp8x16_to_bf16(rog, og0, og1);
        if (u + F.G < 2048) S3_LOAD(u + F.G);
        __syncthreads();
        const int et = wave >> 1, tt = wave & 1, t = 32 * tt + r;
        bf16x8 qf[4];
#pragma unroll
        for (int s4 = 0; s4 < 4; ++s4) qf[s4] = *(const LAS bf16x8*)(lds + S3_Q + off128r(t, 2 * s4 + h));
        f32x16 pF, pB, pO;
#pragma unroll
        for (int i = 0; i < 16; ++i) { pF[i] = 0.f; pB[i] = 0.f; pO[i] = 0.f; }
        const int so = 1 - tt; const int koff = tt == 0 ? S3_KB : S3_KF;
#pragma unroll
        for (int s4 = 0; s4 < 4; ++s4) {
            const bf16x8 kF = *(const LAS bf16x8*)(lds + S3_KF + off128r(32 * tt + r, 2 * s4 + h)), kB = *(const LAS bf16x8*)(lds + S3_KB + off128r(32 * tt + r, 2 * s4 + h));
            const bf16x8 kO = *(const LAS bf16x8*)(lds + koff + off128r(32 * so + r, 2 * s4 + h));
            pF = __builtin_amdgcn_mfma_f32_32x32x16_bf16(kF, qf[s4], pF, 0, 0, 0);
            pB = __builtin_amdgcn_mfma_f32_32x32x16_bf16(kB, qf[s4], pB, 0, 0, 0);
            pO = __builtin_amdgcn_mfma_f32_32x32x16_bf16(kO, qf[s4], pO, 0, 0, 0);
        }
        float rsF = 0.f, rsB = 0.f, rsO = 0.f;
#pragma unroll
        for (int i = 0; i < 16; ++i) { const int sl_ = (i & 3) + 8 * (i >> 2) + 4 * h;
            pF[i] = sl_ <= r ? pF[i] : 0.f; pB[i] = sl_ >= r ? pB[i] : 0.f; rsF += pF[i]; rsB += pB[i]; rsO += pO[i]; }
        rsF += __shfl_xor(rsF, 32); rsB += __shfl_xor(rsB, 32); rsO += __shfl_xor(rsO, 32);
        if (tt == 0) rsB += rsO; else rsF += rsO;
        asm volatile("" ::: "memory");
        float qnf, qnb;
        {   f32x16 qn;
#pragma unroll
            for (int i = 0; i < 16; ++i) qn[i] = 0.f;
#pragma unroll
            for (int s4 = 0; s4 < 4; ++s4) { const bf16x8 nF = *(const LAS bf16x8*)(NB16 + 16 * s4 + 8 * h); qn = __builtin_amdgcn_mfma_f32_32x32x16_bf16(nF, qf[s4], qn, 0, 0, 0); }
            qnf = qn[0];
#pragma unroll
            for (int i = 0; i < 16; ++i) qn[i] = 0.f;
#pragma unroll
            for (int s4 = 0; s4 < 4; ++s4) { const bf16x8 nB = *(const LAS bf16x8*)(NB16 + 64 + 16 * s4 + 8 * h); qn = __builtin_amdgcn_mfma_f32_32x32x16_bf16(nB, qf[s4], qn, 0, 0, 0); }
            qnb = qn[0]; }
        const float alF = ALPHA[t], eaF = EA[t], emF = EMT[t], alB = ALPHA[64 + t], eaB = EA[64 + t], emB = EMT[64 + t];
        const float invF = __builtin_amdgcn_rcpf(fmaxf(fabsf(eaF * qnf + alF * rsF), emF)), invB = __builtin_amdgcn_rcpf(fmaxf(fabsf(eaB * qnb + alB * rsB), emB));
        asm volatile("" ::: "memory");
        f32x16 hs;
        const int cbv = 64 * et + 32 * blk + 8 * p4;
        {   f32x16 it, in;
#pragma unroll
            for (int i = 0; i < 16; ++i) { it[i] = 0.f; in[i] = 0.f; }
#pragma unroll
            for (int s4 = 0; s4 < 4; ++s4) { const bf16x8 cF = *(const LAS bf16x8*)(lds + S3_CF + off128r(32 * et + r, 2 * s4 + h)); it = __builtin_amdgcn_mfma_f32_32x32x16_bf16(cF, qf[s4], it, 0, 0, 0); }
#pragma unroll
            for (int s2 = 0; s2 < 2; ++s2) { const int rd0 = 32 * tt + 16 * s2 + 4 * h + q4;
                const bf16x8 vD = cat8(tr_read(lds + S3_V + off256t(rd0, cbv)), tr_read(lds + S3_V + off256t(rd0 + 8, cbv)));
                in = __builtin_amdgcn_mfma_f32_32x32x16_bf16(vD, pack_step(pF, s2), in, 0, 0, 0);
                if (tt == 1) { const int ro0 = 16 * s2 + 4 * h + q4; const bf16x8 vO = cat8(tr_read(lds + S3_V + off256t(ro0, cbv)), tr_read(lds + S3_V + off256t(ro0 + 8, cbv)));
                    in = __builtin_amdgcn_mfma_f32_32x32x16_bf16(vO, pack_step(pO, s2), in, 0, 0, 0); } }
#pragma unroll
            for (int i = 0; i < 16; ++i) hs[i] = (eaF * (1.f / STS8) * it[i] + alF * in[i]) * invF;
        }
        asm volatile("" ::: "memory");
        {   f32x16 it, in;
#pragma unroll
            for (int i = 0; i < 16; ++i) { it[i] = 0.f; in[i] = 0.f; }
#pragma unroll
            for (int s4 = 0; s4 < 4; ++s4) { const bf16x8 cB = *(const LAS bf16x8*)(lds + S3_CB + off128r(32 * et + r, 2 * s4 + h)); it = __builtin_amdgcn_mfma_f32_32x32x16_bf16(cB, qf[s4], it, 0, 0, 0); }
#pragma unroll
            for (int s2 = 0; s2 < 2; ++s2) { const int rd0 = 32 * tt + 16 * s2 + 4 * h + q4;
                const bf16x8 vD = cat8(tr_read(lds + S3_V + off256t(rd0, cbv)), tr_read(lds + S3_V + off256t(rd0 + 8, cbv)));
                in = __builtin_amdgcn_mfma_f32_32x32x16_bf16(vD, pack_step(pB, s2), in, 0, 0, 0);
                if (tt == 0) { const int ro0 = 32 + 16 * s2 + 4 * h + q4; const bf16x8 vO = cat8(tr_read(lds + S3_V + off256t(ro0, cbv)), tr_read(lds + S3_V + off256t(ro0 + 8, cbv)));
                    in = __builtin_amdgcn_mfma_f32_32x32x16_bf16(vO, pack_step(pO, s2), in, 0, 0, 0); } }
#pragma unroll
            for (int i = 0; i < 16; ++i) hs[i] += (eaB * (1.f / STS8) * it[i] + alB * in[i]) * invB;
        }
#pragma unroll
        for (int i = 0; i < 16; ++i) HS[t * S3_HS_LD + 32 * et + (i & 3) + 8 * (i >> 2) + 4 * h] = hs[i];
        __syncthreads();
        { const int tr = tid >> 3, e0 = (tid & 7) * 16; float vv[16]; float ss = 0.f;
#pragma unroll
          for (int i = 0; i < 4; ++i) { const f32x4 x = *(const LAS f32x4*)(HS + tr * S3_HS_LD + e0 + 4 * i); vv[4 * i] = x[0]; vv[4 * i + 1] = x[1]; vv[4 * i + 2] = x[2]; vv[4 * i + 3] = x[3]; ss += (x[0] * x[0] + x[1] * x[1]) + (x[2] * x[2] + x[3] * x[3]); }
          ss += __shfl_xor(ss, 1); ss += __shfl_xor(ss, 2); ss += __shfl_xor(ss, 4);
          const float rinv = __builtin_amdgcn_rsqf(ss * (1.f / 128.f) + RMS_EPS);
          unsigned ow[8];
#pragma unroll
          for (int i = 0; i < 8; ++i) { const unsigned w = i < 4 ? og0[i] : og1[i - 4];
              const float o0 = __builtin_bit_cast(float, w << 16), o1 = __builtin_bit_cast(float, w & 0xffff0000u);
              const float g0 = outg[hd * 128 + e0 + 2 * i], g1 = outg[hd * 128 + e0 + 2 * i + 1];
              const float y0 = vv[2 * i] * rinv * g0 * __builtin_amdgcn_rcpf(1.f + __expf(-o0)), y1 = vv[2 * i + 1] * rinv * g1 * __builtin_amdgcn_rcpf(1.f + __expf(-o1));
              ow[i] = cvt_pk_bf16(y0, y1); }
          const size_t tk2 = tok0 + tr; const int col2 = hd * 128 + e0;
          bf16_t* yp = Y2 + (((tk2 >> 8) * 16 + (col2 >> 6)) * 256 + (tk2 & 255)) * 64 + (col2 & 63);
          *(u32x4*)yp = (u32x4){ow[0], ow[1], ow[2], ow[3]}; *(u32x4*)(yp + 8) = (u32x4){ow[4], ow[5], ow[6], ow[7]}; }
    }
#undef S3_LOAD
}

__global__ void __launch_bounds__(NTHR, 2) fwd_kernel(Args args) {
    extern __shared__ __attribute__((aligned(16))) unsigned char lds_raw[];
    Frame F;
    F.lds = (LAS unsigned char*)lds_raw;
    F.MISC = (volatile LAS unsigned*)(F.lds + MISC_OFF);
    F.tid = threadIdx.x; F.lane = F.tid & 63; F.wave = __builtin_amdgcn_readfirstlane(F.tid >> 6);
    F.G = gridDim.x; { const int bx = blockIdx.x; F.vcu = (F.G % 8 == 0) ? (bx % 8) * (F.G / 8) + bx / 8 : bx; }
    F.ctl = (unsigned*)(args.ws + WS_CTL);
    if (F.tid < 64) F.MISC[F.tid] = 0u;
    __syncthreads();
    XcdBarrier bar = xcd_barrier_post(F.ctl + CW_BAR, F.MISC + 8);
    const int lo = args.ph_lo, hi = args.ph_hi;
    unsigned char* ws = args.ws;
#define IN(k) (lo <= (k) && (k) < hi)
#define SEAM(k) do { if (IN(k) && IN((k) + 1)) xcd_barrier(bar); } while (0)

    if (IN(0)) { p0_prologue(F, args); } SEAM(0);
    if (IN(1)) {
        pg8::DenseOrder8 S; S.init(M, NQKV, F.G, (int)blockIdx.x, (const bf16_t*)(ws + WS_WQKV), D);
        pg8::EpiQKV E{(bf16_t*)(ws + WS_Q), (bf16_t*)(ws + WS_K), (bf16_t*)(ws + WS_V), args.in[IN_AQG], args.in[IN_AKG]};
        pg8::gemm_phase<pg8::EpiQKV, pg8::DenseOrder8, false, true, true>(F.lds, nullptr, (const void*)(ws + WS_XN8), D, S, E);
        if ((int)blockIdx.x >= 128 && F.G == 256) expert_conv_items(F, args, XI_PRO_END, XI_A_END, ((int)blockIdx.x - 128) * NWAVES + F.wave, 128 * NWAVES);
        else if (F.G != 256 && (int)blockIdx.x == 0) expert_conv_items(F, args, XI_PRO_END, XI_A_END, F.wave, NWAVES);
    } SEAM(1);
    if (IN(2)) { attn_phase(F, args); } SEAM(2);
    if (IN(3)) {
        pg8::DenseOrder8 S; S.init(M, D, F.G, (int)blockIdx.x, (const bf16_t*)(ws + WS_WAO), D);
        if (F.G == 256) { pg8::EpiResRoute<false> E{args.in[IN_X], (bf16_t*)(ws + WS_X1), ws + WS_XN8, (float*)(ws + WS_PART), args.in[IN_FNG], args.in[IN_RW], 1.f / 256.f};
            pg8::gemm_phase<pg8::EpiResRoute<false>, pg8::DenseOrder8, false, false, true>(F.lds, nullptr, (const void*)(ws + WS_O), D, S, E); }
        else { pg8::EpiRes<false, true> E{args.in[IN_X], (void*)(ws + WS_X1), D, 1.f / 256.f};
            pg8::gemm_phase<pg8::EpiRes<false, true>, pg8::DenseOrder8, false, false, true>(F.lds, nullptr, (const void*)(ws + WS_O), D, S, E); }
    } SEAM(3);
    if (IN(4) && F.G != 256) { nr_phase<16, false>(F, (const bf16_t*)(ws + WS_X1), nullptr, nullptr, nullptr, args.in[IN_FNG], nullptr, (unsigned char*)(ws + WS_XN8), args.in[IN_RW], NE, 0, (float*)(ws + WS_PART), nullptr, nullptr); }
    if (F.G != 256) SEAM(4);
    if (IN(5)) { topk_phase(F, (const float*)(ws + WS_PART), (int*)(ws + WS_IDX), (float*)(ws + WS_GATE), (float*)(ws + WS_RSC), (int*)(ws + WS_SLOT));
        if ((int)blockIdx.x >= 64) expert_conv_items(F, args, XI_A_END, XI_B_END, ((int)blockIdx.x - 64) * NWAVES + F.wave, (F.G - 64) * NWAVES); } SEAM(5);
    if (IN(6)) { moe_up_phase(F, ws, 0); } SEAM(6);
    if (IN(7)) { moe_down_phase(F, ws, 0); } SEAM(7);
    if (IN(8)) { nrm_phase(F, (const bf16_t*)(ws + WS_X1), (const unsigned char*)(ws + WS_Y), (const int*)(ws + WS_SLOT), (bf16_t*)(ws + WS_X2), args.in[IN_MNG], (float*)(ws + WS_RINV2), ws + WS_XN8,
                           args.in[IN_MWIN], MIN_LD, MIN_N, (float*)(ws + WS_MG), args.in[IN_MBI], args.in[IN_MBF]); } SEAM(8);
    if (IN(9)) {
        { pg8::DenseOrder S; S.init(M, 1024, F.G, (int)blockIdx.x, (const bf16_t*)(ws + WS_WMIN), D);
          pg8::EpiBf16 E{(bf16_t*)(ws + WS_PROJ), MIN_N, (const float*)(ws + WS_RINV2), 1.f, 0};
          pg8::gemm_phase<pg8::EpiBf16, pg8::DenseOrder, false, true, false>(F.lds, nullptr, (const bf16_t*)(ws + WS_X2), D, S, E); }
        { pg8::DenseOrder8 S; S.init(M, 2048, F.G, (int)blockIdx.x, (const bf16_t*)(ws + WS_WMIN8), D);
          pg8::EpiFp8 E{ws + WS_PVO, 2048, nullptr, 0.0625f};
          pg8::gemm_phase<pg8::EpiFp8, pg8::DenseOrder8, false, true, true>(F.lds, nullptr, (const void*)(ws + WS_XN8), D, S, E); }
    } SEAM(9);
    if (IN(10)) { mlstm_scan_phase(F, args); } SEAM(10);
    if (IN(12)) { mlstm_s3_phase(F, args); } SEAM(12);
    if (IN(13)) {
        pg8::DenseOrder S; S.init(M, D, F.G, (int)blockIdx.x, (const bf16_t*)(ws + WS_WMO), D);
        if (F.G == 256) { pg8::EpiResRoute<true> E{(const void*)(ws + WS_X2), (bf16_t*)(ws + WS_X3), ws + WS_XN8, (float*)(ws + WS_PART), args.in[IN_FNG] + D, args.in[IN_RW] + D * NE, 1.f};
            pg8::gemm_phase<pg8::EpiResRoute<true>, pg8::DenseOrder, false, false, false, true>(F.lds, nullptr, (const bf16_t*)(ws + WS_Y2), D, S, E); }
        else { pg8::EpiRes<true, true> E{(const void*)(ws + WS_X2), (void*)(ws + WS_X3), D, 1.f};
            pg8::gemm_phase<pg8::EpiRes<true, true>, pg8::DenseOrder, false, false, false, true>(F.lds, nullptr, (const bf16_t*)(ws + WS_Y2), D, S, E); }
    } SEAM(13);
    if (IN(14) && F.G != 256) { nr_phase<16, false>(F, (const bf16_t*)(ws + WS_X3), nullptr, nullptr, nullptr, args.in[IN_FNG] + D, nullptr, (unsigned char*)(ws + WS_XN8), args.in[IN_RW] + D * NE, NE, 0, (float*)(ws + WS_PART), nullptr, nullptr); }
    if (F.G != 256) SEAM(14);
    if (IN(15)) { topk_phase(F, (const float*)(ws + WS_PART), (int*)(ws + WS_IDX), (float*)(ws + WS_GATE), (float*)(ws + WS_RSC), (int*)(ws + WS_SLOT));
        if ((int)blockIdx.x >= 64) expert_conv_items(F, args, XI_C_END - XI_NC, XI_C_END, ((int)blockIdx.x - 64) * NWAVES + F.wave, (F.G - 64) * NWAVES); } SEAM(15);
    if (IN(16)) { moe_up_phase(F, ws, 1); } SEAM(16);
    if (IN(17)) { moe_down_phase(F, ws, 1); } SEAM(17);
    if (IN(18)) { combine_phase(F, (const bf16_t*)(ws + WS_X3), (const unsigned char*)(ws + WS_Y), (const int*)(ws + WS_SLOT), args.out); }
#undef IN
#undef SEAM
}

extern "C" void kernel_launch(void* const* d_in, const int* in_sizes, int n_in, void* d_out, int out_size, void* d_ws, size_t ws_size, hipStream_t stream) {
    static int grid = 0;
    if (grid == 0) {
        if (n_in != 19 || out_size != M * D || ws_size < WS_END) { fprintf(stderr, "kernel_launch: unexpected problem (n_in %d, out %d, ws %zu)\n", n_in, out_size, ws_size); grid = -1; return; }
        int dev = 0, cus = 0, per_cu = 0;
        if (hipGetDevice(&dev) != hipSuccess || hipDeviceGetAttribute(&cus, hipDeviceAttributeMultiprocessorCount, dev) != hipSuccess) { grid = -1; return; }
        if (hipFuncSetAttribute((const void*)fwd_kernel, hipFuncAttributeMaxDynamicSharedMemorySize, LDS_BYTES) != hipSuccess) { fprintf(stderr, "kernel_launch: hipFuncSetAttribute failed\n"); grid = -1; return; }
        if (hipOccupancyMaxActiveBlocksPerMultiprocessor(&per_cu, (const void*)fwd_kernel, NTHR, LDS_BYTES) != hipSuccess || per_cu < 1) fprintf(stderr, "kernel_launch: occupancy query reports %d\n", per_cu);
        (void)hipGetLastError();
        grid = cus;
    }
    if (grid < 0) return;
    if (hipMemsetAsync((char*)d_ws + WS_CTL, 0, CTL_ZERO_BYTES, stream) != hipSuccess) return;
    Args a{};
    for (int i = 0; i < 19; ++i) a.in[i] = (const float*)d_in[i];
    a.out = (float*)d_out; a.ws = (unsigned char*)d_ws; a.ph_lo = 0; a.ph_hi = 19;
#ifndef EXP_LO
    hipLaunchKernelGGL(fwd_kernel, dim3(grid), dim3(NTHR), LDS_BYTES, stream, a);
#else
    a.ph_lo = 0; a.ph_hi = EXP_HI; hipLaunchKernelGGL(fwd_kernel, dim3(grid), dim3(NTHR), LDS_BYTES, stream, a);
    hipMemsetAsync((char*)d_ws + WS_CTL, 0, CTL_ZERO_BYTES, stream);
    a.ph_lo = EXP_LO; a.ph_hi = 19; hipLaunchKernelGGL(fwd_kernel, dim3(grid), dim3(NTHR), LDS_BYTES, stream, a);
#endif
}
```
